# Optimizing an MI355X kernel written in HIP

```python
import math
import jax, jax.numpy as jnp
from jax import lax
import numpy as np

D_MODEL = 2048
BATCH = 16
SEQ = 2048
DEPTH = 1
DEC_BATCH = 8
DEC_SEQ = 4096
PAST_LEN = 128

DA_HEADS = 8
DA_DK = 64
DA_DV = 2 * DA_DK
SW_Q_HEADS = 16
SW_KV_HEADS = 4
SW_GROUP = SW_Q_HEADS // SW_KV_HEADS
SW_DH = 64
WINDOW = 128
BLOCK = 128
N_BUCKETS = 32
MAX_DISTANCE = 128
N_BIAS_HEADS = DA_HEADS + SW_Q_HEADS
D_FF = 5632
EPS = 1e-6

DA_Q = DA_HEADS * 2 * DA_DK
DA_K = DA_HEADS * 2 * DA_DK
DA_V = DA_HEADS * DA_DV
SW_Q = SW_Q_HEADS * SW_DH
SW_K = SW_KV_HEADS * SW_DH
SW_V = SW_KV_HEADS * SW_DH
D_IN = DA_Q + DA_K + DA_V + SW_Q + SW_K + SW_V
SPLITS = list(np.cumsum([DA_Q, DA_K, DA_V, SW_Q, SW_K]))
D_MIX = DA_HEADS * DA_DV + SW_Q_HEADS * SW_DH

kernel_name = "hybrid_diffattn_swa_macaron_encoder"


def rmsnorm(x, g):
    xf = x.astype(jnp.float32)
    y = xf * lax.rsqrt(jnp.mean(xf * xf, axis=-1, keepdims=True) + EPS)
    return (y * g.astype(jnp.float32)).astype(x.dtype)


def swiglu(x, w_gu, w_down):
    gu = x @ w_gu
    g, u = jnp.split(gu, 2, axis=-1)
    return (jax.nn.silu(g) * u) @ w_down


def t5_bucket(rp):
    half = N_BUCKETS // 2
    max_exact = half // 2
    ret = jnp.where(rp > 0, half, 0)
    n = jnp.abs(rp)
    nf = jnp.maximum(n, 1).astype(jnp.float32)
    large = max_exact + (jnp.log(nf / max_exact) / math.log(MAX_DISTANCE / max_exact)
                         * (half - max_exact)).astype(jnp.int32)
    large = jnp.minimum(large, half - 1)
    return ret + jnp.where(n < max_exact, n, large)


def diff_attention(q, k, v, lam, subln_g, lambda_init, rel_bias):
    B, S = q.shape[0], q.shape[1]
    nb = S // BLOCK
    scale = DA_DK ** -0.5
    qb = q.reshape(B, nb, BLOCK, DA_HEADS, 2, DA_DK).transpose(1, 0, 3, 4, 2, 5)
    kpos = jnp.arange(S)
    bias_tab = rel_bias[:, :DA_HEADS]

    def block(args):
        qi, i = args
        qpos = i * BLOCK + jnp.arange(BLOCK)
        bias = bias_tab[t5_bucket(kpos[None, :] - qpos[:, None])].astype(jnp.float32)
        s = jnp.einsum('bhmqd,bkhmd->bhmqk', qi, k).astype(jnp.float32) * scale \
            + bias.transpose(2, 0, 1)[None, :, None]
        p = jax.nn.softmax(s, axis=-1)
        a = p[:, :, 0] - lam * p[:, :, 1]
        return jnp.einsum('bhqk,bkhd->bqhd', a.astype(v.dtype), v)

    o = lax.map(block, (qb, jnp.arange(nb)))
    o = o.transpose(1, 0, 2, 3, 4).reshape(B, S, DA_HEADS, DA_DV)
    o = rmsnorm(o, subln_g) * (1.0 - lambda_init)
    return o.reshape(B, S, DA_HEADS * DA_DV)


def window_attention(q, k, v, sink, rel_bias):
    B, S = q.shape[0], q.shape[1]
    nb = S // BLOCK
    scale = SW_DH ** -0.5
    qb = jnp.moveaxis(q.reshape(B, nb, BLOCK, SW_KV_HEADS, SW_GROUP, SW_DH), 1, 0)

    def band(t):
        tp = jnp.pad(t, ((0, 0), (BLOCK, BLOCK), (0, 0), (0, 0)))
        tp = tp.reshape(B, nb + 2, BLOCK, SW_KV_HEADS, SW_DH)
        tb = jnp.concatenate([tp[:, :-2], tp[:, 1:-1], tp[:, 2:]], axis=2)
        return jnp.moveaxis(tb, 1, 0)

    kb, vb = band(k), band(v)
    off = jnp.arange(3 * BLOCK) - BLOCK
    rp = off[None, :] - jnp.arange(BLOCK)[:, None]
    kpos = jnp.arange(nb)[:, None] * BLOCK + off[None, :]
    valid = (jnp.abs(rp) <= WINDOW)[None] & ((kpos >= 0) & (kpos < S))[:, None, :]
    bias = rel_bias[t5_bucket(rp)][..., DA_HEADS:].astype(jnp.float32)
    bias = bias.transpose(2, 0, 1).reshape(SW_KV_HEADS, SW_GROUP, BLOCK, 3 * BLOCK)
    sk = sink.astype(jnp.float32).reshape(SW_KV_HEADS, SW_GROUP)[:, :, None, None]

    def block(args):
        qi, ki, vi, ok = args
        s = jnp.einsum('bqhgd,bkhd->bhgqk', qi, ki).astype(jnp.float32) * scale + bias
        s = jnp.where(ok[None, None, None], s, -jnp.inf)
        m = jnp.maximum(jnp.max(s, axis=-1, keepdims=True), sk)
        e = jnp.exp(s - m)
        p = e / (jnp.sum(e, axis=-1, keepdims=True) + jnp.exp(sk - m))
        return jnp.einsum('bhgqk,bkhd->bqhgd', p.astype(vi.dtype), vi)

    o = lax.map(block, (qb, kb, vb, valid))
    return jnp.moveaxis(o, 0, 1).reshape(B, S, SW_Q_HEADS * SW_DH)


def encoder_layer(x, l, rel_bias, g_ffn1_pre, w_ffn1_gu, w_ffn1_down, g_ffn1_post,
                  g_mix_pre, w_in, lambda_q1, lambda_k1, lambda_q2, lambda_k2,
                  g_diff_subln, sink_logit, w_out, g_mix_post,
                  g_ffn2_pre, w_ffn2_gu, w_ffn2_down, g_ffn2_post):
    B, S = x.shape[0], x.shape[1]
    lambda_init = 0.8 - 0.6 * math.exp(-0.3 * l)
    h = x + 0.5 * rmsnorm(swiglu(rmsnorm(x, g_ffn1_pre), w_ffn1_gu, w_ffn1_down), g_ffn1_post)
    n = rmsnorm(h, g_mix_pre)
    proj = n @ w_in
    q_da, k_da, v_da, q_sw, k_sw, v_sw = jnp.split(proj, SPLITS, axis=-1)
    lam = (jnp.exp(jnp.sum(lambda_q1.astype(jnp.float32) * lambda_k1.astype(jnp.float32)))
           - jnp.exp(jnp.sum(lambda_q2.astype(jnp.float32) * lambda_k2.astype(jnp.float32)))
           + lambda_init)
    o_da = diff_attention(q_da.reshape(B, S, DA_HEADS, 2, DA_DK),
                          k_da.reshape(B, S, DA_HEADS, 2, DA_DK),
                          v_da.reshape(B, S, DA_HEADS, DA_DV),
                          lam, g_diff_subln, lambda_init, rel_bias)
    o_sw = window_attention(q_sw.reshape(B, S, SW_Q_HEADS, SW_DH),
                            k_sw.reshape(B, S, SW_KV_HEADS, SW_DH),
                            v_sw.reshape(B, S, SW_KV_HEADS, SW_DH),
                            sink_logit, rel_bias)
    mix = jnp.concatenate([o_da, o_sw], axis=-1) @ w_out
    h = h + rmsnorm(mix, g_mix_post)
    return h + 0.5 * rmsnorm(swiglu(rmsnorm(h, g_ffn2_pre), w_ffn2_gu, w_ffn2_down), g_ffn2_post)


def setup_inputs(seed: int = 0) -> dict:
    key = jax.random.key(seed)
    ks = jax.random.split(key, 24)
    f32 = jnp.float32

    def nrm(k, shape, s):
        return jax.random.normal(k, shape, f32) * s

    def gain(k, shape):
        return 1.0 + 0.02 * jax.random.normal(k, shape, f32)

    return {
        "x_prompt": nrm(ks[0], (BATCH, SEQ, D_MODEL), 1.0),
        "x_sample": nrm(ks[1], (DEC_BATCH, DEC_SEQ, D_MODEL), 1.0),
        "rel_bias": nrm(ks[2], (N_BUCKETS, N_BIAS_HEADS), 0.2),
        "g_ffn1_pre": gain(ks[3], (DEPTH, D_MODEL)),
        "w_ffn1_gu": nrm(ks[4], (DEPTH, D_MODEL, 2 * D_FF), D_MODEL ** -0.5),
        "w_ffn1_down": nrm(ks[5], (DEPTH, D_FF, D_MODEL), D_FF ** -0.5),
        "g_ffn1_post": gain(ks[6], (DEPTH, D_MODEL)),
        "g_mix_pre": gain(ks[7], (DEPTH, D_MODEL)),
        "w_in": nrm(ks[8], (DEPTH, D_MODEL, D_IN), D_MODEL ** -0.5),
        "lambda_q1": nrm(ks[9], (DEPTH, DA_DK), 0.1),
        "lambda_k1": nrm(ks[10], (DEPTH, DA_DK), 0.1),
        "lambda_q2": nrm(ks[11], (DEPTH, DA_DK), 0.1),
        "lambda_k2": nrm(ks[12], (DEPTH, DA_DK), 0.1),
        "g_diff_subln": gain(ks[13], (DEPTH, DA_DV)),
        "sink_logit": nrm(ks[14], (DEPTH, SW_Q_HEADS), 0.5),
        "w_out": nrm(ks[15], (DEPTH, D_MIX, D_MODEL), D_MIX ** -0.5),
        "g_mix_post": gain(ks[16], (DEPTH, D_MODEL)),
        "g_ffn2_pre": gain(ks[17], (DEPTH, D_MODEL)),
        "w_ffn2_gu": nrm(ks[18], (DEPTH, D_MODEL, 2 * D_FF), D_MODEL ** -0.5),
        "w_ffn2_down": nrm(ks[19], (DEPTH, D_FF, D_MODEL), D_FF ** -0.5),
        "g_ffn2_post": gain(ks[20], (DEPTH, D_MODEL)),
    }


def reference(x_prompt, x_sample, rel_bias, g_ffn1_pre, w_ffn1_gu, w_ffn1_down, g_ffn1_post,
              g_mix_pre, w_in, lambda_q1, lambda_k1, lambda_q2, lambda_k2,
              g_diff_subln, sink_logit, w_out, g_mix_post,
              g_ffn2_pre, w_ffn2_gu, w_ffn2_down, g_ffn2_post):
    def trunk(x):
        for l in range(DEPTH):
            x = encoder_layer(x, l, rel_bias, g_ffn1_pre[l], w_ffn1_gu[l], w_ffn1_down[l],
                              g_ffn1_post[l], g_mix_pre[l], w_in[l], lambda_q1[l], lambda_k1[l],
                              lambda_q2[l], lambda_k2[l], g_diff_subln[l], sink_logit[l],
                              w_out[l], g_mix_post[l], g_ffn2_pre[l], w_ffn2_gu[l],
                              w_ffn2_down[l], g_ffn2_post[l])
        return x
    y_prompt = trunk(x_prompt)
    y_sample = trunk(x_sample)
    return (y_prompt, y_sample)
```

```cpp
#include <hip/hip_runtime.h>
#include <hip/hip_cooperative_groups.h>
#include <cstdio>
#include <cstdint>
#include <cmath>
namespace cg = cooperative_groups;
#define MK_MULTI_LAUNCH 0
namespace pg8 {
#define PG8_LAS __attribute__((address_space(3)))
typedef unsigned short bf16_t;
typedef short bf16x8 __attribute__((ext_vector_type(8)));
typedef float f32x4 __attribute__((ext_vector_type(4)));
typedef unsigned u32x4 __attribute__((ext_vector_type(4)));
constexpr int BM = 256, BK = 64, HALF = 128, HTB = HALF * BK * 2  , STAGE_BYTES = 8 * HTB, NXCD = 8, WGM = 8;

__host__ __device__ __forceinline__ int lds_byte(int r, int c) { const int st = (r >> 4) * 2 + (c >> 5), rr = r & 15, cc = c & 31, ob = rr * 64 + cc * 2; return st * 1024 + (ob ^ (((ob >> 9) & 1) << 5)); }
__host__ __device__ __forceinline__ void stage_rc(int b, int& R, int& C) { const int st = b / 1024, sb = b % 1024, swz = sb ^ (((sb >> 9) & 1) << 5); R = (st >> 1) * 16 + swz / 64; C = (st & 1) * 32 + (swz % 64) / 2; }
__host__ __device__ __forceinline__ int perm32(int rho) { const int n = rho >> 4, i = rho & 15; return 8 * (i >> 2) + 4 * n + (i & 3); }

struct Unit { int pm, pn; };
struct Gemm { const bf16_t* A; const bf16_t* Bt; int M, N, K; };

struct StaticOrder {
    int nM, nN, nwg, G, c;
    __host__ __device__ void init(int M, int N, int G_, int c_) { nM = M / BM; nN = N / BM; nwg = nM * nN; G = G_; c = c_; }
    __host__ __device__ bool next(int i, Unit& u) const {
        const long L = (long)i * G + c; if (L >= nwg) return false;
        int wgid = (int)L; { const int q = nwg / NXCD, r = nwg % NXCD, xcd = wgid % NXCD, off = wgid / NXCD; wgid = (xcd < r ? xcd * (q + 1) : r * (q + 1) + (xcd - r) * q) + off; }
        const int nig = WGM * nN, gid = wgid / nig, fm = gid * WGM, gsz = (nM - fm) < WGM ? (nM - fm) : WGM;
        u.pm = fm + ((wgid % nig) % gsz); u.pn = (wgid % nig) / gsz; return true;
    }
    __device__ __forceinline__ void a_ready(const Unit&) const {}
    __device__ __forceinline__ void done(const Unit&) const {}
};
__device__ __forceinline__ unsigned cvt_pk_bf16(float lo, float hi) { unsigned r; asm volatile("v_cvt_pk_bf16_f32 %0, %1, %2" : "=v"(r) : "v"(lo), "v"(hi)); return r; }
typedef unsigned u32x2 __attribute__((ext_vector_type(2)));
__device__ __forceinline__ float silu_mul(float g, float u) {
    const float e = __builtin_amdgcn_exp2f(g * -1.4426950408889634f);
    return g * __builtin_amdgcn_rcpf(1.0f + e) * u;
}
struct EpiSwiglu {
    static constexpr bool PERM = true, AFTER_DRAIN = false;
    bf16_t* O; int ldc; const float* rs;
    __device__ __forceinline__ void operator()(const f32x4 (&acc)[2][2][4][2], const Unit& u, int wr, int wc, int fr, int fq) const {
        const int row0 = u.pm * BM + wr * 64 + fr, col0 = u.pn * HALF + wc * 32 + 8 * fq;
#pragma unroll
        for (int ai = 0; ai < 2; ++ai)
#pragma unroll
            for (int m = 0; m < 4; ++m) {
                bf16_t* rowp = O + (size_t)(row0 + ai * HALF + m * 16) * ldc + col0;
                const float r = rs[row0 + ai * HALF + m * 16];
                const f32x4 g0 = acc[ai][0][m][0] * r, g1 = acc[ai][0][m][1] * r, u0 = acc[ai][1][m][0] * r, u1 = acc[ai][1][m][1] * r;
                u32x4 w;
                w.x = cvt_pk_bf16(silu_mul(g0[0], u0[0]), silu_mul(g0[1], u0[1]));
                w.y = cvt_pk_bf16(silu_mul(g0[2], u0[2]), silu_mul(g0[3], u0[3]));
                w.z = cvt_pk_bf16(silu_mul(g1[0], u1[0]), silu_mul(g1[1], u1[1]));
                w.w = cvt_pk_bf16(silu_mul(g1[2], u1[2]), silu_mul(g1[3], u1[3]));
                *(u32x4*)rowp = w;
            }
    }
};
struct EpiT {
    static constexpr bool PERM = true, AFTER_DRAIN = false;
    bf16_t* O; int ldc; float* part;
    __device__ __forceinline__ void operator()(const f32x4 (&acc)[2][2][4][2], const Unit& u, int wr, int wc, int fr, int fq) const {
        const int row0 = u.pm * BM + wr * 64 + fr, col0 = u.pn * BM + wc * 32 + 8 * fq;
#pragma unroll
        for (int ai = 0; ai < 2; ++ai)
#pragma unroll
            for (int m = 0; m < 4; ++m) {
                const int row = row0 + ai * HALF + m * 16;
                bf16_t* rowp = O + (size_t)row * ldc + col0;
                float ss = 0.f;
#pragma unroll
                for (int bj = 0; bj < 2; ++bj) {
                    const f32x4 v0 = acc[ai][bj][m][0], v1 = acc[ai][bj][m][1];
                    ss += (v0[0] * v0[0] + v0[1] * v0[1]) + (v0[2] * v0[2] + v0[3] * v0[3]) + (v1[0] * v1[0] + v1[1] * v1[1]) + (v1[2] * v1[2] + v1[3] * v1[3]);
                    u32x4 w; w.x = cvt_pk_bf16(v0[0], v0[1]); w.y = cvt_pk_bf16(v0[2], v0[3]); w.z = cvt_pk_bf16(v1[0], v1[1]); w.w = cvt_pk_bf16(v1[2], v1[3]);
                    *(u32x4*)(rowp + bj * HALF) = w;
                }
                ss += __shfl_xor(ss, 16); ss += __shfl_xor(ss, 32);
                if (fq == 0) part[(size_t)row * 32 + u.pn * 4 + wc] = ss;
            }
    }
};
struct EpiProj {
    static constexpr bool PERM = true, AFTER_DRAIN = false;
    bf16_t *Qda, *Kda, *VTda, *Qsw, *Ksw, *VTsw; float qscale; PG8_LAS unsigned char* epi_lds; const float* rs;
    __device__ __forceinline__ void operator()(const f32x4 (&acc)[2][2][4][2], const Unit& u, int wr, int wc, int fr, int fq) const {
        const int pn = u.pn;
        const int row0 = u.pm * BM + wr * 64 + fr;
        const int trow = u.pm * BM;
        int S, seqbase;
        if (trow < 32768) { S = 2048; seqbase = trow & ~2047; } else { S = 4096; seqbase = 32768 + ((trow - 32768) & ~4095); }
        const int s0 = row0 - seqbase;
        if (pn < 8 || (pn >= 12 && pn < 17)) {
            bf16_t* base; int colt; float sc = 1.f;
            if (pn < 4) { base = Qda + (size_t)seqbase * 1024; colt = pn * BM; sc = qscale; }
            else if (pn < 8) { base = Kda + (size_t)seqbase * 1024; colt = (pn - 4) * BM; }
            else if (pn < 16) { base = Qsw + (size_t)seqbase * 1024; colt = (pn - 12) * BM; sc = qscale; }
            else { base = Ksw + (size_t)seqbase * 256; colt = 0; }
            const int d0 = (wc & 1) * 32 + 8 * fq;
#pragma unroll
            for (int bj = 0; bj < 2; ++bj) {
                bf16_t* hb = base + (size_t)((colt >> 6) + bj * 2 + (wc >> 1)) * 64 * S + d0;
#pragma unroll
                for (int ai = 0; ai < 2; ++ai)
#pragma unroll
                    for (int m = 0; m < 4; ++m) {
                        const float r = rs[row0 + ai * HALF + m * 16] * sc;
                        const f32x4 v0 = acc[ai][bj][m][0] * r, v1 = acc[ai][bj][m][1] * r;
                        u32x4 w; w.x = cvt_pk_bf16(v0[0], v0[1]); w.y = cvt_pk_bf16(v0[2], v0[3]); w.z = cvt_pk_bf16(v1[0], v1[1]); w.w = cvt_pk_bf16(v1[2], v1[3]);
                        *(u32x4*)(hb + (size_t)(s0 + ai * HALF + m * 16) * 64) = w;
                    }
            }
        } else {
            bf16_t* base; int colt, dvh;
            if (pn < 12) { base = VTda + (size_t)seqbase * 1024; colt = (pn - 8) * BM; dvh = 128; } else { base = VTsw + (size_t)seqbase * 256; colt = 0; dvh = 64; }
            const int lane = fq * 16 + fr;
            PG8_LAS unsigned char* wl = epi_lds + (wr * 4 + wc) * 4096;
            const int stw = (u.pm * BM + wr * 64 - seqbase) >> 6;
#pragma unroll
            for (int ai = 0; ai < 2; ++ai)
#pragma unroll
                for (int bj = 0; bj < 2; ++bj) {
#pragma unroll
                    for (int m = 0; m < 4; ++m)
#pragma unroll
                        for (int n = 0; n < 2; ++n) {
                            const f32x4 v = acc[ai][bj][m][n] * rs[row0 + ai * HALF + m * 16];
                            const unsigned p01 = cvt_pk_bf16(v[0], v[1]), p23 = cvt_pk_bf16(v[2], v[3]);
                            const int token = m * 16 + fr, d = 8 * fq + 4 * n;
                            PG8_LAS unsigned char* wp = wl + d * 128 + (((token >> 3) ^ fq) << 4) + (token & 7) * 2;
                            *(PG8_LAS bf16_t*)(wp) = (bf16_t)(p01 & 0xffffu); *(PG8_LAS bf16_t*)(wp + 128) = (bf16_t)(p01 >> 16);
                            *(PG8_LAS bf16_t*)(wp + 256) = (bf16_t)(p23 & 0xffffu); *(PG8_LAS bf16_t*)(wp + 384) = (bf16_t)(p23 >> 16);
                        }
                    const int c0 = colt + bj * HALF + wc * 32, h = (dvh == 128) ? (c0 >> 7) : (c0 >> 6), dd0 = c0 & (dvh - 1);
                    bf16_t* blk = base + (size_t)h * dvh * S + (size_t)(stw + 2 * ai) * (dvh * 64) + dd0 * 64;
#pragma unroll
                    for (int i = 0; i < 4; ++i) {
                        const int q = lane + 64 * i, d = q >> 3, c = q & 7;
                        const u32x4 w = *(const PG8_LAS u32x4*)(wl + d * 128 + ((c ^ ((d >> 3) & 7)) << 4));
                        *(u32x4*)(blk + q * 8) = w;
                    }
                }
        }
    }
};
template <class Epi, class Sched, bool ALIGN_EPI = false, bool SP2 = false>
__device__ __forceinline__ void gemm_phase(PG8_LAS unsigned char* lds, const Gemm g, const Sched& S, const Epi& E) {
    const int tid = threadIdx.x, wid = __builtin_amdgcn_readfirstlane(tid >> 6), lane = tid & 63, wr = wid >> 2, wc = wid & 3, fr = lane & 15, fq = lane >> 4;
    const int K = g.K, nt = K / BK;
    unsigned voffA[2], voffB[2];
#pragma unroll
    for (int i = 0; i < 2; ++i) { int R, C; stage_rc(tid * 16 + i * 8192, R, C); const int Rb = Epi::PERM ? ((R & ~31) + perm32(R & 31)) : R;
        voffA[i] = (unsigned)(R * K + C) * 2u; voffB[i] = (unsigned)(Rb * K + C) * 2u; }
    const size_t kstep = (size_t)(BK * 2);
    const size_t hstep = (size_t)HALF * K * 2;
    const size_t tstep = 2 * hstep;
    const unsigned ldsw = (unsigned)wid * 1024u;
    const int aoff = lds_byte(wr * 64 + fr, fq * 8), boff = lds_byte(wc * 32 + fr, fq * 8);
#define PG8_SA(b, h) (((b) * 2 + (h)) * HTB)
#define PG8_SB(b, h) ((4 + (b) * 2 + (h)) * HTB)
#define PG8_STAGE(bufoff, gbase, voff) do { _Pragma("unroll") for (int _i = 0; _i < 2; ++_i) \
        __builtin_amdgcn_global_load_lds((const unsigned*)((const char*)(gbase) + (voff)[_i]), (PG8_LAS unsigned*)(lds + (bufoff) + ldsw + _i * 8192), 16, 0, 0); } while (0)
#define PG8_LDA(dst, b, h) do { _Pragma("unroll") for (int m = 0; m < 4; ++m) _Pragma("unroll") for (int k = 0; k < 2; ++k) dst[m][k] = *(const PG8_LAS bf16x8*)(lds + PG8_SA(b, h) + aoff + m * 2048 + k * 1024); } while (0)
#define PG8_LDB(dst, b, h) do { _Pragma("unroll") for (int n = 0; n < 2; ++n) _Pragma("unroll") for (int k = 0; k < 2; ++k) dst[n][k] = *(const PG8_LAS bf16x8*)(lds + PG8_SB(b, h) + boff + n * 2048 + k * 1024); } while (0)
#define PG8_MMA(ai, bj, At, Bt) do { __builtin_amdgcn_s_setprio(1); _Pragma("unroll") for (int m = 0; m < 4; ++m) _Pragma("unroll") for (int n = 0; n < 2; ++n) _Pragma("unroll") for (int k = 0; k < 2; ++k) \
        acc[ai][bj][m][n] = __builtin_amdgcn_mfma_f32_16x16x32_bf16(Bt[n][k], At[m][k], acc[ai][bj][m][n], 0, 0, 0); __builtin_amdgcn_s_setprio(0); } while (0)
#define PG8_WAIT_V(n) asm volatile("s_waitcnt vmcnt(" #n ")" ::: "memory")
#define PG8_WAIT_L(n) asm volatile("s_waitcnt lgkmcnt(" #n ")" ::: "memory")
#define PG8_BAR __builtin_amdgcn_s_barrier()
#define PG8_SCHED __builtin_amdgcn_sched_barrier(0)
    Unit cur, nxt; int ui = 0;
    if (!S.next(0, cur)) return;
    f32x4 acc[2][2][4][2];
#pragma unroll
    for (int a = 0; a < 2; ++a)
#pragma unroll
        for (int b = 0; b < 2; ++b)
#pragma unroll
            for (int m = 0; m < 4; ++m)
#pragma unroll
                for (int n = 0; n < 2; ++n) acc[a][b][m][n] = (f32x4){0.f, 0.f, 0.f, 0.f};
    bf16x8 At[4][2], B0[2][2], B1[2][2];
    const char* cA = (const char*)g.A + (size_t)cur.pm * tstep; const char* cB = (const char*)g.Bt + (size_t)cur.pn * tstep;
    S.a_ready(cur);
    if constexpr (SP2) {
        PG8_STAGE(PG8_SB(0, 0), cB, voffB); PG8_STAGE(PG8_SB(0, 1), cB + hstep, voffB); PG8_STAGE(PG8_SA(0, 0), cA, voffA); PG8_STAGE(PG8_SA(0, 1), cA + hstep, voffA);
        if (wr == 1) PG8_BAR;
        PG8_WAIT_V(2); PG8_BAR;
        PG8_STAGE(PG8_SB(1, 0), cB + kstep, voffB); PG8_STAGE(PG8_SA(1, 0), cA + kstep, voffA); PG8_STAGE(PG8_SB(1, 1), cB + hstep + kstep, voffB);
        PG8_WAIT_V(6); PG8_BAR;
    } else {
        PG8_STAGE(PG8_SB(0, 0), cB, voffB); PG8_STAGE(PG8_SA(0, 0), cA, voffA); PG8_STAGE(PG8_SB(0, 1), cB + hstep, voffB); PG8_STAGE(PG8_SA(0, 1), cA + hstep, voffA);
        if (wr == 1) PG8_BAR;
        PG8_WAIT_V(4); PG8_BAR;
        PG8_STAGE(PG8_SB(1, 0), cB + kstep, voffB); PG8_STAGE(PG8_SA(1, 0), cA + kstep, voffA); PG8_STAGE(PG8_SB(1, 1), cB + hstep + kstep, voffB);
        PG8_WAIT_V(6); PG8_BAR;
    }
    for (;;) {
        const bool has_next = S.next(ui + 1, nxt);
        const char* nA = has_next ? (const char*)g.A + (size_t)nxt.pm * tstep : cA; const char* nB = has_next ? (const char*)g.Bt + (size_t)nxt.pn * tstep : cB;
        for (int t = 0; t < nt; t += 2) {
            const bool last = (t == nt - 2);
            const char* a1 = cA + (size_t)(t + 1) * kstep;
            const char* a2 = last ? nA : cA + (size_t)(t + 2) * kstep; const char* b2 = last ? nB : cB + (size_t)(t + 2) * kstep;
            const char* a3 = a2 + kstep; const char* b3 = b2 + kstep;
            if (last && has_next) S.a_ready(nxt);
            if constexpr (SP2) {
            PG8_LDB(B0, 0, 0); PG8_LDB(B1, 0, 1); PG8_SCHED; PG8_LDA(At, 0, 0); PG8_STAGE(PG8_SA(1, 1), a1 + hstep, voffA);
            PG8_WAIT_V(8); PG8_WAIT_L(0); PG8_BAR; PG8_MMA(0, 0, At, B0); PG8_MMA(0, 1, At, B1); PG8_BAR; PG8_SCHED;
            PG8_LDA(At, 0, 1); PG8_STAGE(PG8_SB(0, 0), b2, voffB); PG8_STAGE(PG8_SB(0, 1), b2 + hstep, voffB); PG8_STAGE(PG8_SA(0, 0), a2, voffA);
            PG8_WAIT_V(8); PG8_WAIT_L(0); PG8_BAR; PG8_MMA(1, 0, At, B0); PG8_MMA(1, 1, At, B1); PG8_BAR; PG8_SCHED;
            PG8_LDB(B0, 1, 0); PG8_LDB(B1, 1, 1); PG8_SCHED; PG8_LDA(At, 1, 0); PG8_STAGE(PG8_SA(0, 1), a2 + hstep, voffA);
            PG8_WAIT_V(8); PG8_WAIT_L(0); PG8_BAR; PG8_MMA(0, 0, At, B0); PG8_MMA(0, 1, At, B1); PG8_BAR; PG8_SCHED;
            PG8_LDA(At, 1, 1); PG8_STAGE(PG8_SB(1, 0), b3, voffB); PG8_STAGE(PG8_SB(1, 1), b3 + hstep, voffB); PG8_STAGE(PG8_SA(1, 0), a3, voffA);
            PG8_WAIT_V(8); PG8_WAIT_L(0); PG8_BAR; PG8_MMA(1, 0, At, B0); PG8_MMA(1, 1, At, B1); PG8_BAR; PG8_SCHED;
            } else {
            PG8_LDB(B0, 0, 0); PG8_SCHED; PG8_LDA(At, 0, 0); PG8_STAGE(PG8_SA(1, 1), a1 + hstep, voffA);
            PG8_WAIT_L(8); PG8_BAR; PG8_WAIT_L(0); PG8_MMA(0, 0, At, B0); PG8_BAR; PG8_SCHED;
            PG8_LDB(B1, 0, 1); PG8_STAGE(PG8_SB(0, 0), b2, voffB);
            PG8_BAR; PG8_WAIT_L(0); PG8_MMA(0, 1, At, B1); PG8_BAR;
            PG8_LDA(At, 0, 1); PG8_STAGE(PG8_SA(0, 0), a2, voffA);
            PG8_BAR; PG8_WAIT_L(0); PG8_MMA(1, 0, At, B0); PG8_BAR; PG8_SCHED;
            PG8_STAGE(PG8_SB(0, 1), b2 + hstep, voffB);
            PG8_WAIT_V(6); PG8_BAR; PG8_MMA(1, 1, At, B1); PG8_BAR;
            PG8_LDB(B0, 1, 0); PG8_SCHED; PG8_LDA(At, 1, 0); PG8_STAGE(PG8_SA(0, 1), a2 + hstep, voffA);
            PG8_WAIT_L(8); PG8_BAR; PG8_WAIT_L(0); PG8_MMA(0, 0, At, B0); PG8_BAR; PG8_SCHED;
            PG8_LDB(B1, 1, 1); PG8_STAGE(PG8_SB(1, 0), b3, voffB);
            PG8_BAR; PG8_WAIT_L(0); PG8_MMA(0, 1, At, B1); PG8_BAR;
            PG8_LDA(At, 1, 1); PG8_STAGE(PG8_SA(1, 0), a3, voffA);
            PG8_BAR; PG8_WAIT_L(0); PG8_MMA(1, 0, At, B0); PG8_BAR; PG8_SCHED;
            PG8_STAGE(PG8_SB(1, 1), b3 + hstep, voffB);
            PG8_WAIT_V(6); PG8_BAR; PG8_MMA(1, 1, At, B1); PG8_BAR;
            }
        }
        if constexpr (ALIGN_EPI) { if (wr == 0) PG8_BAR; }
        if constexpr (!Epi::AFTER_DRAIN) { E(acc, cur, wr, wc, fr, fq); S.done(cur); }
        if (!has_next) break;
#pragma unroll
        for (int a = 0; a < 2; ++a)
#pragma unroll
            for (int b = 0; b < 2; ++b)
#pragma unroll
                for (int m = 0; m < 4; ++m)
#pragma unroll
                    for (int n = 0; n < 2; ++n) acc[a][b][m][n] = (f32x4){0.f, 0.f, 0.f, 0.f};
        cur = nxt; cA = nA; cB = nB; ++ui;
        if constexpr (ALIGN_EPI) { if (wr == 1) PG8_BAR; }
    }
    PG8_WAIT_V(0);
    if constexpr (!ALIGN_EPI) { if (wr == 0) PG8_BAR; }
    PG8_BAR;
    if constexpr (Epi::AFTER_DRAIN) { E.fused(acc, cur, wr, wc, fr, fq, lds, wid, lane); S.done(cur); }
#undef PG8_SA
#undef PG8_SB
#undef PG8_STAGE
#undef PG8_LDA
#undef PG8_LDB
#undef PG8_MMA
#undef PG8_WAIT_V
#undef PG8_WAIT_L
#undef PG8_BAR
#undef PG8_SCHED
}
}

#ifndef PG8_SP2
#define PG8_SP2 true
#endif
#ifndef PG8_ALIGN
#define PG8_ALIGN true
#endif
constexpr int D_MODEL = 2048, D_FF = 5632, D_IN = 4608;
constexpr int M_P = 16 * 2048, M_TOT = 65536;
constexpr float EPS = 1e-6f;
constexpr float LOG2E = 1.4426950408889634f;
constexpr float QSCALE = 0.125f * LOG2E;
constexpr float LAMBDA_INIT = 0.2f;
constexpr int NWAVES = 8, NTHREADS = 512;
constexpr int LDS_BYTES = 163840;

#define LAS __attribute__((address_space(3)))
typedef unsigned short bf16;
typedef short bf16x8 __attribute__((ext_vector_type(8)));
typedef float f32x16 __attribute__((ext_vector_type(16)));
typedef float f32x4 __attribute__((ext_vector_type(4)));
typedef unsigned u32x4 __attribute__((ext_vector_type(4)));
typedef unsigned u32x2 __attribute__((ext_vector_type(2)));
typedef float f32x2_t __attribute__((ext_vector_type(2)));
typedef __bf16 bf16x2_t __attribute__((ext_vector_type(2)));

constexpr size_t MiB = 1u << 20;
constexpr size_t WS_WGU1 = 0, WS_WD1 = 44 * MiB, WS_WIN = 66 * MiB, WS_WOUT = 84 * MiB, WS_WGU2 = 92 * MiB, WS_WD2 = 136 * MiB;
constexpr size_t WS_RS = 158 * MiB;
constexpr size_t WS_BAR = 159 * MiB;
constexpr size_t WS_PART = 160 * MiB;
constexpr size_t WS_XN = 168 * MiB;
constexpr size_t WS_T = 424 * MiB;
constexpr size_t WS_ACT = 680 * MiB;
constexpr size_t WS_QDA = WS_ACT, WS_KDA = WS_ACT + 128 * MiB, WS_VTDA = WS_ACT + 256 * MiB, WS_QSW = WS_ACT + 384 * MiB, WS_KSW = WS_ACT + 512 * MiB, WS_VTSW = WS_ACT + 544 * MiB;
constexpr size_t WS_H = WS_ACT + 704 * MiB;
constexpr size_t WS_END = WS_H + 256 * MiB;

__device__ __forceinline__ unsigned cvtpk(float lo, float hi) { f32x2_t v = {lo, hi}; bf16x2_t b = __builtin_convertvector(v, bf16x2_t); return __builtin_bit_cast(unsigned, b); }
__device__ __forceinline__ float hmax(float v) { auto rr = __builtin_amdgcn_permlane32_swap(__float_as_uint(v), __float_as_uint(v), false, false); return fmaxf(__uint_as_float(rr[0]), __uint_as_float(rr[1])); }
__device__ __forceinline__ float hsum(float v) { auto rr = __builtin_amdgcn_permlane32_swap(__float_as_uint(v), __float_as_uint(v), false, false); return __uint_as_float(rr[0]) + __uint_as_float(rr[1]); }
__device__ __forceinline__ float wave_sum(float v) {
#pragma unroll
    for (int o = 1; o < 64; o <<= 1) v += __shfl_xor(v, o);
    return v;
}
__device__ __forceinline__ float bf_lo(unsigned w) { return __uint_as_float(w << 16); }
__device__ __forceinline__ float bf_hi(unsigned w) { return __uint_as_float(w & 0xffff0000u); }

constexpr int A_K = 0, A_V = 32768, A_BT = 114688, A_G = 115968;

__device__ __forceinline__ int t5_bucket(int rp) {
    const int n = rp < 0 ? -rp : rp;
    int b;
    if (n < 8) b = n; else if (n < 12) b = 8; else if (n < 16) b = 9; else if (n < 23) b = 10; else if (n < 32) b = 11; else if (n < 46) b = 12; else if (n < 64) b = 13; else if (n < 91) b = 14; else b = 15;
    return b + (rp > 0 ? 16 : 0);
}

__device__ __forceinline__ float max3f(float a, float b, float c) { float r; asm("v_max3_f32 %0, %1, %2, %3" : "=v"(r) : "v"(a), "v"(b), "v"(c)); return r; }
#define SBAR() __builtin_amdgcn_sched_barrier(0)
__device__ __forceinline__ void v_reads(bf16x8 (&vf)[4], LAS unsigned char* lds, const unsigned (&vaddr)[4], unsigned off) {
#pragma unroll
    for (int c4 = 0; c4 < 4; ++c4) vf[c4] = *(const LAS bf16x8*)(lds + vaddr[c4] + off);
}
__device__ __forceinline__ void pv_mma(f32x16& o, const bf16x8 (&vf)[4], const bf16x8 (&p)[4]) {
#pragma unroll
    for (int c4 = 0; c4 < 4; ++c4) o = __builtin_amdgcn_mfma_f32_32x32x16_bf16(vf[c4], p[c4], o, 0, 0, 0);
}
template <int DV>
__device__ __forceinline__ void pv_rest(f32x16 (&o)[DV / 32], const bf16x8 (&p)[4], bf16x8 (&va)[4], bf16x8 (&vb)[4], LAS unsigned char* lds, const unsigned (&vaddr)[4], unsigned vb_) {
    if (DV == 128) {
        pv_mma(o[0], va, p); v_reads(va, lds, vaddr, vb_ + 2 * 4096); SBAR();
        pv_mma(o[1], vb, p); v_reads(vb, lds, vaddr, vb_ + 3 * 4096); SBAR();
        pv_mma(o[2], va, p); SBAR();
        pv_mma(o[DV / 32 - 1], vb, p);
    } else {
        pv_mma(o[0], va, p); SBAR();
        pv_mma(o[1], vb, p);
    }
}
__device__ __forceinline__ void glds16(const void* gsrc, unsigned lds_dst) {
    unsigned keep;
    asm volatile("s_mov_b32 %0, m0\n\ts_mov_b32 m0, %2\n\ts_nop 0\n\tglobal_load_lds_dwordx4 %1, off\n\ts_mov_b32 m0, %0" : "=&s"(keep) : "v"(gsrc), "s"(lds_dst) : "memory");
}
constexpr int NKS = 4, NVS = 5, PFD = 3;
template <int DV, bool SW>
__device__ __forceinline__ void flash(LAS unsigned char* lds, const bf16* __restrict__ Qw, int qpitch, const bf16* __restrict__ Kb, int kpitch,
                                      const bf16* __restrict__ VTb, int S, int t_lo, int t_hi, int qpos_w, bool grpB, f32x16 (&o)[DV / 32], float& mref, float& lsum) {
    const int tid = threadIdx.x, lane = tid & 63, r32 = lane & 31, hi = lane >> 5;
    const int wid = __builtin_amdgcn_readfirstlane(tid >> 6);
    const LAS float* bt = (const LAS float*)(lds + A_BT);
    const unsigned lds0 = (unsigned)(uintptr_t)lds;
    bf16x8 qf[4];
#pragma unroll
    for (int d0 = 0; d0 < 4; ++d0) qf[d0] = *(const bf16x8*)(Qw + (size_t)r32 * qpitch + d0 * 16 + hi * 8);
    const int lrow = wid * 8 + (lane >> 3), pch = lane & 7, lch = pch ^ ((lrow >> 1) & 7);
    const int rho = lrow & 31, key = (lrow & 32) + 16 * ((rho >> 2) & 1) + 4 * (rho >> 3) + (rho & 3);
    const bf16* ksrc = Kb + key * 64 + lch * 8;
    const bf16* vsrc = VTb + lrow * 64 + lch * 8;
    const unsigned kdst = lds0 + A_K + wid * 1024, vdst = lds0 + A_V + wid * 1024;
    const int sw = (r32 >> 1) & 7;
    unsigned kaddr[4], vaddr[4];
#pragma unroll
    for (int d0 = 0; d0 < 4; ++d0) kaddr[d0] = A_K + r32 * 128 + (((2 * d0 + hi) ^ sw) << 4);
#pragma unroll
    for (int c4 = 0; c4 < 4; ++c4) vaddr[c4] = A_V + r32 * 128 + (((4 * (c4 >> 1) + 2 * hi + (c4 & 1)) ^ sw) << 4);
#define FL_ISSUE(tt, ks, vs) do { const int tc_ = min((tt), t_hi - 1); \
        glds16(ksrc + (size_t)tc_ * 4096, (unsigned)__builtin_amdgcn_readfirstlane(kdst + (ks) * 8192)); \
        _Pragma("unroll") for (int i_ = 0; i_ < DV / 64; ++i_) glds16(vsrc + (size_t)tc_ * (DV * 64) + i_ * 4096, (unsigned)__builtin_amdgcn_readfirstlane(vdst + (vs) * 16384 + i_ * 8192)); } while (0)
    FL_ISSUE(t_lo, 0, 0); FL_ISSUE(t_lo + 1, 1, 1); FL_ISSUE(t_lo + 2, 2, 2);
    asm volatile("" :: "v"(qf[0]), "v"(qf[1]), "v"(qf[2]), "v"(qf[3]));
    if (DV == 128) asm volatile("s_waitcnt vmcnt(6) lgkmcnt(0)\n\ts_barrier" ::: "memory"); else asm volatile("s_waitcnt vmcnt(4) lgkmcnt(0)\n\ts_barrier" ::: "memory");
    int ks_cur = 0, ks_iss = 3;
    int vs_prev = 4, vs_cur = 0, vs_iss = 3;
    int cls_cur = 0; float cb = 0.f;
    bf16x8 p[4];
    bool have_prev = false;
    for (int t = t_lo; t <= t_hi; ++t) {
        bool issued = false;
        if (grpB && have_prev) {
            bf16x8 va[4], vb[4];
            v_reads(va, lds, vaddr, (unsigned)vs_prev * 16384); v_reads(vb, lds, vaddr, (unsigned)vs_prev * 16384 + 4096); SBAR();
            pv_rest<DV>(o, p, va, vb, lds, vaddr, (unsigned)vs_prev * 16384);
        }
        const int kt = t * 64;
        bool active = (t < t_hi);
        if (SW) active = active && (kt + 63 >= qpos_w - 128) && (kt <= qpos_w + 31 + 128);
        if (active) {
            const unsigned kb_ = (unsigned)ks_cur * 8192;
            bf16x8 kf[8];
#pragma unroll
            for (int d0 = 0; d0 < 4; ++d0) { kf[2 * d0] = *(const LAS bf16x8*)(lds + kaddr[d0] + kb_); kf[2 * d0 + 1] = *(const LAS bf16x8*)(lds + kaddr[d0] + kb_ + 4096); }
            SBAR();
            const int rpmin = kt - (qpos_w + 31), rpmax = kt + 63 - qpos_w;
            const int cls = SW ? 0 : (rpmax <= -91 ? 1 : (rpmin >= 91 ? 2 : 0));
            if (cls != cls_cur) { cls_cur = cls; cb = (cls == 0) ? 0.f : (cls == 1 ? bt[0] : bt[258]); }
            f32x16 s0, s1;
            s0 = __builtin_amdgcn_mfma_f32_32x32x16_bf16(kf[0], qf[0], f32x16{}, 0, 0, 0);
            s1 = __builtin_amdgcn_mfma_f32_32x32x16_bf16(kf[1], qf[0], f32x16{}, 0, 0, 0);
#pragma unroll
            for (int d0 = 1; d0 < 4; ++d0) {
                s0 = __builtin_amdgcn_mfma_f32_32x32x16_bf16(kf[2 * d0], qf[d0], s0, 0, 0, 0);
                s1 = __builtin_amdgcn_mfma_f32_32x32x16_bf16(kf[2 * d0 + 1], qf[d0], s1, 0, 0, 0);
            }
#ifdef PROBE_EXTRA_MFMA
            { f32x16 dm_;
#pragma unroll
              for (int d0 = 0; d0 < 4; ++d0) { asm volatile("v_mfma_f32_32x32x16_bf16 %0, %1, %2, 0" : "=v"(dm_) : "v"(kf[2 * d0]), "v"(qf[d0])); asm volatile("v_mfma_f32_32x32x16_bf16 %0, %1, %2, 0" : "=v"(dm_) : "v"(kf[2 * d0 + 1]), "v"(qf[d0])); } }
#endif
            bf16x8 va[4], vb[4];
            if (!grpB) { v_reads(va, lds, vaddr, (unsigned)vs_cur * 16384); v_reads(vb, lds, vaddr, (unsigned)vs_cur * 16384 + 4096); }
            SBAR();
            if (cls == 0) {
                const int a0 = (kt + 16 * hi - (qpos_w + r32) + 129) * 4 + A_BT;
#pragma unroll
                for (int rg = 0; rg < 4; ++rg) {
#pragma unroll
                    for (int r = 4 * rg; r < 4 * rg + 4; ++r) {
                        const int aa = min(max(a0 + 4 * r, A_BT), A_BT + 258 * 4), ab = min(max(a0 + 4 * r + 128, A_BT), A_BT + 258 * 4);
                        s0[r] += *(const LAS float*)(lds + aa);
                        s1[r] += *(const LAS float*)(lds + ab);
                    }
                    SBAR();
                }
            }
            float mx = max3f(s0[0], s1[0], s0[1]);
            mx = max3f(mx, s1[1], s0[2]);
#pragma unroll
            for (int r = 2; r < 15; ++r) mx = max3f(mx, s1[r], s0[r + 1]);
            mx = fmaxf(mx, s1[15]);
            mx = hmax(mx) + (cb - mref);
            if (__any(mx > 8.0f)) {
                const float dl = fmaxf(mx, 0.f);
                mref += dl;
                const float f = __builtin_amdgcn_exp2f(-dl);
                lsum *= f;
#pragma unroll
                for (int db = 0; db < DV / 32; ++db) o[db] *= f;
            }
            FL_ISSUE(t + PFD, ks_iss, vs_iss); issued = true;
            const float off = mref - cb;
            s0 = s0 - off; s1 = s1 - off;
#pragma unroll
            for (int r = 0; r < 16; ++r) { s0[r] = __builtin_amdgcn_exp2f(s0[r]); s1[r] = __builtin_amdgcn_exp2f(s1[r]); }
#ifdef PROBE_EXTRA_EXP
#pragma unroll
            for (int r = 0; r < 16; ++r) { float t0_, t1_; asm volatile("v_exp_f32 %0, %1" : "=v"(t0_) : "v"(s0[r])); asm volatile("v_exp_f32 %0, %1" : "=v"(t1_) : "v"(s1[r])); }
#endif
#ifdef PROBE_EXTRA_VALU
#pragma unroll
            for (int r = 0; r < 16; ++r) { float t0_, t1_, t2_, t3_; asm volatile("v_add_f32 %0, %1, %1" : "=v"(t0_) : "v"(s0[r])); asm volatile("v_add_f32 %0, %1, %1" : "=v"(t1_) : "v"(s1[r])); asm volatile("v_add_f32 %0, %1, %1" : "=v"(t2_) : "v"(s0[r])); asm volatile("v_add_f32 %0, %1, %1" : "=v"(t3_) : "v"(s1[r])); }
#endif
            {
                const f32x16 sm = s0 + s1;
                lsum += ((sm[0] + sm[1]) + (sm[2] + sm[3])) + ((sm[4] + sm[5]) + (sm[6] + sm[7])) + (((sm[8] + sm[9]) + (sm[10] + sm[11])) + ((sm[12] + sm[13]) + (sm[14] + sm[15])));
            }
            {
                u32x4 w;
                w.x = cvtpk(s0[0], s0[1]); w.y = cvtpk(s0[2], s0[3]); w.z = cvtpk(s0[4], s0[5]); w.w = cvtpk(s0[6], s0[7]); p[0] = __builtin_bit_cast(bf16x8, w);
                w.x = cvtpk(s0[8], s0[9]); w.y = cvtpk(s0[10], s0[11]); w.z = cvtpk(s0[12], s0[13]); w.w = cvtpk(s0[14], s0[15]); p[1] = __builtin_bit_cast(bf16x8, w);
                w.x = cvtpk(s1[0], s1[1]); w.y = cvtpk(s1[2], s1[3]); w.z = cvtpk(s1[4], s1[5]); w.w = cvtpk(s1[6], s1[7]); p[2] = __builtin_bit_cast(bf16x8, w);
                w.x = cvtpk(s1[8], s1[9]); w.y = cvtpk(s1[10], s1[11]); w.z = cvtpk(s1[12], s1[13]); w.w = cvtpk(s1[14], s1[15]); p[3] = __builtin_bit_cast(bf16x8, w);
            }
            if (!grpB) { SBAR(); pv_rest<DV>(o, p, va, vb, lds, vaddr, (unsigned)vs_cur * 16384); }
        }
        if (!issued) FL_ISSUE(t + PFD, ks_iss, vs_iss);
        have_prev = active;
        if (DV == 128) asm volatile("s_waitcnt vmcnt(6) lgkmcnt(0)\n\ts_barrier" ::: "memory"); else asm volatile("s_waitcnt vmcnt(4) lgkmcnt(0)\n\ts_barrier" ::: "memory");
        ks_cur = (ks_cur + 1) & 3; ks_iss = (ks_iss + 1) & 3;
        vs_prev = vs_cur; vs_cur = (vs_cur == NVS - 1) ? 0 : vs_cur + 1; vs_iss = (vs_iss == NVS - 1) ? 0 : vs_iss + 1;
    }
    asm volatile("s_waitcnt vmcnt(0)" ::: "memory");
    __syncthreads();
#undef FL_ISSUE
}

template <bool ISSUE>
__device__ __forceinline__ void da_tile(LAS unsigned char* lds, int t, int NT, int qpos_w, int r32, int hi, const bf16x8 (&qf)[4], const unsigned (&kaddr)[4], const unsigned (&vaddr)[4],
                                        const bf16* ksrc, const bf16* vsrc, unsigned kdst, unsigned vdst, int& cls_cur, float& cb, f32x16 (&o)[4], float& mref, float& lsum) {
    const LAS float* bt = (const LAS float*)(lds + A_BT);
    const unsigned kb_ = (unsigned)(t & 3) * 8192, vb_ = (unsigned)(t & 3) * 16384;
    bf16x8 kf[8];
#pragma unroll
    for (int d0 = 0; d0 < 4; ++d0) { kf[2 * d0] = *(const LAS bf16x8*)(lds + kaddr[d0] + kb_); kf[2 * d0 + 1] = *(const LAS bf16x8*)(lds + kaddr[d0] + kb_ + 4096); }
    SBAR();
    const int kt = t * 64;
    const int rpmin = kt - (qpos_w + 31), rpmax = kt + 63 - qpos_w;
    const int cls = (rpmax <= -91 ? 1 : (rpmin >= 91 ? 2 : 0));
    if (cls != cls_cur) { cls_cur = cls; cb = (cls == 0) ? 0.f : (cls == 1 ? bt[0] : bt[258]); }
    f32x16 s0, s1;
    s0 = __builtin_amdgcn_mfma_f32_32x32x16_bf16(kf[0], qf[0], f32x16{}, 0, 0, 0);
    s1 = __builtin_amdgcn_mfma_f32_32x32x16_bf16(kf[1], qf[0], f32x16{}, 0, 0, 0);
#pragma unroll
    for (int d0 = 1; d0 < 4; ++d0) {
        s0 = __builtin_amdgcn_mfma_f32_32x32x16_bf16(kf[2 * d0], qf[d0], s0, 0, 0, 0);
        s1 = __builtin_amdgcn_mfma_f32_32x32x16_bf16(kf[2 * d0 + 1], qf[d0], s1, 0, 0, 0);
    }
    bf16x8 va[4], vb[4];
    v_reads(va, lds, vaddr, vb_);
    SBAR();
    if (cls == 0) {
        int a0 = (kt + 16 * hi - (qpos_w + r32) + 129) * 4 + A_BT; asm volatile("" : "+v"(a0));
#pragma unroll
        for (int rg = 0; rg < 4; ++rg) {
#pragma unroll
            for (int r = 4 * rg; r < 4 * rg + 4; ++r) {
                const int aa = min(max(a0 + 4 * r, A_BT), A_BT + 258 * 4), ab = min(max(a0 + 4 * r + 128, A_BT), A_BT + 258 * 4);
                s0[r] += *(const LAS float*)(lds + aa);
                s1[r] += *(const LAS float*)(lds + ab);
            }
            SBAR();
        }
    }
    float mx;
    {
        float m0 = max3f(s0[0], s0[1], s0[2]), m1 = max3f(s0[8], s0[9], s0[10]), m2 = max3f(s1[0], s1[1], s1[2]), m3 = max3f(s1[8], s1[9], s1[10]);
        m0 = max3f(m0, s0[3], s0[4]); m1 = max3f(m1, s0[11], s0[12]); m2 = max3f(m2, s1[3], s1[4]); m3 = max3f(m3, s1[11], s1[12]);
        m0 = max3f(m0, s0[5], s0[6]); m1 = max3f(m1, s0[13], s0[14]); m2 = max3f(m2, s1[5], s1[6]); m3 = max3f(m3, s1[13], s1[14]);
        m0 = max3f(m0, s0[7], s0[15]); m2 = max3f(m2, s1[7], s1[15]);
        mx = max3f(max3f(m0, m1, m2), m3, m3);
    }
    mx = hmax(mx) + (cb - mref);
    if (__any(mx > 8.0f)) {
        const float dl = fmaxf(mx, 0.f);
        mref += dl;
        const float f = __builtin_amdgcn_exp2f(-dl);
        lsum *= f;
#pragma unroll
        for (int db = 0; db < 4; ++db) o[db] *= f;
    }
    if (ISSUE) {
        if (t + 2 < NT) {
            glds16(ksrc + (size_t)(t + 2) * 4096, (unsigned)__builtin_amdgcn_readfirstlane(kdst + ((t + 2) & 3) * 8192));
            glds16(vsrc + (size_t)(t + 2) * 8192, (unsigned)__builtin_amdgcn_readfirstlane(vdst + ((t + 2) & 3) * 16384));
            glds16(vsrc + (size_t)(t + 2) * 8192 + 4096, (unsigned)__builtin_amdgcn_readfirstlane(vdst + ((t + 2) & 3) * 16384 + 8192));
            glds16(ksrc + (size_t)(t + 3) * 4096, (unsigned)__builtin_amdgcn_readfirstlane(kdst + ((t + 3) & 3) * 8192));
            glds16(vsrc + (size_t)(t + 3) * 8192, (unsigned)__builtin_amdgcn_readfirstlane(vdst + ((t + 3) & 3) * 16384));
            glds16(vsrc + (size_t)(t + 3) * 8192 + 4096, (unsigned)__builtin_amdgcn_readfirstlane(vdst + ((t + 3) & 3) * 16384 + 8192));
        }
    }
    const float off = mref - cb;
    s0 = s0 - off; s1 = s1 - off;
#pragma unroll
    for (int r = 0; r < 16; ++r) { s0[r] = __builtin_amdgcn_exp2f(s0[r]); s1[r] = __builtin_amdgcn_exp2f(s1[r]); }
    {
        const f32x16 sm = s0 + s1;
        lsum += ((sm[0] + sm[1]) + (sm[2] + sm[3])) + ((sm[4] + sm[5]) + (sm[6] + sm[7])) + (((sm[8] + sm[9]) + (sm[10] + sm[11])) + ((sm[12] + sm[13]) + (sm[14] + sm[15])));
    }
    bf16x8 p[4];
    {
        u32x4 w;
        w.x = cvtpk(s0[0], s0[1]); w.y = cvtpk(s0[2], s0[3]); w.z = cvtpk(s0[4], s0[5]); w.w = cvtpk(s0[6], s0[7]); p[0] = __builtin_bit_cast(bf16x8, w);
        w.x = cvtpk(s0[8], s0[9]); w.y = cvtpk(s0[10], s0[11]); w.z = cvtpk(s0[12], s0[13]); w.w = cvtpk(s0[14], s0[15]); p[1] = __builtin_bit_cast(bf16x8, w);
        w.x = cvtpk(s1[0], s1[1]); w.y = cvtpk(s1[2], s1[3]); w.z = cvtpk(s1[4], s1[5]); w.w = cvtpk(s1[6], s1[7]); p[2] = __builtin_bit_cast(bf16x8, w);
        w.x = cvtpk(s1[8], s1[9]); w.y = cvtpk(s1[10], s1[11]); w.z = cvtpk(s1[12], s1[13]); w.w = cvtpk(s1[14], s1[15]); p[3] = __builtin_bit_cast(bf16x8, w);
    }
    v_reads(vb, lds, vaddr, vb_ + 4096);
    SBAR();
    pv_rest<128>(o, p, va, vb, lds, vaddr, vb_);
}
__device__ __forceinline__ void flash_da2(LAS unsigned char* lds, const bf16* __restrict__ Qw, const bf16* __restrict__ Kb, const bf16* __restrict__ VTb,
                                          int NT, int qpos_w, f32x16 (&o)[4], float& mref, float& lsum) {
    const int tid = threadIdx.x, lane = tid & 63, r32 = lane & 31, hi = lane >> 5;
    const int wid = __builtin_amdgcn_readfirstlane(tid >> 6);
    const unsigned lds0 = (unsigned)(uintptr_t)lds;
    bf16x8 qf[4];
#pragma unroll
    for (int d0 = 0; d0 < 4; ++d0) qf[d0] = *(const bf16x8*)(Qw + (size_t)r32 * 64 + d0 * 16 + hi * 8);
    const int lrow = wid * 8 + (lane >> 3), pch = lane & 7, lch = pch ^ ((lrow >> 1) & 7);
    const int rho = lrow & 31, key = (lrow & 32) + 16 * ((rho >> 2) & 1) + 4 * (rho >> 3) + (rho & 3);
    const bf16* ksrc = Kb + key * 64 + lch * 8;
    const bf16* vsrc = VTb + lrow * 64 + lch * 8;
    const unsigned kdst = lds0 + A_K + wid * 1024, vdst = lds0 + A_V + wid * 1024;
    const int sw = (r32 >> 1) & 7;
    unsigned kaddr[4], vaddr[4];
#pragma unroll
    for (int d0 = 0; d0 < 4; ++d0) kaddr[d0] = A_K + r32 * 128 + (((2 * d0 + hi) ^ sw) << 4);
#pragma unroll
    for (int c4 = 0; c4 < 4; ++c4) vaddr[c4] = A_V + r32 * 128 + (((4 * (c4 >> 1) + 2 * hi + (c4 & 1)) ^ sw) << 4);
#pragma unroll
    for (int j = 0; j < 2; ++j) {
        glds16(ksrc + (size_t)j * 4096, (unsigned)__builtin_amdgcn_readfirstlane(kdst + j * 8192));
        glds16(vsrc + (size_t)j * 8192, (unsigned)__builtin_amdgcn_readfirstlane(vdst + j * 16384));
        glds16(vsrc + (size_t)j * 8192 + 4096, (unsigned)__builtin_amdgcn_readfirstlane(vdst + j * 16384 + 8192));
    }
    asm volatile("" :: "v"(qf[0]), "v"(qf[1]), "v"(qf[2]), "v"(qf[3]));
    asm volatile("s_waitcnt vmcnt(0) lgkmcnt(0)\n\ts_barrier" ::: "memory");
    int cls_cur = 0; float cb = 0.f;
#pragma unroll 1
    for (int t = 0; t < NT; t += 2) {
        da_tile<true>(lds, t, NT, qpos_w, r32, hi, qf, kaddr, vaddr, ksrc, vsrc, kdst, vdst, cls_cur, cb, o, mref, lsum);
        da_tile<false>(lds, t + 1, NT, qpos_w, r32, hi, qf, kaddr, vaddr, ksrc, vsrc, kdst, vdst, cls_cur, cb, o, mref, lsum);
        asm volatile("s_waitcnt vmcnt(0) lgkmcnt(0)\n\ts_barrier" ::: "memory");
    }
}

struct AttnP {
    const bf16 *Qda, *Kda, *VTda, *Qsw, *Ksw, *VTsw; bf16* O;
    const float *rel_bias, *subln_g, *sink; float* stash;
};

__device__ __forceinline__ void bias_table(LAS unsigned char* lds, const float* rel_bias, int head, bool mask) {
    LAS float* bt = (LAS float*)(lds + A_BT);
    for (int i = threadIdx.x; i < 259; i += NTHREADS) {
        const int rp = i - 129;
        bt[i] = (mask && (rp < -128 || rp > 128)) ? -INFINITY : rel_bias[t5_bucket(rp) * 24 + head] * LOG2E;
    }
}

__device__ __forceinline__ void da_unit(LAS unsigned char* lds, const AttnP& P, int seqbase, int S, int h, int qb, float lam) {
    const int tid = threadIdx.x, lane = tid & 63, r32 = lane & 31, hi = lane >> 5, wid = __builtin_amdgcn_readfirstlane(tid >> 6);
    bias_table(lds, P.rel_bias, h, false);
    const int qpos_w = qb * 256 + wid * 32;
    const size_t row_w = (size_t)seqbase + qpos_w;
    const bf16* Kb = P.Kda + (size_t)seqbase * 1024 + (size_t)(h * 2) * 64 * S;
    const bf16* Qb = P.Qda + (size_t)seqbase * 1024 + (size_t)(h * 2) * 64 * S + (size_t)qpos_w * 64;
    const bf16* VTb = P.VTda + (size_t)seqbase * 1024 + (size_t)(h * 128) * S;
    f32x16 o[4];
    float ss = 0.f;
#pragma unroll 1
    for (int map = 0; map < 2; ++map) {
#pragma unroll
        for (int db = 0; db < 4; ++db) o[db] = f32x16{};
        float mref = 0.f, l = 0.f;
        flash_da2(lds, Qb + (size_t)map * 64 * S, Kb + (size_t)map * 64 * S, VTb, S / 64, qpos_w, o, mref, l);
        int tid3 = threadIdx.x; asm volatile("" : "+v"(tid3));
        f32x4* stash = (f32x4*)(P.stash + (size_t)blockIdx.x * 32768 + tid3 * 64);
        if (map == 0) {
            const float inv = 1.0f / hsum(l);
#pragma unroll
            for (int db = 0; db < 4; ++db)
#pragma unroll
                for (int g = 0; g < 4; ++g) stash[db * 4 + g] = (f32x4){o[db][4 * g], o[db][4 * g + 1], o[db][4 * g + 2], o[db][4 * g + 3]} * inv;
        } else {
            const float inv = lam / hsum(l);
#pragma unroll
            for (int db = 0; db < 4; ++db)
#pragma unroll
                for (int g = 0; g < 4; ++g) {
                    const f32x4 st = stash[db * 4 + g];
#pragma unroll
                    for (int e = 0; e < 4; ++e) { const float a = st[e] - o[db][4 * g + e] * inv; o[db][4 * g + e] = a; ss += a * a; }
                }
        }
    }
    ss = hsum(ss);
    const float rstd = __builtin_amdgcn_rsqf(ss * (1.0f / 128.0f) + EPS) * (1.0f - LAMBDA_INIT);
    int tid2 = threadIdx.x; asm volatile("" : "+v"(tid2));
    const int r32e = tid2 & 31, hie = (tid2 >> 5) & 1;
    bf16* orow = P.O + (row_w + r32e) * 2048 + h * 128 + 4 * hie;
    const LAS unsigned char* gb = lds + A_G + hie * 16;
#pragma unroll
    for (int db = 0; db < 4; ++db)
#pragma unroll
        for (int g4 = 0; g4 < 4; ++g4) {
            const int d0 = 32 * db + 8 * g4;
            const f32x4 gv = *(const LAS f32x4*)(gb + d0 * 4);
            u32x2 w;
            w.x = cvtpk(o[db][4 * g4] * rstd * gv[0], o[db][4 * g4 + 1] * rstd * gv[1]);
            w.y = cvtpk(o[db][4 * g4 + 2] * rstd * gv[2], o[db][4 * g4 + 3] * rstd * gv[3]);
            *(u32x2*)(orow + d0) = w;
        }
}

__device__ __forceinline__ void sw_unit(LAS unsigned char* lds, const AttnP& P, int blk, int qh) {
    const int tid = threadIdx.x, lane = tid & 63, r32 = lane & 31, hi = lane >> 5, wid = __builtin_amdgcn_readfirstlane(tid >> 6);
    const int row0 = blk * 256;
    int S, seqbase;
    if (row0 < M_P) { S = 2048; seqbase = row0 & ~2047; } else { S = 4096; seqbase = M_P + ((row0 - M_P) & ~4095); }
    const int q0 = row0 - seqbase;
    bias_table(lds, P.rel_bias, 8 + qh, true);
    const int kvh = qh >> 2;
    const int t_lo = max(0, q0 - 128) >> 6, t_hi = min(S, q0 + 384) >> 6;
    const int qpos_w = q0 + wid * 32;
    const size_t row_w = (size_t)row0 + wid * 32;
    f32x16 o[2];
    o[0] = f32x16{}; o[1] = f32x16{};
    float mref = 0.f, l = 0.f;
    flash<64, true>(lds, P.Qsw + (size_t)seqbase * 1024 + (size_t)qh * 64 * S + (size_t)qpos_w * 64, 64, P.Ksw + (size_t)seqbase * 256 + (size_t)kvh * 64 * S, 64, P.VTsw + (size_t)seqbase * 256 + (size_t)(kvh * 64) * S, S, t_lo, t_hi, qpos_w, wid >= 4, o, mref, l);
    const float lt = hsum(l) + __builtin_amdgcn_exp2f(P.sink[qh] * LOG2E - mref);
    const float inv = 1.0f / lt;
    bf16* orow = P.O + (row_w + r32) * 2048 + 1024 + qh * 64;
#pragma unroll
    for (int db = 0; db < 2; ++db)
#pragma unroll
        for (int g4 = 0; g4 < 4; ++g4) {
            const int d0 = 32 * db + 8 * g4 + 4 * hi;
            u32x2 w;
            w.x = cvtpk(o[db][4 * g4] * inv, o[db][4 * g4 + 1] * inv);
            w.y = cvtpk(o[db][4 * g4 + 2] * inv, o[db][4 * g4 + 3] * inv);
            *(u32x2*)(orow + d0) = w;
        }
}

constexpr int A_K8 = 0, A_V8 = 65536, A_BT4 = 131072;
__device__ __forceinline__ void sw_unit4(LAS unsigned char* lds, const AttnP& P, int blk, int kvh) {
    const int tid = threadIdx.x, lane = tid & 63, r32 = lane & 31, hi = lane >> 5, wid = __builtin_amdgcn_readfirstlane(tid >> 6);
    const unsigned lds0 = (unsigned)(uintptr_t)lds;
    const int row0 = blk * 256;
    int S, seqbase;
    if (row0 < M_P) { S = 2048; seqbase = row0 & ~2047; } else { S = 4096; seqbase = M_P + ((row0 - M_P) & ~4095); }
    const int q0 = row0 - seqbase;
    const int t_lo = max(0, q0 - 128) >> 6, t_hi = min(S, q0 + 384) >> 6;
    for (int i = tid; i < 4 * 452; i += NTHREADS) {
        const int g = i / 452, e = i - g * 452, rp = e - 224;
        ((LAS float*)(lds + A_BT4))[i] = (rp < -128 || rp > 128) ? -INFINITY : P.rel_bias[t5_bucket(rp) * 24 + 8 + kvh * 4 + g] * LOG2E;
    }
    {
        const int lrow = wid * 8 + (lane >> 3), pch = lane & 7, lch = pch ^ ((lrow >> 1) & 7);
        const int rho = lrow & 31, key = (lrow & 32) + 16 * ((rho >> 2) & 1) + 4 * (rho >> 3) + (rho & 3);
        const bf16* ksrc = P.Ksw + (size_t)seqbase * 256 + (size_t)kvh * 64 * S + key * 64 + lch * 8;
        const bf16* vsrc = P.VTsw + (size_t)seqbase * 256 + (size_t)(kvh * 64) * S + lrow * 64 + lch * 8;
        for (int t = t_lo; t < t_hi; ++t) {
            glds16(ksrc + (size_t)t * 4096, (unsigned)__builtin_amdgcn_readfirstlane(lds0 + A_K8 + (t - t_lo) * 8192 + wid * 1024));
            glds16(vsrc + (size_t)t * 4096, (unsigned)__builtin_amdgcn_readfirstlane(lds0 + A_V8 + (t - t_lo) * 8192 + wid * 1024));
        }
    }
    const int sw = (r32 >> 1) & 7;
    unsigned kaddr[4], vaddr[4];
#pragma unroll
    for (int d0 = 0; d0 < 4; ++d0) kaddr[d0] = A_K8 + r32 * 128 + (((2 * d0 + hi) ^ sw) << 4);
#pragma unroll
    for (int c4 = 0; c4 < 4; ++c4) vaddr[c4] = A_V8 + r32 * 128 + (((4 * (c4 >> 1) + 2 * hi + (c4 & 1)) ^ sw) << 4);
    const int qpos_w = q0 + wid * 32;
    const size_t row_w = (size_t)row0 + wid * 32;
    asm volatile("s_waitcnt vmcnt(0) lgkmcnt(0)\n\ts_barrier" ::: "memory");
    const bf16* Qg = P.Qsw + (size_t)seqbase * 1024 + (size_t)(kvh * 4) * 64 * S + (size_t)qpos_w * 64 + (size_t)r32 * 64 + hi * 8;
    bf16x8 qn[4];
#pragma unroll
    for (int d0 = 0; d0 < 4; ++d0) qn[d0] = *(const bf16x8*)(Qg + d0 * 16);
#pragma unroll 1
    for (int g = 0; g < 4; ++g) {
        const int qh = kvh * 4 + g;
        bf16x8 qf[4];
#pragma unroll
        for (int d0 = 0; d0 < 4; ++d0) qf[d0] = qn[d0];
        if (g < 3) {
#pragma unroll
            for (int d0 = 0; d0 < 4; ++d0) qn[d0] = *(const bf16x8*)(Qg + (size_t)(g + 1) * 64 * S + d0 * 16);
        }
        const int btg = A_BT4 + g * 1808;
        f32x16 o[2]; o[0] = f32x16{}; o[1] = f32x16{};
        float mref = 0.f, lsum = 0.f;
#pragma unroll 1
        for (int t = t_lo; t < t_hi; ++t) {
            const int kt = t * 64;
            if (!((kt + 63 >= qpos_w - 128) && (kt <= qpos_w + 31 + 128))) continue;
            const unsigned sl = (unsigned)(t - t_lo) * 8192;
            bf16x8 kf[8];
#pragma unroll
            for (int d0 = 0; d0 < 4; ++d0) { kf[2 * d0] = *(const LAS bf16x8*)(lds + kaddr[d0] + sl); kf[2 * d0 + 1] = *(const LAS bf16x8*)(lds + kaddr[d0] + sl + 4096); }
            f32x16 s0, s1;
            s0 = __builtin_amdgcn_mfma_f32_32x32x16_bf16(kf[0], qf[0], f32x16{}, 0, 0, 0);
            s1 = __builtin_amdgcn_mfma_f32_32x32x16_bf16(kf[1], qf[0], f32x16{}, 0, 0, 0);
#pragma unroll
            for (int d0 = 1; d0 < 4; ++d0) {
                s0 = __builtin_amdgcn_mfma_f32_32x32x16_bf16(kf[2 * d0], qf[d0], s0, 0, 0, 0);
                s1 = __builtin_amdgcn_mfma_f32_32x32x16_bf16(kf[2 * d0 + 1], qf[d0], s1, 0, 0, 0);
            }
            bf16x8 va[4], vb[4];
            v_reads(va, lds, vaddr, sl); v_reads(vb, lds, vaddr, sl + 4096);
            SBAR();
            {
                const LAS float* tb = (const LAS float*)(lds + btg) + (kt + 16 * hi - (qpos_w + r32) + 224);
#pragma unroll
                for (int rg = 0; rg < 4; ++rg) {
#pragma unroll
                    for (int r = 4 * rg; r < 4 * rg + 4; ++r) { s0[r] += tb[r]; s1[r] += tb[r + 32]; }
                    SBAR();
                }
            }
            float mx;
            {
                float m0 = max3f(s0[0], s0[1], s0[2]), m1 = max3f(s0[8], s0[9], s0[10]), m2 = max3f(s1[0], s1[1], s1[2]), m3 = max3f(s1[8], s1[9], s1[10]);
                m0 = max3f(m0, s0[3], s0[4]); m1 = max3f(m1, s0[11], s0[12]); m2 = max3f(m2, s1[3], s1[4]); m3 = max3f(m3, s1[11], s1[12]);
                m0 = max3f(m0, s0[5], s0[6]); m1 = max3f(m1, s0[13], s0[14]); m2 = max3f(m2, s1[5], s1[6]); m3 = max3f(m3, s1[13], s1[14]);
                m0 = max3f(m0, s0[7], s0[15]); m2 = max3f(m2, s1[7], s1[15]);
                mx = max3f(max3f(m0, m1, m2), m3, m3);
            }
            mx = hmax(mx) - mref;
            if (__any(mx > 8.0f)) {
                const float dl = fmaxf(mx, 0.f);
                mref += dl;
                const float f = __builtin_amdgcn_exp2f(-dl);
                lsum *= f; o[0] *= f; o[1] *= f;
            }
            s0 = s0 - mref; s1 = s1 - mref;
#pragma unroll
            for (int r = 0; r < 16; ++r) { s0[r] = __builtin_amdgcn_exp2f(s0[r]); s1[r] = __builtin_amdgcn_exp2f(s1[r]); }
            {
                const f32x16 sm = s0 + s1;
                lsum += ((sm[0] + sm[1]) + (sm[2] + sm[3])) + ((sm[4] + sm[5]) + (sm[6] + sm[7])) + (((sm[8] + sm[9]) + (sm[10] + sm[11])) + ((sm[12] + sm[13]) + (sm[14] + sm[15])));
            }
            bf16x8 p[4];
            {
                u32x4 w;
                w.x = cvtpk(s0[0], s0[1]); w.y = cvtpk(s0[2], s0[3]); w.z = cvtpk(s0[4], s0[5]); w.w = cvtpk(s0[6], s0[7]); p[0] = __builtin_bit_cast(bf16x8, w);
                w.x = cvtpk(s0[8], s0[9]); w.y = cvtpk(s0[10], s0[11]); w.z = cvtpk(s0[12], s0[13]); w.w = cvtpk(s0[14], s0[15]); p[1] = __builtin_bit_cast(bf16x8, w);
                w.x = cvtpk(s1[0], s1[1]); w.y = cvtpk(s1[2], s1[3]); w.z = cvtpk(s1[4], s1[5]); w.w = cvtpk(s1[6], s1[7]); p[2] = __builtin_bit_cast(bf16x8, w);
                w.x = cvtpk(s1[8], s1[9]); w.y = cvtpk(s1[10], s1[11]); w.z = cvtpk(s1[12], s1[13]); w.w = cvtpk(s1[14], s1[15]); p[3] = __builtin_bit_cast(bf16x8, w);
            }
            SBAR();
            pv_mma(o[0], va, p); pv_mma(o[1], vb, p);
        }
        const float lt = hsum(lsum) + __builtin_amdgcn_exp2f(P.sink[qh] * LOG2E - mref);
        const float inv = 1.0f / lt;
        bf16* orow = P.O + (row_w + r32) * 2048 + 1024 + qh * 64 + 4 * hi;
#pragma unroll
        for (int db = 0; db < 2; ++db)
#pragma unroll
            for (int g4 = 0; g4 < 4; ++g4) {
                u32x2 w;
                w.x = cvtpk(o[db][4 * g4] * inv, o[db][4 * g4 + 1] * inv);
                w.y = cvtpk(o[db][4 * g4 + 2] * inv, o[db][4 * g4 + 3] * inv);
                *(u32x2*)(orow + 32 * db + 8 * g4) = w;
            }
    }
    asm volatile("s_waitcnt vmcnt(0) lgkmcnt(0)\n\ts_barrier" ::: "memory");
}

__device__ __forceinline__ void attn_phase(LAS unsigned char* lds, const AttnP& P, int vcu, int G, const float* lq1, const float* lk1, const float* lq2, const float* lk2) {
    const int lane = threadIdx.x & 63;
    const float s1 = wave_sum(lq1[lane] * lk1[lane]), s2 = wave_sum(lq2[lane] * lk2[lane]);
    const float lam = __expf(s1) - __expf(s2) + LAMBDA_INIT;
    if (threadIdx.x < 128) ((LAS float*)(lds + A_G))[threadIdx.x] = P.subln_g[threadIdx.x];
#ifndef REP_DA
#define REP_DA 1
#endif
#ifndef REP_SW
#define REP_SW 1
#endif
#ifndef NO_DA
    const int nda = (G == 256) ? 8 : (2048 - vcu + G - 1) / G;
#pragma unroll 1
    for (int j0 = 0; j0 < nda * REP_DA; ++j0) {
        const int j = j0 % nda;
        int grp, qb, seqbase, S;
        if (G == 256) {
            const int x = vcu >> 5, i = vcu & 31;
            if (j < 4) { grp = x * 16 + j * 4 + (i >> 3); qb = i & 7; seqbase = (grp >> 3) * 2048; S = 2048; }
            else { grp = x * 8 + (j - 4) * 2 + (i >> 4); qb = i & 15; seqbase = M_P + (grp >> 3) * 4096; S = 4096; }
        } else {
            const int u = vcu + j * G;
            if (u < 1024) { grp = u >> 3; qb = u & 7; seqbase = (grp >> 3) * 2048; S = 2048; }
            else { const int u2 = u - 1024; grp = u2 >> 4; qb = u2 & 15; seqbase = M_P + (grp >> 3) * 4096; S = 4096; }
        }
        da_unit(lds, P, seqbase, S, grp & 7, qb, lam);
    }
#endif
#ifndef NO_SW
    __syncthreads();
#pragma unroll 1
    for (int u = vcu; u < 256; u += G)
#pragma unroll 1
        for (int kv0 = 0; kv0 < 4 * REP_SW; ++kv0) sw_unit4(lds, P, u, kv0 & 3);
#endif
}

__device__ __forceinline__ unsigned f2bf(float f) { unsigned u = __builtin_bit_cast(unsigned, f); return (u + 0x7fffu + ((u >> 16) & 1u)) >> 16; }
__device__ __forceinline__ unsigned pk2(float lo, float hi) { return f2bf(lo) | (f2bf(hi) << 16); }
template <bool GU>
__device__ __forceinline__ void transpose_item(const float* __restrict__ W, int K, int N, bf16* __restrict__ WT, LAS float* scr, int item, int lane, const float* __restrict__ gk) {
    const int nblk = N / 32, kb = item / nblk, nb = item % nblk, k0 = 64 * kb, n0 = 32 * nb;
    int r0 = n0;
    if (GU) { r0 = (n0 < D_FF) ? (n0 >> 7) * 256 + (n0 & 127) : ((n0 - D_FF) >> 7) * 256 + 128 + ((n0 - D_FF) & 127); }
    float wv[32];
#pragma unroll
    for (int i = 0; i < 32; ++i) wv[i] = W[(size_t)(k0 + 2 * i + (lane >> 5)) * N + n0 + (lane & 31)];
#pragma unroll
    for (int i = 0; i < 32; ++i) scr[(2 * i + (lane >> 5)) * 33 + (lane & 31)] = gk ? wv[i] * gk[k0 + 2 * i + (lane >> 5)] : wv[i];
    asm volatile("s_waitcnt lgkmcnt(0)" ::: "memory");
    const int c = lane & 7;
#pragma unroll
    for (int j = 0; j < 4; ++j) { const int n = (lane >> 3) + 8 * j; const LAS float* s = scr + (8 * c) * 33 + n;
        u32x4 o; o.x = pk2(s[0 * 33], s[1 * 33]); o.y = pk2(s[2 * 33], s[3 * 33]); o.z = pk2(s[4 * 33], s[5 * 33]); o.w = pk2(s[6 * 33], s[7 * 33]);
        *(u32x4*)(WT + (size_t)(r0 + n) * K + k0 + 8 * c) = o; }
    asm volatile("s_waitcnt lgkmcnt(0)" ::: "memory");
}

template <bool HAS_T, bool NEXT, bool BASE_BF, bool OUT_BF>
__device__ __forceinline__ void rowpass(int gw, int ngw, int lane, const float* base0, const float* base1, const bf16* hin, const bf16* T, const float* part, const float* gpost, float alpha,
                                        float* out, bf16* hout, float* rs, bf16* xn) {
    f32x4 gp[4][2];
#pragma unroll
    for (int j = 0; j < 4; ++j)
#pragma unroll
        for (int e = 0; e < 2; ++e) {
            if (HAS_T) gp[j][e] = *(const f32x4*)(gpost + j * 512 + lane * 8 + e * 4) * alpha;
        }
    for (int row_ = gw; row_ < M_TOT; row_ += ngw) {
        const int row = HAS_T ? (M_TOT - 1 - row_) : row_;
        f32x4 v[4][2];
        if (BASE_BF) {
            u32x4 hw[4];
#pragma unroll
            for (int j = 0; j < 4; ++j) hw[j] = *(const u32x4*)(hin + (size_t)row * D_MODEL + j * 512 + lane * 8);
#pragma unroll
            for (int j = 0; j < 4; ++j) { v[j][0] = (f32x4){bf_lo(hw[j].x), bf_hi(hw[j].x), bf_lo(hw[j].y), bf_hi(hw[j].y)}; v[j][1] = (f32x4){bf_lo(hw[j].z), bf_hi(hw[j].z), bf_lo(hw[j].w), bf_hi(hw[j].w)}; }
        } else {
            const float* brow = (row < M_P ? base0 : base1) + (size_t)row * D_MODEL;
#pragma unroll
            for (int j = 0; j < 4; ++j) { v[j][0] = *(const f32x4*)(brow + j * 512 + lane * 8); v[j][1] = *(const f32x4*)(brow + j * 512 + lane * 8 + 4); }
        }
        if (HAS_T) {
            u32x4 tw[4];
#pragma unroll
            for (int j = 0; j < 4; ++j) tw[j] = *(const u32x4*)(T + (size_t)row * D_MODEL + j * 512 + lane * 8);
            float ps = (lane < 32) ? part[(size_t)row * 32 + lane] : 0.f;
            ps = wave_sum(ps);
            const float rstd = __builtin_amdgcn_rsqf(ps * (1.0f / D_MODEL) + EPS);
#pragma unroll
            for (int j = 0; j < 4; ++j) {
                const f32x4 t0 = {bf_lo(tw[j].x), bf_hi(tw[j].x), bf_lo(tw[j].y), bf_hi(tw[j].y)}, t1 = {bf_lo(tw[j].z), bf_hi(tw[j].z), bf_lo(tw[j].w), bf_hi(tw[j].w)};
                v[j][0] += t0 * rstd * gp[j][0]; v[j][1] += t1 * rstd * gp[j][1];
            }
            if (OUT_BF) {
                bf16* hr = hout + (size_t)row * D_MODEL;
#pragma unroll
                for (int j = 0; j < 4; ++j) {
                    u32x4 w; w.x = cvtpk(v[j][0][0], v[j][0][1]); w.y = cvtpk(v[j][0][2], v[j][0][3]); w.z = cvtpk(v[j][1][0], v[j][1][1]); w.w = cvtpk(v[j][1][2], v[j][1][3]);
                    *(u32x4*)(hr + j * 512 + lane * 8) = w;
                }
            } else {
                float* orow = out + (size_t)row * D_MODEL;
#pragma unroll
                for (int j = 0; j < 4; ++j) { *(f32x4*)(orow + j * 512 + lane * 8) = v[j][0]; *(f32x4*)(orow + j * 512 + lane * 8 + 4) = v[j][1]; }
            }
        }
        if (NEXT) {
            float ss = 0.f;
#pragma unroll
            for (int j = 0; j < 4; ++j)
#pragma unroll
                for (int e = 0; e < 2; ++e) ss += (v[j][e][0] * v[j][e][0] + v[j][e][1] * v[j][e][1]) + (v[j][e][2] * v[j][e][2] + v[j][e][3] * v[j][e][3]);
            ss = wave_sum(ss);
            if (lane == 0) rs[row] = __builtin_amdgcn_rsqf(ss * (1.0f / D_MODEL) + EPS);
            if (!HAS_T) {
                bf16* xr = xn + (size_t)row * D_MODEL;
#pragma unroll
                for (int j = 0; j < 4; ++j) {
                    u32x4 w; w.x = cvtpk(v[j][0][0], v[j][0][1]); w.y = cvtpk(v[j][0][2], v[j][0][3]); w.z = cvtpk(v[j][1][0], v[j][1][1]); w.w = cvtpk(v[j][1][2], v[j][1][3]);
                    *(u32x4*)(xr + j * 512 + lane * 8) = w;
                }
            }
        }
    }
}

#ifndef REP_P0
#define REP_P0 1
#endif
#ifndef REP_P1
#define REP_P1 1
#endif
#ifndef REP_P2
#define REP_P2 1
#endif
#ifndef REP_P3
#define REP_P3 1
#endif
#ifndef REP_P4
#define REP_P4 1
#endif
#ifndef REP_P5
#define REP_P5 1
#endif
#ifndef REP_P6
#define REP_P6 1
#endif
#ifndef REP_P7
#define REP_P7 1
#endif
#ifndef REP_P8
#define REP_P8 1
#endif
#ifndef REP_P9
#define REP_P9 1
#endif
#ifndef REP_P10
#define REP_P10 1
#endif
#define XB_TMO      128
#define XB_XCNT(j)  (256  + 64 * (j))
#define XB_XSUB(j)  (1280 + 64 * (j))
#define XB_XGEN(j)  (2304 + 64 * (j))
#define XB_TOP      3328
#define XB_TOPGEN   3392
#define XCD_BAR_WORDS 3456
#define XB_SPIN_CAP (1u << 18)

__device__ __forceinline__ unsigned xb_ld(unsigned* p)              { return __hip_atomic_load(p, __ATOMIC_RELAXED, __HIP_MEMORY_SCOPE_AGENT); }
__device__ __forceinline__ unsigned xb_add(unsigned* p, unsigned v) { return __hip_atomic_fetch_add(p, v, __ATOMIC_RELAXED, __HIP_MEMORY_SCOPE_AGENT); }
__device__ __forceinline__ unsigned xb_xcc_id() { return (unsigned)__builtin_amdgcn_s_getreg((3 << 11) | 20) & 0xFu; }
#define XB_SPIN(cond, bar) do { unsigned _sp = 0; while (cond) { __builtin_amdgcn_s_sleep(1); \
    if ((++_sp & 255u) == 0u) { if (xb_ld(&(bar)[XB_TMO])) break; if (_sp > XB_SPIN_CAP) { atomicAdd(&(bar)[XB_TMO], 1u); break; } } } } while (0)

struct XcdBarrier {
    unsigned* bar; unsigned x;
    unsigned nloc, nx;
};

__device__ __forceinline__ XcdBarrier xcd_barrier_post(unsigned* bar) {
    XcdBarrier b; b.bar = bar; b.x = xb_xcc_id(); b.nloc = 0u; b.nx = 0u;
    if (threadIdx.x == 0) (void)xb_add(&bar[XB_XCNT(b.x)], 1u);
    return b;
}
__device__ __forceinline__ void xcd_barrier_complete(unsigned* bar, unsigned x, unsigned& nloc, unsigned& nx) {
    const unsigned G = gridDim.x * gridDim.y * gridDim.z;
    unsigned sum, cnt, mine, sp = 0u;
    for (;;) {
        sum = 0u; cnt = 0u; mine = 0u;
#pragma unroll
        for (unsigned j = 0; j < 16; ++j) { const unsigned c = xb_ld(&bar[XB_XCNT(j)]); sum += c; cnt += (c > 0u) ? 1u : 0u; mine = (j == x) ? c : mine; }
        if (sum == G) break;
        __builtin_amdgcn_s_sleep(1);
        if ((++sp & 255u) == 0u) { if (xb_ld(&bar[XB_TMO])) break; if (sp > XB_SPIN_CAP) { atomicAdd(&bar[XB_TMO], 1u); break; } }
    }
    nloc = mine > 0u ? mine : 1u; nx = cnt > 0u ? cnt : 1u;
}

__device__ __forceinline__ void xcd_barrier(XcdBarrier& b) {
    asm volatile("s_waitcnt vmcnt(0)" ::: "memory");
    __syncthreads();
    if (threadIdx.x == 0) {
        unsigned* bar = b.bar;
        __builtin_amdgcn_s_waitcnt(0);
        unsigned nloc = b.nloc, nx = b.nx;
        if (nloc == 0u) { xcd_barrier_complete(bar, b.x, nloc, nx); b.nloc = nloc; b.nx = nx; }
        const unsigned old = xb_add(&bar[XB_XSUB(b.x)], 1u);
        const unsigned gen = old / nloc;
        if (old + 1u == (gen + 1u) * nloc) {
            __builtin_amdgcn_fence(__ATOMIC_RELEASE, "agent");
            asm volatile("s_waitcnt vmcnt(0)" ::: "memory");
            const unsigned og = xb_add(&bar[XB_TOP], 1u);
            const unsigned tg = og / nx;
            if (og + 1u == (tg + 1u) * nx) xb_add(&bar[XB_TOPGEN], 1u);
            else XB_SPIN(xb_ld(&bar[XB_TOPGEN]) == tg, bar);
            __builtin_amdgcn_fence(__ATOMIC_ACQUIRE, "agent");
            xb_add(&bar[XB_XGEN(b.x)], 1u);
            asm volatile("s_waitcnt vmcnt(0)" ::: "memory");
        } else {
            XB_SPIN(xb_ld(&bar[XB_XGEN(b.x)]) == gen, bar);
            __builtin_amdgcn_fence(__ATOMIC_ACQUIRE, "agent");
            asm volatile("s_waitcnt vmcnt(0)" ::: "memory");
        }
    }
    __syncthreads();
}

constexpr int N_PHASES = 11;
struct Args { const float* in[21]; float* out; unsigned char* ws; int ph_lo, ph_hi; };
static_assert(sizeof(Args) == 21 * 8 + 8 + 8 + 8, "Args has no padding");

__global__ void __launch_bounds__(NTHREADS, 2) mega_fwd(Args args) {
    extern __shared__ __attribute__((aligned(16))) unsigned char lds_raw[];
    LAS unsigned char* lds = (LAS unsigned char*)lds_raw;
    cg::grid_group grid = cg::this_grid();
    const int tid = threadIdx.x, lane = tid & 63, wave = __builtin_amdgcn_readfirstlane(tid >> 6);
    const int G = gridDim.x, bx = blockIdx.x;
    const int vcu = (G % 8 == 0) ? (bx % 8) * (G / 8) + bx / 8 : bx;
    const int gw = vcu * NWAVES + wave, ngw = G * NWAVES;
    unsigned char* ws = args.ws;
    const float* x_prompt = args.in[0]; const float* x_sample = args.in[1]; const float* rel_bias = args.in[2];
    const float* g_ffn1_pre = args.in[3]; const float* w_ffn1_gu = args.in[4]; const float* w_ffn1_down = args.in[5]; const float* g_ffn1_post = args.in[6];
    const float* g_mix_pre = args.in[7]; const float* w_in = args.in[8];
    const float* lq1 = args.in[9]; const float* lk1 = args.in[10]; const float* lq2 = args.in[11]; const float* lk2 = args.in[12];
    const float* g_subln = args.in[13]; const float* sink = args.in[14]; const float* w_out = args.in[15]; const float* g_mix_post = args.in[16];
    const float* g_ffn2_pre = args.in[17]; const float* w_ffn2_gu = args.in[18]; const float* w_ffn2_down = args.in[19]; const float* g_ffn2_post = args.in[20];
    float* out = args.out;
    bf16* Wgu1 = (bf16*)(ws + WS_WGU1); bf16* Wd1 = (bf16*)(ws + WS_WD1); bf16* Win = (bf16*)(ws + WS_WIN); bf16* Wout = (bf16*)(ws + WS_WOUT);
    bf16* Wgu2 = (bf16*)(ws + WS_WGU2); bf16* Wd2 = (bf16*)(ws + WS_WD2);
    float* PART = (float*)(ws + WS_PART); float* RS = (float*)(ws + WS_RS); bf16* XN = (bf16*)(ws + WS_XN); bf16* T = (bf16*)(ws + WS_T); bf16* ACT = (bf16*)(ws + WS_ACT); bf16* H = (bf16*)(ws + WS_H);
    const float* xs_off = x_sample - (size_t)M_P * D_MODEL;
    const int lo = args.ph_lo, hi = args.ph_hi;
    XcdBarrier xbar; xbar.bar = (unsigned*)(ws + WS_BAR); xbar.x = 0u; xbar.nloc = 0u; xbar.nx = 0u;
#ifndef PH_MASK
#define PH_MASK 0x7ff
#endif
#define IN(k) (((PH_MASK >> (k)) & 1) && lo <= (k) && (k) < hi)
#define SEAM(k) do { if ((k) + 1 < hi) { if ((k) == 0) grid.sync(); else xcd_barrier(xbar); } } while (0)

    if (IN(0)) for (int rep_ = 0; rep_ < REP_P0; ++rep_) {
        LAS float* scr = (LAS float*)(lds + wave * 16384);
        constexpr int I_GU = (D_MODEL / 64) * (2 * D_FF / 32), I_D = (D_FF / 64) * (D_MODEL / 32), I_IN = (D_MODEL / 64) * (D_IN / 32), I_OUT = (D_MODEL / 64) * (D_MODEL / 32);
        constexpr int NITEMS = 2 * I_GU + 2 * I_D + I_IN + I_OUT;
        for (int it = gw; it < NITEMS; it += ngw) {
            int r = it;
            if (r < I_GU) { transpose_item<true>(w_ffn1_gu, D_MODEL, 2 * D_FF, Wgu1, scr, r, lane, g_ffn1_pre); continue; } r -= I_GU;
            if (r < I_GU) { transpose_item<true>(w_ffn2_gu, D_MODEL, 2 * D_FF, Wgu2, scr, r, lane, g_ffn2_pre); continue; } r -= I_GU;
            if (r < I_D) { transpose_item<false>(w_ffn1_down, D_FF, D_MODEL, Wd1, scr, r, lane, nullptr); continue; } r -= I_D;
            if (r < I_D) { transpose_item<false>(w_ffn2_down, D_FF, D_MODEL, Wd2, scr, r, lane, nullptr); continue; } r -= I_D;
            if (r < I_IN) { transpose_item<false>(w_in, D_MODEL, D_IN, Win, scr, r, lane, g_mix_pre); continue; } r -= I_IN;
            transpose_item<false>(w_out, D_MODEL, D_MODEL, Wout, scr, r, lane, nullptr);
        }
        rowpass<false, true, false, false>(gw, ngw, lane, x_prompt, xs_off, nullptr, nullptr, nullptr, nullptr, 0.f, nullptr, nullptr, RS, XN);
        if (rep_ == 0 && bx == 0) { for (int i = tid; i < 4096; i += NTHREADS) ((unsigned*)(ws + WS_BAR))[i] = 0u; }
        SEAM(0);
        if (rep_ == 0) xbar = xcd_barrier_post((unsigned*)(ws + WS_BAR));
    }
    if (IN(1)) for (int rep_ = 0; rep_ < REP_P1; ++rep_) {
        pg8::Gemm g{XN, Wgu1, M_TOT, 2 * D_FF, D_MODEL}; pg8::StaticOrder S; S.init(M_TOT, 2 * D_FF, G, bx);
        pg8::EpiSwiglu E{ACT, D_FF, RS};
        pg8::gemm_phase<pg8::EpiSwiglu, pg8::StaticOrder, PG8_ALIGN, PG8_SP2>(lds, g, S, E);
        SEAM(1);
    }
    if (IN(2)) for (int rep_ = 0; rep_ < REP_P2; ++rep_) {
        pg8::Gemm g{ACT, Wd1, M_TOT, D_MODEL, D_FF}; pg8::StaticOrder S; S.init(M_TOT, D_MODEL, G, bx);
        pg8::EpiT E{T, D_MODEL, PART};
        pg8::gemm_phase<pg8::EpiT, pg8::StaticOrder, PG8_ALIGN, PG8_SP2>(lds, g, S, E);
        SEAM(2);
    }
#ifdef PROBE_SYNCS
    for (int i_ = 0; i_ < PROBE_SYNCS; ++i_) grid.sync();
#endif
    if (IN(3)) for (int rep_ = 0; rep_ < REP_P3; ++rep_) {
        rowpass<true, true, false, true>(gw, ngw, lane, x_prompt, xs_off, nullptr, T, PART, g_ffn1_post, 0.5f, nullptr, H, RS, nullptr);
        SEAM(3);
    }
    if (IN(4)) for (int rep_ = 0; rep_ < REP_P4; ++rep_) {
        pg8::Gemm g{H, Win, M_TOT, D_IN, D_MODEL}; pg8::StaticOrder S; S.init(M_TOT, D_IN, G, bx);
        pg8::EpiProj E{(bf16*)(ws + WS_QDA), (bf16*)(ws + WS_KDA), (bf16*)(ws + WS_VTDA), (bf16*)(ws + WS_QSW), (bf16*)(ws + WS_KSW), (bf16*)(ws + WS_VTSW), QSCALE, lds + 131072, RS};
        pg8::gemm_phase<pg8::EpiProj, pg8::StaticOrder, PG8_ALIGN, PG8_SP2>(lds, g, S, E);
#ifdef PROBE_DUP_P4
        grid.sync();
        pg8::gemm_phase<pg8::EpiProj, pg8::StaticOrder, PG8_ALIGN, PG8_SP2>(lds, g, S, E);
#endif
        SEAM(4);
    }
    if (IN(5)) for (int rep_ = 0; rep_ < REP_P5; ++rep_) {
        AttnP P{(const bf16*)(ws + WS_QDA), (const bf16*)(ws + WS_KDA), (const bf16*)(ws + WS_VTDA), (const bf16*)(ws + WS_QSW), (const bf16*)(ws + WS_KSW), (const bf16*)(ws + WS_VTSW), XN, rel_bias, g_subln, sink, (float*)(ws + WS_T)};
        attn_phase(lds, P, vcu, G, lq1, lk1, lq2, lk2);
        SEAM(5);
    }
    if (IN(6)) for (int rep_ = 0; rep_ < REP_P6; ++rep_) {
        pg8::Gemm g{XN, Wout, M_TOT, D_MODEL, D_MODEL}; pg8::StaticOrder S; S.init(M_TOT, D_MODEL, G, bx);
        pg8::EpiT E{T, D_MODEL, PART};
        pg8::gemm_phase<pg8::EpiT, pg8::StaticOrder, PG8_ALIGN, PG8_SP2>(lds, g, S, E);
        SEAM(6);
    }
    if (IN(7)) for (int rep_ = 0; rep_ < REP_P7; ++rep_) {
        rowpass<true, true, true, true>(gw, ngw, lane, nullptr, nullptr, H, T, PART, g_mix_post, 1.0f, nullptr, H, RS, nullptr);
        SEAM(7);
    }
    if (IN(8)) for (int rep_ = 0; rep_ < REP_P8; ++rep_) {
        pg8::Gemm g{H, Wgu2, M_TOT, 2 * D_FF, D_MODEL}; pg8::StaticOrder S; S.init(M_TOT, 2 * D_FF, G, bx);
        pg8::EpiSwiglu E{ACT, D_FF, RS};
        pg8::gemm_phase<pg8::EpiSwiglu, pg8::StaticOrder, PG8_ALIGN, PG8_SP2>(lds, g, S, E);
        SEAM(8);
    }
    if (IN(9)) for (int rep_ = 0; rep_ < REP_P9; ++rep_) {
        pg8::Gemm g{ACT, Wd2, M_TOT, D_MODEL, D_FF}; pg8::StaticOrder S; S.init(M_TOT, D_MODEL, G, bx);
        pg8::EpiT E{T, D_MODEL, PART};
        pg8::gemm_phase<pg8::EpiT, pg8::StaticOrder, PG8_ALIGN, PG8_SP2>(lds, g, S, E);
        SEAM(9);
    }
    if (IN(10)) for (int rep_ = 0; rep_ < REP_P10; ++rep_) {
        rowpass<true, false, true, false>(gw, ngw, lane, nullptr, nullptr, H, T, PART, g_ffn2_post, 0.5f, out, nullptr, nullptr, nullptr);
    }
#undef IN
#undef SEAM
}

#ifndef MK_MULTI_LAUNCH
#define MK_MULTI_LAUNCH 0
#endif
extern "C" void kernel_launch(void* const* d_in, const int* in_sizes, int n_in, void* d_out, int out_size, void* d_ws, size_t ws_size, hipStream_t stream) {
    static int grid = 0;
    if (grid == 0) {
        if (n_in != 21 || out_size != M_TOT * D_MODEL || ws_size < WS_END) { fprintf(stderr, "kernel_launch: unexpected shapes (n_in %d, out %d, ws %zu)\n", n_in, out_size, ws_size); grid = -1; return; }
        int dev = 0, cus = 0, per_cu = 0;
        hipGetDevice(&dev);
        hipDeviceGetAttribute(&cus, hipDeviceAttributeMultiprocessorCount, dev);
        if (hipFuncSetAttribute((const void*)mega_fwd, hipFuncAttributeMaxDynamicSharedMemorySize, LDS_BYTES) != hipSuccess) { fprintf(stderr, "kernel_launch: hipFuncSetAttribute failed\n"); grid = -1; return; }
        if (hipOccupancyMaxActiveBlocksPerMultiprocessor(&per_cu, (const void*)mega_fwd, NTHREADS, LDS_BYTES) != hipSuccess || per_cu < 1) { fprintf(stderr, "kernel_launch: occupancy query gave %d\n", per_cu); per_cu = 1; }
        (void)hipGetLastError();
        grid = cus * per_cu;
    }
    if (grid < 0) return;
    Args a{};
    for (int i = 0; i < 21; ++i) a.in[i] = (const float*)d_in[i];
    a.out = (float*)d_out; a.ws = (unsigned char*)d_ws;
#if MK_MULTI_LAUNCH
    for (int p = 0; p < N_PHASES; ++p) {
        a.ph_lo = p; a.ph_hi = p + 1;
        hipLaunchKernelGGL(mega_fwd, dim3(grid), dim3(NTHREADS), LDS_BYTES, stream, a);
    }
#else
    a.ph_lo = 0; a.ph_hi = N_PHASES;
    void* kargs[] = {&a};
    hipError_t e = hipLaunchCooperativeKernel((const void*)mega_fwd, dim3(grid), dim3(NTHREADS), kargs, LDS_BYTES, stream);
    if (e != hipSuccess) fprintf(stderr, "cooperative launch failed: %s (grid %d)\n", hipGetErrorString(e), grid);
#endif
}
```

```cpp
#include <hip/hip_runtime.h>
#include <hip/hip_cooperative_groups.h>
#include <cstdio>
#include <cstdint>
#include <cmath>
namespace cg = cooperative_groups;
#define MK_MULTI_LAUNCH 0
namespace pg8 {
#define PG8_LAS __attribute__((address_space(3)))
typedef unsigned short bf16_t;
typedef short bf16x8 __attribute__((ext_vector_type(8)));
typedef float f32x4 __attribute__((ext_vector_type(4)));
typedef unsigned u32x4 __attribute__((ext_vector_type(4)));
constexpr int BM = 256, BK = 64, HALF = 128, HTB = HALF * BK * 2  , STAGE_BYTES = 8 * HTB, NXCD = 8, WGM = 8;

__host__ __device__ __forceinline__ int lds_byte(int r, int c) { const int st = (r >> 4) * 2 + (c >> 5), rr = r & 15, cc = c & 31, ob = rr * 64 + cc * 2; return st * 1024 + (ob ^ (((ob >> 9) & 1) << 5)); }
__host__ __device__ __forceinline__ void stage_rc(int b, int& R, int& C) { const int st = b / 1024, sb = b % 1024, swz = sb ^ (((sb >> 9) & 1) << 5); R = (st >> 1) * 16 + swz / 64; C = (st & 1) * 32 + (swz % 64) / 2; }
__host__ __device__ __forceinline__ int perm32(int rho) { const int n = rho >> 4, i = rho & 15; return 8 * (i >> 2) + 4 * n + (i & 3); }

struct Unit { int pm, pn; };
struct Gemm { const bf16_t* A; const bf16_t* Bt; int M, N, K; };

struct StaticOrder {
    int nM, nN, nwg, G, c, rev;
    __host__ __device__ void init(int M, int N, int G_, int c_, int rev_ = 0) { nM = M / BM; nN = N / BM; nwg = nM * nN; G = G_; c = c_; rev = rev_; }
    __host__ __device__ bool next(int i, Unit& u) const {
        const long L = (long)i * G + c; if (L >= nwg) return false;
        int wgid = (int)L; { const int q = nwg / NXCD, r = nwg % NXCD, xcd = wgid % NXCD, off = wgid / NXCD; wgid = (xcd < r ? xcd * (q + 1) : r * (q + 1) + (xcd - r) * q) + off; }
        const int nig = WGM * nN, gid = wgid / nig, fm = gid * WGM, gsz = (nM - fm) < WGM ? (nM - fm) : WGM;
        u.pm = fm + ((wgid % nig) % gsz); u.pn = (wgid % nig) / gsz; if (rev) u.pm = nM - 1 - u.pm; return true;
    }
    __device__ __forceinline__ void a_ready(const Unit&) const {}
    __device__ __forceinline__ void done(const Unit&) const {}
};
__device__ __forceinline__ unsigned cvt_pk_bf16(float lo, float hi) { unsigned r; asm volatile("v_cvt_pk_bf16_f32 %0, %1, %2" : "=v"(r) : "v"(lo), "v"(hi)); return r; }
typedef unsigned u32x2 __attribute__((ext_vector_type(2)));
__device__ __forceinline__ float silu_mul(float g, float u) {
    const float e = __builtin_amdgcn_exp2f(g * -1.4426950408889634f);
    return g * __builtin_amdgcn_rcpf(1.0f + e) * u;
}
struct EpiSwiglu {
    static constexpr bool PERM = true, AFTER_DRAIN = false;
    bf16_t* O; int ldc; const float* rs;
    __device__ __forceinline__ void operator()(const f32x4 (&acc)[2][2][4][2], const Unit& u, int wr, int wc, int fr, int fq) const {
        const int row0 = u.pm * BM + wr * 64 + fr, col0 = u.pn * HALF + wc * 32 + 8 * fq;
#pragma unroll
        for (int ai = 0; ai < 2; ++ai)
#pragma unroll
            for (int m = 0; m < 4; ++m) {
                bf16_t* rowp = O + (size_t)(row0 + ai * HALF + m * 16) * ldc + col0;
                const float r = rs[row0 + ai * HALF + m * 16];
                const f32x4 g0 = acc[ai][0][m][0] * r, g1 = acc[ai][0][m][1] * r, u0 = acc[ai][1][m][0] * r, u1 = acc[ai][1][m][1] * r;
                u32x4 w;
                w.x = cvt_pk_bf16(silu_mul(g0[0], u0[0]), silu_mul(g0[1], u0[1]));
                w.y = cvt_pk_bf16(silu_mul(g0[2], u0[2]), silu_mul(g0[3], u0[3]));
                w.z = cvt_pk_bf16(silu_mul(g1[0], u1[0]), silu_mul(g1[1], u1[1]));
                w.w = cvt_pk_bf16(silu_mul(g1[2], u1[2]), silu_mul(g1[3], u1[3]));
                *(u32x4*)rowp = w;
            }
    }
};
struct EpiT {
    static constexpr bool PERM = true, AFTER_DRAIN = false;
    bf16_t* O; int ldc; float* part;
    __device__ __forceinline__ void operator()(const f32x4 (&acc)[2][2][4][2], const Unit& u, int wr, int wc, int fr, int fq) const {
        const int row0 = u.pm * BM + wr * 64 + fr, col0 = u.pn * BM + wc * 32 + 8 * fq;
#pragma unroll
        for (int ai = 0; ai < 2; ++ai)
#pragma unroll
            for (int m = 0; m < 4; ++m) {
                const int row = row0 + ai * HALF + m * 16;
                bf16_t* rowp = O + (size_t)row * ldc + col0;
                float ss = 0.f;
#pragma unroll
                for (int bj = 0; bj < 2; ++bj) {
                    const f32x4 v0 = acc[ai][bj][m][0], v1 = acc[ai][bj][m][1];
                    ss += (v0[0] * v0[0] + v0[1] * v0[1]) + (v0[2] * v0[2] + v0[3] * v0[3]) + (v1[0] * v1[0] + v1[1] * v1[1]) + (v1[2] * v1[2] + v1[3] * v1[3]);
                    u32x4 w; w.x = cvt_pk_bf16(v0[0], v0[1]); w.y = cvt_pk_bf16(v0[2], v0[3]); w.z = cvt_pk_bf16(v1[0], v1[1]); w.w = cvt_pk_bf16(v1[2], v1[3]);
                    *(u32x4*)(rowp + bj * HALF) = w;
                }
                ss += __shfl_xor(ss, 16); ss += __shfl_xor(ss, 32);
                if (fq == 0) part[(size_t)row * 32 + u.pn * 4 + wc] = ss;
            }
    }
};
struct EpiProj {
    static constexpr bool PERM = true, AFTER_DRAIN = false;
    bf16_t *Qda, *Kda, *VTda, *Qsw, *Ksw, *VTsw; float qscale; PG8_LAS unsigned char* epi_lds; const float* rs;
    __device__ __forceinline__ void operator()(const f32x4 (&acc)[2][2][4][2], const Unit& u, int wr, int wc, int fr, int fq) const {
        const int pn = u.pn;
        const int row0 = u.pm * BM + wr * 64 + fr;
        const int trow = u.pm * BM;
        int S, seqbase;
        if (trow < 32768) { S = 2048; seqbase = trow & ~2047; } else { S = 4096; seqbase = 32768 + ((trow - 32768) & ~4095); }
        const int s0 = row0 - seqbase;
        if (pn < 8 || (pn >= 12 && pn < 17)) {
            bf16_t* base; int colt; float sc = 1.f;
            if (pn < 4) { base = Qda + (size_t)seqbase * 1024; colt = pn * BM; sc = qscale; }
            else if (pn < 8) { base = Kda + (size_t)seqbase * 1024; colt = (pn - 4) * BM; }
            else if (pn < 16) { base = Qsw + (size_t)seqbase * 1024; colt = (pn - 12) * BM; sc = qscale; }
            else { base = Ksw + (size_t)seqbase * 256; colt = 0; }
            const int d0 = (wc & 1) * 32 + 8 * fq;
#pragma unroll
            for (int bj = 0; bj < 2; ++bj) {
                bf16_t* hb = base + (size_t)((colt >> 6) + bj * 2 + (wc >> 1)) * 64 * S + d0;
#pragma unroll
                for (int ai = 0; ai < 2; ++ai)
#pragma unroll
                    for (int m = 0; m < 4; ++m) {
                        const float r = rs[row0 + ai * HALF + m * 16] * sc;
                        const f32x4 v0 = acc[ai][bj][m][0] * r, v1 = acc[ai][bj][m][1] * r;
                        u32x4 w; w.x = cvt_pk_bf16(v0[0], v0[1]); w.y = cvt_pk_bf16(v0[2], v0[3]); w.z = cvt_pk_bf16(v1[0], v1[1]); w.w = cvt_pk_bf16(v1[2], v1[3]);
                        *(u32x4*)(hb + (size_t)(s0 + ai * HALF + m * 16) * 64) = w;
                    }
            }
        } else {
            bf16_t* base; int colt, dvh;
            if (pn < 12) { base = VTda + (size_t)seqbase * 1024; colt = (pn - 8) * BM; dvh = 128; } else { base = VTsw + (size_t)seqbase * 256; colt = 0; dvh = 64; }
            const int lane = fq * 16 + fr;
            PG8_LAS unsigned char* wl = epi_lds + (wr * 4 + wc) * 4096;
            const int stw = (u.pm * BM + wr * 64 - seqbase) >> 6;
#pragma unroll
            for (int ai = 0; ai < 2; ++ai)
#pragma unroll
                for (int bj = 0; bj < 2; ++bj) {
#pragma unroll
                    for (int m = 0; m < 4; ++m)
#pragma unroll
                        for (int n = 0; n < 2; ++n) {
                            const f32x4 v = acc[ai][bj][m][n] * rs[row0 + ai * HALF + m * 16];
                            const unsigned p01 = cvt_pk_bf16(v[0], v[1]), p23 = cvt_pk_bf16(v[2], v[3]);
                            const int token = m * 16 + fr, d = 8 * fq + 4 * n;
                            PG8_LAS unsigned char* wp = wl + d * 128 + (((token >> 3) ^ fq) << 4) + (token & 7) * 2;
                            *(PG8_LAS bf16_t*)(wp) = (bf16_t)(p01 & 0xffffu); *(PG8_LAS bf16_t*)(wp + 128) = (bf16_t)(p01 >> 16);
                            *(PG8_LAS bf16_t*)(wp + 256) = (bf16_t)(p23 & 0xffffu); *(PG8_LAS bf16_t*)(wp + 384) = (bf16_t)(p23 >> 16);
                        }
                    const int c0 = colt + bj * HALF + wc * 32, h = (dvh == 128) ? (c0 >> 7) : (c0 >> 6), dd0 = c0 & (dvh - 1);
                    bf16_t* blk = base + (size_t)h * dvh * S + (size_t)(stw + 2 * ai) * (dvh * 64) + dd0 * 64;
#pragma unroll
                    for (int i = 0; i < 4; ++i) {
                        const int q = lane + 64 * i, d = q >> 3, c = q & 7;
                        const u32x4 w = *(const PG8_LAS u32x4*)(wl + d * 128 + ((c ^ ((d >> 3) & 7)) << 4));
                        *(u32x4*)(blk + q * 8) = w;
                    }
                }
        }
    }
};
template <class Epi, class Sched, bool ALIGN_EPI = false, bool SP2 = false>
__device__ __forceinline__ void gemm_phase(PG8_LAS unsigned char* lds, const Gemm g, const Sched& S, const Epi& E) {
    const int tid = threadIdx.x, wid = __builtin_amdgcn_readfirstlane(tid >> 6), lane = tid & 63, wr = wid >> 2, wc = wid & 3, fr = lane & 15, fq = lane >> 4;
    const int K = g.K, nt = K / BK;
    unsigned voffA[2], voffB[2];
#pragma unroll
    for (int i = 0; i < 2; ++i) { int R, C; stage_rc(tid * 16 + i * 8192, R, C); const int Rb = Epi::PERM ? ((R & ~31) + perm32(R & 31)) : R;
        voffA[i] = (unsigned)(R * K + C) * 2u; voffB[i] = (unsigned)(Rb * K + C) * 2u; }
    const size_t kstep = (size_t)(BK * 2);
    const size_t hstep = (size_t)HALF * K * 2;
    const size_t tstep = 2 * hstep;
    const unsigned ldsw = (unsigned)wid * 1024u;
    const int aoff = lds_byte(wr * 64 + fr, fq * 8), boff = lds_byte(wc * 32 + fr, fq * 8);
#define PG8_SA(b, h) (((b) * 2 + (h)) * HTB)
#define PG8_SB(b, h) ((4 + (b) * 2 + (h)) * HTB)
#define PG8_STAGE(bufoff, gbase, voff) do { _Pragma("unroll") for (int _i = 0; _i < 2; ++_i) \
        __builtin_amdgcn_global_load_lds((const unsigned*)((const char*)(gbase) + (voff)[_i]), (PG8_LAS unsigned*)(lds + (bufoff) + ldsw + _i * 8192), 16, 0, 0); } while (0)
#define PG8_LDA(dst, b, h) do { _Pragma("unroll") for (int m = 0; m < 4; ++m) _Pragma("unroll") for (int k = 0; k < 2; ++k) dst[m][k] = *(const PG8_LAS bf16x8*)(lds + PG8_SA(b, h) + aoff + m * 2048 + k * 1024); } while (0)
#define PG8_LDB(dst, b, h) do { _Pragma("unroll") for (int n = 0; n < 2; ++n) _Pragma("unroll") for (int k = 0; k < 2; ++k) dst[n][k] = *(const PG8_LAS bf16x8*)(lds + PG8_SB(b, h) + boff + n * 2048 + k * 1024); } while (0)
#define PG8_MMA(ai, bj, At, Bt) do { __builtin_amdgcn_s_setprio(1); _Pragma("unroll") for (int m = 0; m < 4; ++m) _Pragma("unroll") for (int n = 0; n < 2; ++n) _Pragma("unroll") for (int k = 0; k < 2; ++k) \
        acc[ai][bj][m][n] = __builtin_amdgcn_mfma_f32_16x16x32_bf16(Bt[n][k], At[m][k], acc[ai][bj][m][n], 0, 0, 0); __builtin_amdgcn_s_setprio(0); } while (0)
#define PG8_WAIT_V(n) asm volatile("s_waitcnt vmcnt(" #n ")" ::: "memory")
#define PG8_WAIT_L(n) asm volatile("s_waitcnt lgkmcnt(" #n ")" ::: "memory")
#define PG8_BAR __builtin_amdgcn_s_barrier()
#define PG8_SCHED __builtin_amdgcn_sched_barrier(0)
    Unit cur, nxt; int ui = 0;
    if (!S.next(0, cur)) return;
    f32x4 acc[2][2][4][2];
#pragma unroll
    for (int a = 0; a < 2; ++a)
#pragma unroll
        for (int b = 0; b < 2; ++b)
#pragma unroll
            for (int m = 0; m < 4; ++m)
#pragma unroll
                for (int n = 0; n < 2; ++n) acc[a][b][m][n] = (f32x4){0.f, 0.f, 0.f, 0.f};
    bf16x8 At[4][2], B0[2][2], B1[2][2];
    const char* cA = (const char*)g.A + (size_t)cur.pm * tstep; const char* cB = (const char*)g.Bt + (size_t)cur.pn * tstep;
    S.a_ready(cur);
    if constexpr (SP2) {
        PG8_STAGE(PG8_SB(0, 0), cB, voffB); PG8_STAGE(PG8_SB(0, 1), cB + hstep, voffB); PG8_STAGE(PG8_SA(0, 0), cA, voffA); PG8_STAGE(PG8_SA(0, 1), cA + hstep, voffA);
        if (wr == 1) PG8_BAR;
        PG8_WAIT_V(2); PG8_BAR;
        PG8_STAGE(PG8_SB(1, 0), cB + kstep, voffB); PG8_STAGE(PG8_SA(1, 0), cA + kstep, voffA); PG8_STAGE(PG8_SB(1, 1), cB + hstep + kstep, voffB);
        PG8_WAIT_V(6); PG8_BAR;
    } else {
        PG8_STAGE(PG8_SB(0, 0), cB, voffB); PG8_STAGE(PG8_SA(0, 0), cA, voffA); PG8_STAGE(PG8_SB(0, 1), cB + hstep, voffB); PG8_STAGE(PG8_SA(0, 1), cA + hstep, voffA);
        if (wr == 1) PG8_BAR;
        PG8_WAIT_V(4); PG8_BAR;
        PG8_STAGE(PG8_SB(1, 0), cB + kstep, voffB); PG8_STAGE(PG8_SA(1, 0), cA + kstep, voffA); PG8_STAGE(PG8_SB(1, 1), cB + hstep + kstep, voffB);
        PG8_WAIT_V(6); PG8_BAR;
    }
    for (;;) {
        const bool has_next = S.next(ui + 1, nxt);
        const char* nA = has_next ? (const char*)g.A + (size_t)nxt.pm * tstep : cA; const char* nB = has_next ? (const char*)g.Bt + (size_t)nxt.pn * tstep : cB;
        for (int t = 0; t < nt; t += 2) {
            const bool last = (t == nt - 2);
            const char* a1 = cA + (size_t)(t + 1) * kstep;
            const char* a2 = last ? nA : cA + (size_t)(t + 2) * kstep; const char* b2 = last ? nB : cB + (size_t)(t + 2) * kstep;
            const char* a3 = a2 + kstep; const char* b3 = b2 + kstep;
            if (last && has_next) S.a_ready(nxt);
            if constexpr (SP2) {
            PG8_LDB(B0, 0, 0); PG8_LDB(B1, 0, 1); PG8_SCHED; PG8_LDA(At, 0, 0); PG8_STAGE(PG8_SA(1, 1), a1 + hstep, voffA);
            PG8_WAIT_V(8); PG8_WAIT_L(0); PG8_BAR; PG8_MMA(0, 0, At, B0); PG8_MMA(0, 1, At, B1); PG8_BAR; PG8_SCHED;
            PG8_LDA(At, 0, 1); PG8_STAGE(PG8_SB(0, 0), b2, voffB); PG8_STAGE(PG8_SB(0, 1), b2 + hstep, voffB); PG8_STAGE(PG8_SA(0, 0), a2, voffA);
            PG8_WAIT_V(8); PG8_WAIT_L(0); PG8_BAR; PG8_MMA(1, 0, At, B0); PG8_MMA(1, 1, At, B1); PG8_BAR; PG8_SCHED;
            PG8_LDB(B0, 1, 0); PG8_LDB(B1, 1, 1); PG8_SCHED; PG8_LDA(At, 1, 0); PG8_STAGE(PG8_SA(0, 1), a2 + hstep, voffA);
            PG8_WAIT_V(8); PG8_WAIT_L(0); PG8_BAR; PG8_MMA(0, 0, At, B0); PG8_MMA(0, 1, At, B1); PG8_BAR; PG8_SCHED;
            PG8_LDA(At, 1, 1); PG8_STAGE(PG8_SB(1, 0), b3, voffB); PG8_STAGE(PG8_SB(1, 1), b3 + hstep, voffB); PG8_STAGE(PG8_SA(1, 0), a3, voffA);
            PG8_WAIT_V(8); PG8_WAIT_L(0); PG8_BAR; PG8_MMA(1, 0, At, B0); PG8_MMA(1, 1, At, B1); PG8_BAR; PG8_SCHED;
            } else {
            PG8_LDB(B0, 0, 0); PG8_SCHED; PG8_LDA(At, 0, 0); PG8_STAGE(PG8_SA(1, 1), a1 + hstep, voffA);
            PG8_WAIT_L(8); PG8_BAR; PG8_WAIT_L(0); PG8_MMA(0, 0, At, B0); PG8_BAR; PG8_SCHED;
            PG8_LDB(B1, 0, 1); PG8_STAGE(PG8_SB(0, 0), b2, voffB);
            PG8_BAR; PG8_WAIT_L(0); PG8_MMA(0, 1, At, B1); PG8_BAR;
            PG8_LDA(At, 0, 1); PG8_STAGE(PG8_SA(0, 0), a2, voffA);
            PG8_BAR; PG8_WAIT_L(0); PG8_MMA(1, 0, At, B0); PG8_BAR; PG8_SCHED;
            PG8_STAGE(PG8_SB(0, 1), b2 + hstep, voffB);
            PG8_WAIT_V(6); PG8_BAR; PG8_MMA(1, 1, At, B1); PG8_BAR;
            PG8_LDB(B0, 1, 0); PG8_SCHED; PG8_LDA(At, 1, 0); PG8_STAGE(PG8_SA(0, 1), a2 + hstep, voffA);
            PG8_WAIT_L(8); PG8_BAR; PG8_WAIT_L(0); PG8_MMA(0, 0, At, B0); PG8_BAR; PG8_SCHED;
            PG8_LDB(B1, 1, 1); PG8_STAGE(PG8_SB(1, 0), b3, voffB);
            PG8_BAR; PG8_WAIT_L(0); PG8_MMA(0, 1, At, B1); PG8_BAR;
            PG8_LDA(At, 1, 1); PG8_STAGE(PG8_SA(1, 0), a3, voffA);
            PG8_BAR; PG8_WAIT_L(0); PG8_MMA(1, 0, At, B0); PG8_BAR; PG8_SCHED;
            PG8_STAGE(PG8_SB(1, 1), b3 + hstep, voffB);
            PG8_WAIT_V(6); PG8_BAR; PG8_MMA(1, 1, At, B1); PG8_BAR;
            }
        }
        if constexpr (ALIGN_EPI) { if (wr == 0) PG8_BAR; }
        if constexpr (!Epi::AFTER_DRAIN) { E(acc, cur, wr, wc, fr, fq); S.done(cur); }
        if (!has_next) break;
#pragma unroll
        for (int a = 0; a < 2; ++a)
#pragma unroll
            for (int b = 0; b < 2; ++b)
#pragma unroll
                for (int m = 0; m < 4; ++m)
#pragma unroll
                    for (int n = 0; n < 2; ++n) acc[a][b][m][n] = (f32x4){0.f, 0.f, 0.f, 0.f};
        cur = nxt; cA = nA; cB = nB; ++ui;
        if constexpr (ALIGN_EPI) { if (wr == 1) PG8_BAR; }
    }
    PG8_WAIT_V(0);
    if constexpr (!ALIGN_EPI) { if (wr == 0) PG8_BAR; }
    PG8_BAR;
    if constexpr (Epi::AFTER_DRAIN) { E.fused(acc, cur, wr, wc, fr, fq, lds, wid, lane); S.done(cur); }
#undef PG8_SA
#undef PG8_SB
#undef PG8_STAGE
#undef PG8_LDA
#undef PG8_LDB
#undef PG8_MMA
#undef PG8_WAIT_V
#undef PG8_WAIT_L
#undef PG8_BAR
#undef PG8_SCHED
}
}

#ifndef PG8_SP2
#define PG8_SP2 true
#endif
#ifndef PG8_ALIGN
#define PG8_ALIGN true
#endif
constexpr int D_MODEL = 2048, D_FF = 5632, D_IN = 4608;
constexpr int M_P = 16 * 2048, M_TOT = 65536;
constexpr float EPS = 1e-6f;
constexpr float LOG2E = 1.4426950408889634f;
constexpr float QSCALE = 0.125f * LOG2E;
constexpr float LAMBDA_INIT = 0.2f;
constexpr int NWAVES = 8, NTHREADS = 512;
constexpr int LDS_BYTES = 163840;

#define LAS __attribute__((address_space(3)))
typedef unsigned short bf16;
typedef short bf16x8 __attribute__((ext_vector_type(8)));
typedef float f32x16 __attribute__((ext_vector_type(16)));
typedef float f32x4 __attribute__((ext_vector_type(4)));
typedef unsigned u32x4 __attribute__((ext_vector_type(4)));
typedef unsigned u32x2 __attribute__((ext_vector_type(2)));
typedef float f32x2_t __attribute__((ext_vector_type(2)));
typedef __bf16 bf16x2_t __attribute__((ext_vector_type(2)));

constexpr size_t MiB = 1u << 20;
constexpr size_t WS_WGU1 = 0, WS_WD1 = 44 * MiB, WS_WIN = 66 * MiB, WS_WOUT = 84 * MiB, WS_WGU2 = 92 * MiB, WS_WD2 = 136 * MiB;
constexpr size_t WS_RS = 158 * MiB;
constexpr size_t WS_BAR = 159 * MiB;
constexpr size_t WS_PART = 160 * MiB;
constexpr size_t WS_XN = 168 * MiB;
constexpr size_t WS_T = 424 * MiB;
constexpr size_t WS_ACT = 680 * MiB;
constexpr size_t WS_QDA = WS_ACT, WS_KDA = WS_ACT + 128 * MiB, WS_VTDA = WS_ACT + 256 * MiB, WS_QSW = WS_ACT + 384 * MiB, WS_KSW = WS_ACT + 512 * MiB, WS_VTSW = WS_ACT + 544 * MiB;
constexpr size_t WS_H = WS_ACT + 704 * MiB;
constexpr size_t WS_END = WS_H + 256 * MiB;

__device__ __forceinline__ unsigned cvtpk(float lo, float hi) { f32x2_t v = {lo, hi}; bf16x2_t b = __builtin_convertvector(v, bf16x2_t); return __builtin_bit_cast(unsigned, b); }
__device__ __forceinline__ float hmax(float v) { auto rr = __builtin_amdgcn_permlane32_swap(__float_as_uint(v), __float_as_uint(v), false, false); return fmaxf(__uint_as_float(rr[0]), __uint_as_float(rr[1])); }
__device__ __forceinline__ float hsum(float v) { auto rr = __builtin_amdgcn_permlane32_swap(__float_as_uint(v), __float_as_uint(v), false, false); return __uint_as_float(rr[0]) + __uint_as_float(rr[1]); }
__device__ __forceinline__ float wave_sum(float v) {
#pragma unroll
    for (int o = 1; o < 64; o <<= 1) v += __shfl_xor(v, o);
    return v;
}
__device__ __forceinline__ float bf_lo(unsigned w) { return __uint_as_float(w << 16); }
__device__ __forceinline__ float bf_hi(unsigned w) { return __uint_as_float(w & 0xffff0000u); }

constexpr int A_K = 0, A_V = 32768, A_BT = 114688, A_G = 115968;

__device__ __forceinline__ int t5_bucket(int rp) {
    const int n = rp < 0 ? -rp : rp;
    int b;
    if (n < 8) b = n; else if (n < 12) b = 8; else if (n < 16) b = 9; else if (n < 23) b = 10; else if (n < 32) b = 11; else if (n < 46) b = 12; else if (n < 64) b = 13; else if (n < 91) b = 14; else b = 15;
    return b + (rp > 0 ? 16 : 0);
}

__device__ __forceinline__ float max3f(float a, float b, float c) { float r; asm("v_max3_f32 %0, %1, %2, %3" : "=v"(r) : "v"(a), "v"(b), "v"(c)); return r; }
#define SBAR() __builtin_amdgcn_sched_barrier(0)
__device__ __forceinline__ void v_reads(bf16x8 (&vf)[4], LAS unsigned char* lds, const unsigned (&vaddr)[4], unsigned off) {
#pragma unroll
    for (int c4 = 0; c4 < 4; ++c4) vf[c4] = *(const LAS bf16x8*)(lds + vaddr[c4] + off);
}
__device__ __forceinline__ void pv_mma(f32x16& o, const bf16x8 (&vf)[4], const bf16x8 (&p)[4]) {
#pragma unroll
    for (int c4 = 0; c4 < 4; ++c4) o = __builtin_amdgcn_mfma_f32_32x32x16_bf16(vf[c4], p[c4], o, 0, 0, 0);
}
template <int DV>
__device__ __forceinline__ void pv_rest(f32x16 (&o)[DV / 32], const bf16x8 (&p)[4], bf16x8 (&va)[4], bf16x8 (&vb)[4], LAS unsigned char* lds, const unsigned (&vaddr)[4], unsigned vb_) {
    if (DV == 128) {
        pv_mma(o[0], va, p); v_reads(va, lds, vaddr, vb_ + 2 * 4096); SBAR();
        pv_mma(o[1], vb, p); v_reads(vb, lds, vaddr, vb_ + 3 * 4096); SBAR();
        pv_mma(o[2], va, p); SBAR();
        pv_mma(o[DV / 32 - 1], vb, p);
    } else {
        pv_mma(o[0], va, p); SBAR();
        pv_mma(o[1], vb, p);
    }
}
__device__ __forceinline__ void glds16(const void* gsrc, unsigned lds_dst) {
    unsigned keep;
    asm volatile("s_mov_b32 %0, m0\n\ts_mov_b32 m0, %2\n\ts_nop 0\n\tglobal_load_lds_dwordx4 %1, off\n\ts_mov_b32 m0, %0" : "=&s"(keep) : "v"(gsrc), "s"(lds_dst) : "memory");
}
constexpr int NKS = 4, NVS = 5, PFD = 3;
template <int DV, bool SW>
__device__ __forceinline__ void flash(LAS unsigned char* lds, const bf16* __restrict__ Qw, int qpitch, const bf16* __restrict__ Kb, int kpitch,
                                      const bf16* __restrict__ VTb, int S, int t_lo, int t_hi, int qpos_w, bool grpB, f32x16 (&o)[DV / 32], float& mref, float& lsum) {
    const int tid = threadIdx.x, lane = tid & 63, r32 = lane & 31, hi = lane >> 5;
    const int wid = __builtin_amdgcn_readfirstlane(tid >> 6);
    const LAS float* bt = (const LAS float*)(lds + A_BT);
    const unsigned lds0 = (unsigned)(uintptr_t)lds;
    bf16x8 qf[4];
#pragma unroll
    for (int d0 = 0; d0 < 4; ++d0) qf[d0] = *(const bf16x8*)(Qw + (size_t)r32 * qpitch + d0 * 16 + hi * 8);
    const int lrow = wid * 8 + (lane >> 3), pch = lane & 7, lch = pch ^ ((lrow >> 1) & 7);
    const int rho = lrow & 31, key = (lrow & 32) + 16 * ((rho >> 2) & 1) + 4 * (rho >> 3) + (rho & 3);
    const bf16* ksrc = Kb + key * 64 + lch * 8;
    const bf16* vsrc = VTb + lrow * 64 + lch * 8;
    const unsigned kdst = lds0 + A_K + wid * 1024, vdst = lds0 + A_V + wid * 1024;
    const int sw = (r32 >> 1) & 7;
    unsigned kaddr[4], vaddr[4];
#pragma unroll
    for (int d0 = 0; d0 < 4; ++d0) kaddr[d0] = A_K + r32 * 128 + (((2 * d0 + hi) ^ sw) << 4);
#pragma unroll
    for (int c4 = 0; c4 < 4; ++c4) vaddr[c4] = A_V + r32 * 128 + (((4 * (c4 >> 1) + 2 * hi + (c4 & 1)) ^ sw) << 4);
#define FL_ISSUE(tt, ks, vs) do { const int tc_ = min((tt), t_hi - 1); \
        glds16(ksrc + (size_t)tc_ * 4096, (unsigned)__builtin_amdgcn_readfirstlane(kdst + (ks) * 8192)); \
        _Pragma("unroll") for (int i_ = 0; i_ < DV / 64; ++i_) glds16(vsrc + (size_t)tc_ * (DV * 64) + i_ * 4096, (unsigned)__builtin_amdgcn_readfirstlane(vdst + (vs) * 16384 + i_ * 8192)); } while (0)
    FL_ISSUE(t_lo, 0, 0); FL_ISSUE(t_lo + 1, 1, 1); FL_ISSUE(t_lo + 2, 2, 2);
    asm volatile("" :: "v"(qf[0]), "v"(qf[1]), "v"(qf[2]), "v"(qf[3]));
    if (DV == 128) asm volatile("s_waitcnt vmcnt(6) lgkmcnt(0)\n\ts_barrier" ::: "memory"); else asm volatile("s_waitcnt vmcnt(4) lgkmcnt(0)\n\ts_barrier" ::: "memory");
    int ks_cur = 0, ks_iss = 3;
    int vs_prev = 4, vs_cur = 0, vs_iss = 3;
    int cls_cur = 0; float cb = 0.f;
    bf16x8 p[4];
    bool have_prev = false;
    for (int t = t_lo; t <= t_hi; ++t) {
        bool issued = false;
        if (grpB && have_prev) {
            bf16x8 va[4], vb[4];
            v_reads(va, lds, vaddr, (unsigned)vs_prev * 16384); v_reads(vb, lds, vaddr, (unsigned)vs_prev * 16384 + 4096); SBAR();
            pv_rest<DV>(o, p, va, vb, lds, vaddr, (unsigned)vs_prev * 16384);
        }
        const int kt = t * 64;
        bool active = (t < t_hi);
        if (SW) active = active && (kt + 63 >= qpos_w - 128) && (kt <= qpos_w + 31 + 128);
        if (active) {
            const unsigned kb_ = (unsigned)ks_cur * 8192;
            bf16x8 kf[8];
#pragma unroll
            for (int d0 = 0; d0 < 4; ++d0) { kf[2 * d0] = *(const LAS bf16x8*)(lds + kaddr[d0] + kb_); kf[2 * d0 + 1] = *(const LAS bf16x8*)(lds + kaddr[d0] + kb_ + 4096); }
            SBAR();
            const int rpmin = kt - (qpos_w + 31), rpmax = kt + 63 - qpos_w;
            const int cls = SW ? 0 : (rpmax <= -91 ? 1 : (rpmin >= 91 ? 2 : 0));
            if (cls != cls_cur) { cls_cur = cls; cb = (cls == 0) ? 0.f : (cls == 1 ? bt[0] : bt[258]); }
            f32x16 s0, s1;
            s0 = __builtin_amdgcn_mfma_f32_32x32x16_bf16(kf[0], qf[0], f32x16{}, 0, 0, 0);
            s1 = __builtin_amdgcn_mfma_f32_32x32x16_bf16(kf[1], qf[0], f32x16{}, 0, 0, 0);
#pragma unroll
            for (int d0 = 1; d0 < 4; ++d0) {
                s0 = __builtin_amdgcn_mfma_f32_32x32x16_bf16(kf[2 * d0], qf[d0], s0, 0, 0, 0);
                s1 = __builtin_amdgcn_mfma_f32_32x32x16_bf16(kf[2 * d0 + 1], qf[d0], s1, 0, 0, 0);
            }
#ifdef PROBE_EXTRA_MFMA
            { f32x16 dm_;
#pragma unroll
              for (int d0 = 0; d0 < 4; ++d0) { asm volatile("v_mfma_f32_32x32x16_bf16 %0, %1, %2, 0" : "=v"(dm_) : "v"(kf[2 * d0]), "v"(qf[d0])); asm volatile("v_mfma_f32_32x32x16_bf16 %0, %1, %2, 0" : "=v"(dm_) : "v"(kf[2 * d0 + 1]), "v"(qf[d0])); } }
#endif
            bf16x8 va[4], vb[4];
            if (!grpB) { v_reads(va, lds, vaddr, (unsigned)vs_cur * 16384); v_reads(vb, lds, vaddr, (unsigned)vs_cur * 16384 + 4096); }
            SBAR();
            if (cls == 0) {
                const int a0 = (kt + 16 * hi - (qpos_w + r32) + 129) * 4 + A_BT;
#pragma unroll
                for (int rg = 0; rg < 4; ++rg) {
#pragma unroll
                    for (int r = 4 * rg; r < 4 * rg + 4; ++r) {
                        const int aa = min(max(a0 + 4 * r, A_BT), A_BT + 258 * 4), ab = min(max(a0 + 4 * r + 128, A_BT), A_BT + 258 * 4);
                        s0[r] += *(const LAS float*)(lds + aa);
                        s1[r] += *(const LAS float*)(lds + ab);
                    }
                    SBAR();
                }
            }
            float mx = max3f(s0[0], s1[0], s0[1]);
            mx = max3f(mx, s1[1], s0[2]);
#pragma unroll
            for (int r = 2; r < 15; ++r) mx = max3f(mx, s1[r], s0[r + 1]);
            mx = fmaxf(mx, s1[15]);
            mx = hmax(mx) + (cb - mref);
            if (__any(mx > 8.0f)) {
                const float dl = fmaxf(mx, 0.f);
                mref += dl;
                const float f = __builtin_amdgcn_exp2f(-dl);
                lsum *= f;
#pragma unroll
                for (int db = 0; db < DV / 32; ++db) o[db] *= f;
            }
            FL_ISSUE(t + PFD, ks_iss, vs_iss); issued = true;
            const float off = mref - cb;
            s0 = s0 - off; s1 = s1 - off;
#pragma unroll
            for (int r = 0; r < 16; ++r) { s0[r] = __builtin_amdgcn_exp2f(s0[r]); s1[r] = __builtin_amdgcn_exp2f(s1[r]); }
#ifdef PROBE_EXTRA_EXP
#pragma unroll
            for (int r = 0; r < 16; ++r) { float t0_, t1_; asm volatile("v_exp_f32 %0, %1" : "=v"(t0_) : "v"(s0[r])); asm volatile("v_exp_f32 %0, %1" : "=v"(t1_) : "v"(s1[r])); }
#endif
#ifdef PROBE_EXTRA_VALU
#pragma unroll
            for (int r = 0; r < 16; ++r) { float t0_, t1_, t2_, t3_; asm volatile("v_add_f32 %0, %1, %1" : "=v"(t0_) : "v"(s0[r])); asm volatile("v_add_f32 %0, %1, %1" : "=v"(t1_) : "v"(s1[r])); asm volatile("v_add_f32 %0, %1, %1" : "=v"(t2_) : "v"(s0[r])); asm volatile("v_add_f32 %0, %1, %1" : "=v"(t3_) : "v"(s1[r])); }
#endif
            {
                const f32x16 sm = s0 + s1;
                lsum += ((sm[0] + sm[1]) + (sm[2] + sm[3])) + ((sm[4] + sm[5]) + (sm[6] + sm[7])) + (((sm[8] + sm[9]) + (sm[10] + sm[11])) + ((sm[12] + sm[13]) + (sm[14] + sm[15])));
            }
            {
                u32x4 w;
                w.x = cvtpk(s0[0], s0[1]); w.y = cvtpk(s0[2], s0[3]); w.z = cvtpk(s0[4], s0[5]); w.w = cvtpk(s0[6], s0[7]); p[0] = __builtin_bit_cast(bf16x8, w);
                w.x = cvtpk(s0[8], s0[9]); w.y = cvtpk(s0[10], s0[11]); w.z = cvtpk(s0[12], s0[13]); w.w = cvtpk(s0[14], s0[15]); p[1] = __builtin_bit_cast(bf16x8, w);
                w.x = cvtpk(s1[0], s1[1]); w.y = cvtpk(s1[2], s1[3]); w.z = cvtpk(s1[4], s1[5]); w.w = cvtpk(s1[6], s1[7]); p[2] = __builtin_bit_cast(bf16x8, w);
                w.x = cvtpk(s1[8], s1[9]); w.y = cvtpk(s1[10], s1[11]); w.z = cvtpk(s1[12], s1[13]); w.w = cvtpk(s1[14], s1[15]); p[3] = __builtin_bit_cast(bf16x8, w);
            }
            if (!grpB) { SBAR(); pv_rest<DV>(o, p, va, vb, lds, vaddr, (unsigned)vs_cur * 16384); }
        }
        if (!issued) FL_ISSUE(t + PFD, ks_iss, vs_iss);
        have_prev = active;
        if (DV == 128) asm volatile("s_waitcnt vmcnt(6) lgkmcnt(0)\n\ts_barrier" ::: "memory"); else asm volatile("s_waitcnt vmcnt(4) lgkmcnt(0)\n\ts_barrier" ::: "memory");
        ks_cur = (ks_cur + 1) & 3; ks_iss = (ks_iss + 1) & 3;
        vs_prev = vs_cur; vs_cur = (vs_cur == NVS - 1) ? 0 : vs_cur + 1; vs_iss = (vs_iss == NVS - 1) ? 0 : vs_iss + 1;
    }
    asm volatile("s_waitcnt vmcnt(0)" ::: "memory");
    __syncthreads();
#undef FL_ISSUE
}

template <bool ISSUE>
__device__ __forceinline__ void da_tile(LAS unsigned char* lds, int t, int NT, int qpos_w, int r32, int hi, const bf16x8 (&qf)[4], const unsigned (&kaddr)[4], const unsigned (&vaddr)[4],
                                        const bf16* ksrc, const bf16* vsrc, unsigned kdst, unsigned vdst, int& cls_cur, float& cb, f32x16 (&o)[4], float& mref, float& lsum) {
    const LAS float* bt = (const LAS float*)(lds + A_BT);
    const unsigned kb_ = (unsigned)(t & 3) * 8192, vb_ = (unsigned)(t & 3) * 16384;
    bf16x8 kf[8];
#pragma unroll
    for (int d0 = 0; d0 < 4; ++d0) { kf[2 * d0] = *(const LAS bf16x8*)(lds + kaddr[d0] + kb_); kf[2 * d0 + 1] = *(const LAS bf16x8*)(lds + kaddr[d0] + kb_ + 4096); }
    SBAR();
    const int kt = t * 64;
    const int rpmin = kt - (qpos_w + 31), rpmax = kt + 63 - qpos_w;
    const int cls = (rpmax <= -91 ? 1 : (rpmin >= 91 ? 2 : 0));
    if (cls != cls_cur) { cls_cur = cls; cb = (cls == 0) ? 0.f : (cls == 1 ? bt[0] : bt[258]); }
    f32x16 s0, s1;
    s0 = __builtin_amdgcn_mfma_f32_32x32x16_bf16(kf[0], qf[0], f32x16{}, 0, 0, 0);
    s1 = __builtin_amdgcn_mfma_f32_32x32x16_bf16(kf[1], qf[0], f32x16{}, 0, 0, 0);
#pragma unroll
    for (int d0 = 1; d0 < 4; ++d0) {
        s0 = __builtin_amdgcn_mfma_f32_32x32x16_bf16(kf[2 * d0], qf[d0], s0, 0, 0, 0);
        s1 = __builtin_amdgcn_mfma_f32_32x32x16_bf16(kf[2 * d0 + 1], qf[d0], s1, 0, 0, 0);
    }
    bf16x8 va[4], vb[4];
    v_reads(va, lds, vaddr, vb_);
    SBAR();
    if (cls == 0) {
        int a0 = (kt + 16 * hi - (qpos_w + r32) + 129) * 4 + A_BT; asm volatile("" : "+v"(a0));
#pragma unroll
        for (int rg = 0; rg < 4; ++rg) {
#pragma unroll
            for (int r = 4 * rg; r < 4 * rg + 4; ++r) {
                const int aa = min(max(a0 + 4 * r, A_BT), A_BT + 258 * 4), ab = min(max(a0 + 4 * r + 128, A_BT), A_BT + 258 * 4);
                s0[r] += *(const LAS float*)(lds + aa);
                s1[r] += *(const LAS float*)(lds + ab);
            }
            SBAR();
        }
    }
    float mx;
    {
        float m0 = max3f(s0[0], s0[1], s0[2]), m1 = max3f(s0[8], s0[9], s0[10]), m2 = max3f(s1[0], s1[1], s1[2]), m3 = max3f(s1[8], s1[9], s1[10]);
        m0 = max3f(m0, s0[3], s0[4]); m1 = max3f(m1, s0[11], s0[12]); m2 = max3f(m2, s1[3], s1[4]); m3 = max3f(m3, s1[11], s1[12]);
        m0 = max3f(m0, s0[5], s0[6]); m1 = max3f(m1, s0[13], s0[14]); m2 = max3f(m2, s1[5], s1[6]); m3 = max3f(m3, s1[13], s1[14]);
        m0 = max3f(m0, s0[7], s0[15]); m2 = max3f(m2, s1[7], s1[15]);
        mx = max3f(max3f(m0, m1, m2), m3, m3);
    }
    mx = hmax(mx) + (cb - mref);
    if (__any(mx > 8.0f)) {
        const float dl = fmaxf(mx, 0.f);
        mref += dl;
        const float f = __builtin_amdgcn_exp2f(-dl);
        lsum *= f;
#pragma unroll
        for (int db = 0; db < 4; ++db) o[db] *= f;
    }
    if (ISSUE) {
        if (t + 2 < NT) {
            glds16(ksrc + (size_t)(t + 2) * 4096, (unsigned)__builtin_amdgcn_readfirstlane(kdst + ((t + 2) & 3) * 8192));
            glds16(vsrc + (size_t)(t + 2) * 8192, (unsigned)__builtin_amdgcn_readfirstlane(vdst + ((t + 2) & 3) * 16384));
            glds16(vsrc + (size_t)(t + 2) * 8192 + 4096, (unsigned)__builtin_amdgcn_readfirstlane(vdst + ((t + 2) & 3) * 16384 + 8192));
            glds16(ksrc + (size_t)(t + 3) * 4096, (unsigned)__builtin_amdgcn_readfirstlane(kdst + ((t + 3) & 3) * 8192));
            glds16(vsrc + (size_t)(t + 3) * 8192, (unsigned)__builtin_amdgcn_readfirstlane(vdst + ((t + 3) & 3) * 16384));
            glds16(vsrc + (size_t)(t + 3) * 8192 + 4096, (unsigned)__builtin_amdgcn_readfirstlane(vdst + ((t + 3) & 3) * 16384 + 8192));
        }
    }
    const float off = mref - cb;
    s0 = s0 - off; s1 = s1 - off;
#pragma unroll
    for (int r = 0; r < 16; ++r) { s0[r] = __builtin_amdgcn_exp2f(s0[r]); s1[r] = __builtin_amdgcn_exp2f(s1[r]); }
    {
        const f32x16 sm = s0 + s1;
        lsum += ((sm[0] + sm[1]) + (sm[2] + sm[3])) + ((sm[4] + sm[5]) + (sm[6] + sm[7])) + (((sm[8] + sm[9]) + (sm[10] + sm[11])) + ((sm[12] + sm[13]) + (sm[14] + sm[15])));
    }
    bf16x8 p[4];
    {
        u32x4 w;
        w.x = cvtpk(s0[0], s0[1]); w.y = cvtpk(s0[2], s0[3]); w.z = cvtpk(s0[4], s0[5]); w.w = cvtpk(s0[6], s0[7]); p[0] = __builtin_bit_cast(bf16x8, w);
        w.x = cvtpk(s0[8], s0[9]); w.y = cvtpk(s0[10], s0[11]); w.z = cvtpk(s0[12], s0[13]); w.w = cvtpk(s0[14], s0[15]); p[1] = __builtin_bit_cast(bf16x8, w);
        w.x = cvtpk(s1[0], s1[1]); w.y = cvtpk(s1[2], s1[3]); w.z = cvtpk(s1[4], s1[5]); w.w = cvtpk(s1[6], s1[7]); p[2] = __builtin_bit_cast(bf16x8, w);
        w.x = cvtpk(s1[8], s1[9]); w.y = cvtpk(s1[10], s1[11]); w.z = cvtpk(s1[12], s1[13]); w.w = cvtpk(s1[14], s1[15]); p[3] = __builtin_bit_cast(bf16x8, w);
    }
    v_reads(vb, lds, vaddr, vb_ + 4096);
    SBAR();
    pv_rest<128>(o, p, va, vb, lds, vaddr, vb_);
}
__device__ __forceinline__ void flash_da2(LAS unsigned char* lds, const bf16* __restrict__ Qw, const bf16* __restrict__ Kb, const bf16* __restrict__ VTb,
                                          int NT, int qpos_w, f32x16 (&o)[4], float& mref, float& lsum) {
    const int tid = threadIdx.x, lane = tid & 63, r32 = lane & 31, hi = lane >> 5;
    const int wid = __builtin_amdgcn_readfirstlane(tid >> 6);
    const unsigned lds0 = (unsigned)(uintptr_t)lds;
    bf16x8 qf[4];
#pragma unroll
    for (int d0 = 0; d0 < 4; ++d0) qf[d0] = *(const bf16x8*)(Qw + (size_t)r32 * 64 + d0 * 16 + hi * 8);
    const int lrow = wid * 8 + (lane >> 3), pch = lane & 7, lch = pch ^ ((lrow >> 1) & 7);
    const int rho = lrow & 31, key = (lrow & 32) + 16 * ((rho >> 2) & 1) + 4 * (rho >> 3) + (rho & 3);
    const bf16* ksrc = Kb + key * 64 + lch * 8;
    const bf16* vsrc = VTb + lrow * 64 + lch * 8;
    const unsigned kdst = lds0 + A_K + wid * 1024, vdst = lds0 + A_V + wid * 1024;
    const int sw = (r32 >> 1) & 7;
    unsigned kaddr[4], vaddr[4];
#pragma unroll
    for (int d0 = 0; d0 < 4; ++d0) kaddr[d0] = A_K + r32 * 128 + (((2 * d0 + hi) ^ sw) << 4);
#pragma unroll
    for (int c4 = 0; c4 < 4; ++c4) vaddr[c4] = A_V + r32 * 128 + (((4 * (c4 >> 1) + 2 * hi + (c4 & 1)) ^ sw) << 4);
#pragma unroll
    for (int j = 0; j < 2; ++j) {
        glds16(ksrc + (size_t)j * 4096, (unsigned)__builtin_amdgcn_readfirstlane(kdst + j * 8192));
        glds16(vsrc + (size_t)j * 8192, (unsigned)__builtin_amdgcn_readfirstlane(vdst + j * 16384));
        glds16(vsrc + (size_t)j * 8192 + 4096, (unsigned)__builtin_amdgcn_readfirstlane(vdst + j * 16384 + 8192));
    }
    asm volatile("" :: "v"(qf[0]), "v"(qf[1]), "v"(qf[2]), "v"(qf[3]));
    asm volatile("s_waitcnt vmcnt(0) lgkmcnt(0)\n\ts_barrier" ::: "memory");
    int cls_cur = 0; float cb = 0.f;
#pragma unroll 1
    for (int t = 0; t < NT; t += 2) {
        da_tile<true>(lds, t, NT, qpos_w, r32, hi, qf, kaddr, vaddr, ksrc, vsrc, kdst, vdst, cls_cur, cb, o, mref, lsum);
        da_tile<false>(lds, t + 1, NT, qpos_w, r32, hi, qf, kaddr, vaddr, ksrc, vsrc, kdst, vdst, cls_cur, cb, o, mref, lsum);
        asm volatile("s_waitcnt vmcnt(0) lgkmcnt(0)\n\ts_barrier" ::: "memory");
    }
}

struct AttnP {
    const bf16 *Qda, *Kda, *VTda, *Qsw, *Ksw, *VTsw; bf16* O;
    const float *rel_bias, *subln_g, *sink; float* stash;
};

__device__ __forceinline__ void bias_table(LAS unsigned char* lds, const float* rel_bias, int head, bool mask) {
    LAS float* bt = (LAS float*)(lds + A_BT);
    for (int i = threadIdx.x; i < 259; i += NTHREADS) {
        const int rp = i - 129;
        bt[i] = (mask && (rp < -128 || rp > 128)) ? -INFINITY : rel_bias[t5_bucket(rp) * 24 + head] * LOG2E;
    }
}

__device__ __forceinline__ void da_unit(LAS unsigned char* lds, const AttnP& P, int seqbase, int S, int h, int qb, float lam) {
    const int tid = threadIdx.x, lane = tid & 63, r32 = lane & 31, hi = lane >> 5, wid = __builtin_amdgcn_readfirstlane(tid >> 6);
    bias_table(lds, P.rel_bias, h, false);
    const int qpos_w = qb * 256 + wid * 32;
    const size_t row_w = (size_t)seqbase + qpos_w;
    const bf16* Kb = P.Kda + (size_t)seqbase * 1024 + (size_t)(h * 2) * 64 * S;
    const bf16* Qb = P.Qda + (size_t)seqbase * 1024 + (size_t)(h * 2) * 64 * S + (size_t)qpos_w * 64;
    const bf16* VTb = P.VTda + (size_t)seqbase * 1024 + (size_t)(h * 128) * S;
    f32x16 o[4];
    float ss = 0.f;
#pragma unroll 1
    for (int map = 0; map < 2; ++map) {
#pragma unroll
        for (int db = 0; db < 4; ++db) o[db] = f32x16{};
        float mref = 0.f, l = 0.f;
        flash_da2(lds, Qb + (size_t)map * 64 * S, Kb + (size_t)map * 64 * S, VTb, S / 64, qpos_w, o, mref, l);
        int tid3 = threadIdx.x; asm volatile("" : "+v"(tid3));
        f32x4* stash = (f32x4*)(P.stash + (size_t)blockIdx.x * 32768 + tid3 * 64);
        if (map == 0) {
            const float inv = 1.0f / hsum(l);
#pragma unroll
            for (int db = 0; db < 4; ++db)
#pragma unroll
                for (int g = 0; g < 4; ++g) stash[db * 4 + g] = (f32x4){o[db][4 * g], o[db][4 * g + 1], o[db][4 * g + 2], o[db][4 * g + 3]} * inv;
        } else {
            const float inv = lam / hsum(l);
#pragma unroll
            for (int db = 0; db < 4; ++db)
#pragma unroll
                for (int g = 0; g < 4; ++g) {
                    const f32x4 st = stash[db * 4 + g];
#pragma unroll
                    for (int e = 0; e < 4; ++e) { const float a = st[e] - o[db][4 * g + e] * inv; o[db][4 * g + e] = a; ss += a * a; }
                }
        }
    }
    ss = hsum(ss);
    const float rstd = __builtin_amdgcn_rsqf(ss * (1.0f / 128.0f) + EPS) * (1.0f - LAMBDA_INIT);
    int tid2 = threadIdx.x; asm volatile("" : "+v"(tid2));
    const int r32e = tid2 & 31, hie = (tid2 >> 5) & 1;
    bf16* orow = P.O + (row_w + r32e) * 2048 + h * 128 + 4 * hie;
    const LAS unsigned char* gb = lds + A_G + hie * 16;
#pragma unroll
    for (int db = 0; db < 4; ++db)
#pragma unroll
        for (int g4 = 0; g4 < 4; ++g4) {
            const int d0 = 32 * db + 8 * g4;
            const f32x4 gv = *(const LAS f32x4*)(gb + d0 * 4);
            u32x2 w;
            w.x = cvtpk(o[db][4 * g4] * rstd * gv[0], o[db][4 * g4 + 1] * rstd * gv[1]);
            w.y = cvtpk(o[db][4 * g4 + 2] * rstd * gv[2], o[db][4 * g4 + 3] * rstd * gv[3]);
            *(u32x2*)(orow + d0) = w;
        }
}

__device__ __forceinline__ void sw_unit(LAS unsigned char* lds, const AttnP& P, int blk, int qh) {
    const int tid = threadIdx.x, lane = tid & 63, r32 = lane & 31, hi = lane >> 5, wid = __builtin_amdgcn_readfirstlane(tid >> 6);
    const int row0 = blk * 256;
    int S, seqbase;
    if (row0 < M_P) { S = 2048; seqbase = row0 & ~2047; } else { S = 4096; seqbase = M_P + ((row0 - M_P) & ~4095); }
    const int q0 = row0 - seqbase;
    bias_table(lds, P.rel_bias, 8 + qh, true);
    const int kvh = qh >> 2;
    const int t_lo = max(0, q0 - 128) >> 6, t_hi = min(S, q0 + 384) >> 6;
    const int qpos_w = q0 + wid * 32;
    const size_t row_w = (size_t)row0 + wid * 32;
    f32x16 o[2];
    o[0] = f32x16{}; o[1] = f32x16{};
    float mref = 0.f, l = 0.f;
    flash<64, true>(lds, P.Qsw + (size_t)seqbase * 1024 + (size_t)qh * 64 * S + (size_t)qpos_w * 64, 64, P.Ksw + (size_t)seqbase * 256 + (size_t)kvh * 64 * S, 64, P.VTsw + (size_t)seqbase * 256 + (size_t)(kvh * 64) * S, S, t_lo, t_hi, qpos_w, wid >= 4, o, mref, l);
    const float lt = hsum(l) + __builtin_amdgcn_exp2f(P.sink[qh] * LOG2E - mref);
    const float inv = 1.0f / lt;
    bf16* orow = P.O + (row_w + r32) * 2048 + 1024 + qh * 64;
#pragma unroll
    for (int db = 0; db < 2; ++db)
#pragma unroll
        for (int g4 = 0; g4 < 4; ++g4) {
            const int d0 = 32 * db + 8 * g4 + 4 * hi;
            u32x2 w;
            w.x = cvtpk(o[db][4 * g4] * inv, o[db][4 * g4 + 1] * inv);
            w.y = cvtpk(o[db][4 * g4 + 2] * inv, o[db][4 * g4 + 3] * inv);
            *(u32x2*)(orow + d0) = w;
        }
}

constexpr int A_K8 = 0, A_V8 = 65536, A_BT4 = 131072;
__device__ __forceinline__ void sw_unit4(LAS unsigned char* lds, const AttnP& P, int blk, int kvh) {
    const int tid = threadIdx.x, lane = tid & 63, r32 = lane & 31, hi = lane >> 5, wid = __builtin_amdgcn_readfirstlane(tid >> 6);
    const unsigned lds0 = (unsigned)(uintptr_t)lds;
    const int row0 = blk * 256;
    int S, seqbase;
    if (row0 < M_P) { S = 2048; seqbase = row0 & ~2047; } else { S = 4096; seqbase = M_P + ((row0 - M_P) & ~4095); }
    const int q0 = row0 - seqbase;
    const int t_lo = max(0, q0 - 128) >> 6, t_hi = min(S, q0 + 384) >> 6;
    for (int i = tid; i < 4 * 452; i += NTHREADS) {
        const int g = i / 452, e = i - g * 452, rp = e - 224;
        ((LAS float*)(lds + A_BT4))[i] = (rp < -128 || rp > 128) ? -INFINITY : P.rel_bias[t5_bucket(rp) * 24 + 8 + kvh * 4 + g] * LOG2E;
    }
    {
        const int lrow = wid * 8 + (lane >> 3), pch = lane & 7, lch = pch ^ ((lrow >> 1) & 7);
        const int rho = lrow & 31, key = (lrow & 32) + 16 * ((rho >> 2) & 1) + 4 * (rho >> 3) + (rho & 3);
        const bf16* ksrc = P.Ksw + (size_t)seqbase * 256 + (size_t)kvh * 64 * S + key * 64 + lch * 8;
        const bf16* vsrc = P.VTsw + (size_t)seqbase * 256 + (size_t)(kvh * 64) * S + lrow * 64 + lch * 8;
        for (int t = t_lo; t < t_hi; ++t) {
            glds16(ksrc + (size_t)t * 4096, (unsigned)__builtin_amdgcn_readfirstlane(lds0 + A_K8 + (t - t_lo) * 8192 + wid * 1024));
            glds16(vsrc + (size_t)t * 4096, (unsigned)__builtin_amdgcn_readfirstlane(lds0 + A_V8 + (t - t_lo) * 8192 + wid * 1024));
        }
    }
    const int sw = (r32 >> 1) & 7;
    unsigned kaddr[4], vaddr[4];
#pragma unroll
    for (int d0 = 0; d0 < 4; ++d0) kaddr[d0] = A_K8 + r32 * 128 + (((2 * d0 + hi) ^ sw) << 4);
#pragma unroll
    for (int c4 = 0; c4 < 4; ++c4) vaddr[c4] = A_V8 + r32 * 128 + (((4 * (c4 >> 1) + 2 * hi + (c4 & 1)) ^ sw) << 4);
    const int qpos_w = q0 + wid * 32;
    const size_t row_w = (size_t)row0 + wid * 32;
    asm volatile("s_waitcnt vmcnt(0) lgkmcnt(0)\n\ts_barrier" ::: "memory");
    const bf16* Qg = P.Qsw + (size_t)seqbase * 1024 + (size_t)(kvh * 4) * 64 * S + (size_t)qpos_w * 64 + (size_t)r32 * 64 + hi * 8;
    bf16x8 qn[4];
#pragma unroll
    for (int d0 = 0; d0 < 4; ++d0) qn[d0] = *(const bf16x8*)(Qg + d0 * 16);
#pragma unroll 1
    for (int g = 0; g < 4; ++g) {
        const int qh = kvh * 4 + g;
        bf16x8 qf[4];
#pragma unroll
        for (int d0 = 0; d0 < 4; ++d0) qf[d0] = qn[d0];
        if (g < 3) {
#pragma unroll
            for (int d0 = 0; d0 < 4; ++d0) qn[d0] = *(const bf16x8*)(Qg + (size_t)(g + 1) * 64 * S + d0 * 16);
        }
        const int btg = A_BT4 + g * 1808;
        f32x16 o[2]; o[0] = f32x16{}; o[1] = f32x16{};
        float mref = 0.f, lsum = 0.f;
#pragma unroll 1
        for (int t = t_lo; t < t_hi; ++t) {
            const int kt = t * 64;
            if (!((kt + 63 >= qpos_w - 128) && (kt <= qpos_w + 31 + 128))) continue;
            const unsigned sl = (unsigned)(t - t_lo) * 8192;
            bf16x8 kf[8];
#pragma unroll
            for (int d0 = 0; d0 < 4; ++d0) { kf[2 * d0] = *(const LAS bf16x8*)(lds + kaddr[d0] + sl); kf[2 * d0 + 1] = *(const LAS bf16x8*)(lds + kaddr[d0] + sl + 4096); }
            f32x16 s0, s1;
            s0 = __builtin_amdgcn_mfma_f32_32x32x16_bf16(kf[0], qf[0], f32x16{}, 0, 0, 0);
            s1 = __builtin_amdgcn_mfma_f32_32x32x16_bf16(kf[1], qf[0], f32x16{}, 0, 0, 0);
#pragma unroll
            for (int d0 = 1; d0 < 4; ++d0) {
                s0 = __builtin_amdgcn_mfma_f32_32x32x16_bf16(kf[2 * d0], qf[d0], s0, 0, 0, 0);
                s1 = __builtin_amdgcn_mfma_f32_32x32x16_bf16(kf[2 * d0 + 1], qf[d0], s1, 0, 0, 0);
            }
            bf16x8 va[4], vb[4];
            v_reads(va, lds, vaddr, sl); v_reads(vb, lds, vaddr, sl + 4096);
            SBAR();
            {
                const LAS float* tb = (const LAS float*)(lds + btg) + (kt + 16 * hi - (qpos_w + r32) + 224);
#pragma unroll
                for (int rg = 0; rg < 4; ++rg) {
#pragma unroll
                    for (int r = 4 * rg; r < 4 * rg + 4; ++r) { s0[r] += tb[r]; s1[r] += tb[r + 32]; }
                    SBAR();
                }
            }
            float mx;
            {
                float m0 = max3f(s0[0], s0[1], s0[2]), m1 = max3f(s0[8], s0[9], s0[10]), m2 = max3f(s1[0], s1[1], s1[2]), m3 = max3f(s1[8], s1[9], s1[10]);
                m0 = max3f(m0, s0[3], s0[4]); m1 = max3f(m1, s0[11], s0[12]); m2 = max3f(m2, s1[3], s1[4]); m3 = max3f(m3, s1[11], s1[12]);
                m0 = max3f(m0, s0[5], s0[6]); m1 = max3f(m1, s0[13], s0[14]); m2 = max3f(m2, s1[5], s1[6]); m3 = max3f(m3, s1[13], s1[14]);
                m0 = max3f(m0, s0[7], s0[15]); m2 = max3f(m2, s1[7], s1[15]);
                mx = max3f(max3f(m0, m1, m2), m3, m3);
            }
            mx = hmax(mx) - mref;
            if (__any(mx > 8.0f)) {
                const float dl = fmaxf(mx, 0.f);
                mref += dl;
                const float f = __builtin_amdgcn_exp2f(-dl);
                lsum *= f; o[0] *= f; o[1] *= f;
            }
            s0 = s0 - mref; s1 = s1 - mref;
#pragma unroll
            for (int r = 0; r < 16; ++r) { s0[r] = __builtin_amdgcn_exp2f(s0[r]); s1[r] = __builtin_amdgcn_exp2f(s1[r]); }
            {
                const f32x16 sm = s0 + s1;
                lsum += ((sm[0] + sm[1]) + (sm[2] + sm[3])) + ((sm[4] + sm[5]) + (sm[6] + sm[7])) + (((sm[8] + sm[9]) + (sm[10] + sm[11])) + ((sm[12] + sm[13]) + (sm[14] + sm[15])));
            }
            bf16x8 p[4];
            {
                u32x4 w;
                w.x = cvtpk(s0[0], s0[1]); w.y = cvtpk(s0[2], s0[3]); w.z = cvtpk(s0[4], s0[5]); w.w = cvtpk(s0[6], s0[7]); p[0] = __builtin_bit_cast(bf16x8, w);
                w.x = cvtpk(s0[8], s0[9]); w.y = cvtpk(s0[10], s0[11]); w.z = cvtpk(s0[12], s0[13]); w.w = cvtpk(s0[14], s0[15]); p[1] = __builtin_bit_cast(bf16x8, w);
                w.x = cvtpk(s1[0], s1[1]); w.y = cvtpk(s1[2], s1[3]); w.z = cvtpk(s1[4], s1[5]); w.w = cvtpk(s1[6], s1[7]); p[2] = __builtin_bit_cast(bf16x8, w);
                w.x = cvtpk(s1[8], s1[9]); w.y = cvtpk(s1[10], s1[11]); w.z = cvtpk(s1[12], s1[13]); w.w = cvtpk(s1[14], s1[15]); p[3] = __builtin_bit_cast(bf16x8, w);
            }
            SBAR();
            pv_mma(o[0], va, p); pv_mma(o[1], vb, p);
        }
        const float lt = hsum(lsum) + __builtin_amdgcn_exp2f(P.sink[qh] * LOG2E - mref);
        const float inv = 1.0f / lt;
        bf16* orow = P.O + (row_w + r32) * 2048 + 1024 + qh * 64 + 4 * hi;
#pragma unroll
        for (int db = 0; db < 2; ++db)
#pragma unroll
            for (int g4 = 0; g4 < 4; ++g4) {
                u32x2 w;
                w.x = cvtpk(o[db][4 * g4] * inv, o[db][4 * g4 + 1] * inv);
                w.y = cvtpk(o[db][4 * g4 + 2] * inv, o[db][4 * g4 + 3] * inv);
                *(u32x2*)(orow + 32 * db + 8 * g4) = w;
            }
    }
    asm volatile("s_waitcnt vmcnt(0) lgkmcnt(0)\n\ts_barrier" ::: "memory");
}

__device__ __forceinline__ void attn_phase(LAS unsigned char* lds, const AttnP& P, int vcu, int G, const float* lq1, const float* lk1, const float* lq2, const float* lk2) {
    const int lane = threadIdx.x & 63;
    const float s1 = wave_sum(lq1[lane] * lk1[lane]), s2 = wave_sum(lq2[lane] * lk2[lane]);
    const float lam = __expf(s1) - __expf(s2) + LAMBDA_INIT;
    if (threadIdx.x < 128) ((LAS float*)(lds + A_G))[threadIdx.x] = P.subln_g[threadIdx.x];
#ifndef REP_DA
#define REP_DA 1
#endif
#ifndef REP_SW
#define REP_SW 1
#endif
#ifndef NO_DA
    const int nda = (G == 256) ? 8 : (2048 - vcu + G - 1) / G;
#pragma unroll 1
    for (int j0 = 0; j0 < nda * REP_DA; ++j0) {
        const int j = j0 % nda;
        int grp, qb, seqbase, S;
        if (G == 256) {
            const int x = vcu >> 5, i = vcu & 31;
            if (j < 4) { grp = x * 16 + j * 4 + (i >> 3); qb = i & 7; seqbase = (grp >> 3) * 2048; S = 2048; }
            else { grp = x * 8 + (j - 4) * 2 + (i >> 4); qb = i & 15; seqbase = M_P + (grp >> 3) * 4096; S = 4096; }
        } else {
            const int u = vcu + j * G;
            if (u < 1024) { grp = u >> 3; qb = u & 7; seqbase = (grp >> 3) * 2048; S = 2048; }
            else { const int u2 = u - 1024; grp = u2 >> 4; qb = u2 & 15; seqbase = M_P + (grp >> 3) * 4096; S = 4096; }
        }
        da_unit(lds, P, seqbase, S, grp & 7, qb, lam);
    }
#endif
#ifndef NO_SW
    __syncthreads();
#pragma unroll 1
    for (int u = vcu; u < 256; u += G)
#pragma unroll 1
        for (int kv0 = 0; kv0 < 4 * REP_SW; ++kv0) sw_unit4(lds, P, u, kv0 & 3);
#endif
}

__device__ __forceinline__ unsigned f2bf(float f) { unsigned u = __builtin_bit_cast(unsigned, f); return (u + 0x7fffu + ((u >> 16) & 1u)) >> 16; }
__device__ __forceinline__ unsigned pk2(float lo, float hi) { return f2bf(lo) | (f2bf(hi) << 16); }
template <bool GU>
__device__ __forceinline__ void transpose_item(const float* __restrict__ W, int K, int N, bf16* __restrict__ WT, LAS float* scr, int item, int lane, const float* __restrict__ gk) {
    const int nblk = N / 32, kb = item / nblk, nb = item % nblk, k0 = 64 * kb, n0 = 32 * nb;
    int r0 = n0;
    if (GU) { r0 = (n0 < D_FF) ? (n0 >> 7) * 256 + (n0 & 127) : ((n0 - D_FF) >> 7) * 256 + 128 + ((n0 - D_FF) & 127); }
    float wv[32];
#pragma unroll
    for (int i = 0; i < 32; ++i) wv[i] = W[(size_t)(k0 + 2 * i + (lane >> 5)) * N + n0 + (lane & 31)];
#pragma unroll
    for (int i = 0; i < 32; ++i) scr[(2 * i + (lane >> 5)) * 33 + (lane & 31)] = gk ? wv[i] * gk[k0 + 2 * i + (lane >> 5)] : wv[i];
    asm volatile("s_waitcnt lgkmcnt(0)" ::: "memory");
    const int c = lane & 7;
#pragma unroll
    for (int j = 0; j < 4; ++j) { const int n = (lane >> 3) + 8 * j; const LAS float* s = scr + (8 * c) * 33 + n;
        u32x4 o; o.x = pk2(s[0 * 33], s[1 * 33]); o.y = pk2(s[2 * 33], s[3 * 33]); o.z = pk2(s[4 * 33], s[5 * 33]); o.w = pk2(s[6 * 33], s[7 * 33]);
        *(u32x4*)(WT + (size_t)(r0 + n) * K + k0 + 8 * c) = o; }
    asm volatile("s_waitcnt lgkmcnt(0)" ::: "memory");
}

template <bool HAS_T, bool NEXT, bool BASE_BF, bool OUT_BF>
__device__ __forceinline__ void rowpass(int gw, int ngw, int lane, const float* base0, const float* base1, const bf16* hin, const bf16* T, const float* part, const float* gpost, float alpha,
                                        float* out, bf16* hout, float* rs, bf16* xn, bool rev) {
    f32x4 gp[4][2];
#pragma unroll
    for (int j = 0; j < 4; ++j)
#pragma unroll
        for (int e = 0; e < 2; ++e) {
            if (HAS_T) gp[j][e] = *(const f32x4*)(gpost + j * 512 + lane * 8 + e * 4) * alpha;
        }
    for (int row_ = gw; row_ < M_TOT; row_ += ngw) {
        const int row = rev ? (M_TOT - 1 - row_) : row_;
        f32x4 v[4][2];
        if (BASE_BF) {
            u32x4 hw[4];
#pragma unroll
            for (int j = 0; j < 4; ++j) hw[j] = *(const u32x4*)(hin + (size_t)row * D_MODEL + j * 512 + lane * 8);
#pragma unroll
            for (int j = 0; j < 4; ++j) { v[j][0] = (f32x4){bf_lo(hw[j].x), bf_hi(hw[j].x), bf_lo(hw[j].y), bf_hi(hw[j].y)}; v[j][1] = (f32x4){bf_lo(hw[j].z), bf_hi(hw[j].z), bf_lo(hw[j].w), bf_hi(hw[j].w)}; }
        } else {
            const float* brow = (row < M_P ? base0 : base1) + (size_t)row * D_MODEL;
#pragma unroll
            for (int j = 0; j < 4; ++j) { v[j][0] = *(const f32x4*)(brow + j * 512 + lane * 8); v[j][1] = *(const f32x4*)(brow + j * 512 + lane * 8 + 4); }
        }
        if (HAS_T) {
            u32x4 tw[4];
#pragma unroll
            for (int j = 0; j < 4; ++j) tw[j] = *(const u32x4*)(T + (size_t)row * D_MODEL + j * 512 + lane * 8);
            float ps = (lane < 32) ? part[(size_t)row * 32 + lane] : 0.f;
            ps = wave_sum(ps);
            const float rstd = __builtin_amdgcn_rsqf(ps * (1.0f / D_MODEL) + EPS);
#pragma unroll
            for (int j = 0; j < 4; ++j) {
                const f32x4 t0 = {bf_lo(tw[j].x), bf_hi(tw[j].x), bf_lo(tw[j].y), bf_hi(tw[j].y)}, t1 = {bf_lo(tw[j].z), bf_hi(tw[j].z), bf_lo(tw[j].w), bf_hi(tw[j].w)};
                v[j][0] += t0 * rstd * gp[j][0]; v[j][1] += t1 * rstd * gp[j][1];
            }
            if (OUT_BF) {
                bf16* hr = hout + (size_t)row * D_MODEL;
#pragma unroll
                for (int j = 0; j < 4; ++j) {
                    u32x4 w; w.x = cvtpk(v[j][0][0], v[j][0][1]); w.y = cvtpk(v[j][0][2], v[j][0][3]); w.z = cvtpk(v[j][1][0], v[j][1][1]); w.w = cvtpk(v[j][1][2], v[j][1][3]);
                    *(u32x4*)(hr + j * 512 + lane * 8) = w;
                }
            } else {
                float* orow = out + (size_t)row * D_MODEL;
#pragma unroll
                for (int j = 0; j < 4; ++j) { *(f32x4*)(orow + j * 512 + lane * 8) = v[j][0]; *(f32x4*)(orow + j * 512 + lane * 8 + 4) = v[j][1]; }
            }
        }
        if (NEXT) {
            float ss = 0.f;
#pragma unroll
            for (int j = 0; j < 4; ++j)
#pragma unroll
                for (int e = 0; e < 2; ++e) ss += (v[j][e][0] * v[j][e][0] + v[j][e][1] * v[j][e][1]) + (v[j][e][2] * v[j][e][2] + v[j][e][3] * v[j][e][3]);
            ss = wave_sum(ss);
            if (lane == 0) rs[row] = __builtin_amdgcn_rsqf(ss * (1.0f / D_MODEL) + EPS);
            if (!HAS_T) {
                bf16* xr = xn + (size_t)row * D_MODEL;
#pragma unroll
                for (int j = 0; j < 4; ++j) {
                    u32x4 w; w.x = cvtpk(v[j][0][0], v[j][0][1]); w.y = cvtpk(v[j][0][2], v[j][0][3]); w.z = cvtpk(v[j][1][0], v[j][1][1]); w.w = cvtpk(v[j][1][2], v[j][1][3]);
                    *(u32x4*)(xr + j * 512 + lane * 8) = w;
                }
            }
        }
    }
}

#ifndef REP_P0
#define REP_P0 1
#endif
#ifndef REP_P1
#define REP_P1 1
#endif
#ifndef REP_P2
#define REP_P2 1
#endif
#ifndef REP_P3
#define REP_P3 1
#endif
#ifndef REP_P4
#define REP_P4 1
#endif
#ifndef REP_P5
#define REP_P5 1
#endif
#ifndef REP_P6
#define REP_P6 1
#endif
#ifndef REP_P7
#define REP_P7 1
#endif
#ifndef REP_P8
#define REP_P8 1
#endif
#ifndef REP_P9
#define REP_P9 1
#endif
#ifndef REP_P10
#define REP_P10 1
#endif
#define XB_TMO      128
#define XB_XCNT(j)  (256  + 64 * (j))
#define XB_XSUB(j)  (1280 + 64 * (j))
#define XB_XGEN(j)  (2304 + 64 * (j))
#define XB_TOP      3328
#define XB_TOPGEN   3392
#define XCD_BAR_WORDS 3456
#define XB_SPIN_CAP (1u << 18)

__device__ __forceinline__ unsigned xb_ld(unsigned* p)              { return __hip_atomic_load(p, __ATOMIC_RELAXED, __HIP_MEMORY_SCOPE_AGENT); }
__device__ __forceinline__ unsigned xb_add(unsigned* p, unsigned v) { return __hip_atomic_fetch_add(p, v, __ATOMIC_RELAXED, __HIP_MEMORY_SCOPE_AGENT); }
__device__ __forceinline__ unsigned xb_xcc_id() { return (unsigned)__builtin_amdgcn_s_getreg((3 << 11) | 20) & 0xFu; }
#define XB_SPIN(cond, bar) do { unsigned _sp = 0; while (cond) { __builtin_amdgcn_s_sleep(1); \
    if ((++_sp & 255u) == 0u) { if (xb_ld(&(bar)[XB_TMO])) break; if (_sp > XB_SPIN_CAP) { atomicAdd(&(bar)[XB_TMO], 1u); break; } } } } while (0)

struct XcdBarrier {
    unsigned* bar; unsigned x;
    unsigned nloc, nx;
};

__device__ __forceinline__ XcdBarrier xcd_barrier_post(unsigned* bar) {
    XcdBarrier b; b.bar = bar; b.x = xb_xcc_id(); b.nloc = 0u; b.nx = 0u;
    if (threadIdx.x == 0) (void)xb_add(&bar[XB_XCNT(b.x)], 1u);
    return b;
}
__device__ __forceinline__ void xcd_barrier_complete(unsigned* bar, unsigned x, unsigned& nloc, unsigned& nx) {
    const unsigned G = gridDim.x * gridDim.y * gridDim.z;
    unsigned sum, cnt, mine, sp = 0u;
    for (;;) {
        sum = 0u; cnt = 0u; mine = 0u;
#pragma unroll
        for (unsigned j = 0; j < 16; ++j) { const unsigned c = xb_ld(&bar[XB_XCNT(j)]); sum += c; cnt += (c > 0u) ? 1u : 0u; mine = (j == x) ? c : mine; }
        if (sum == G) break;
        __builtin_amdgcn_s_sleep(1);
        if ((++sp & 255u) == 0u) { if (xb_ld(&bar[XB_TMO])) break; if (sp > XB_SPIN_CAP) { atomicAdd(&bar[XB_TMO], 1u); break; } }
    }
    nloc = mine > 0u ? mine : 1u; nx = cnt > 0u ? cnt : 1u;
}

__device__ __forceinline__ void xcd_barrier(XcdBarrier& b) {
    asm volatile("s_waitcnt vmcnt(0)" ::: "memory");
    __syncthreads();
    if (threadIdx.x == 0) {
        unsigned* bar = b.bar;
        __builtin_amdgcn_s_waitcnt(0);
        unsigned nloc = b.nloc, nx = b.nx;
        if (nloc == 0u) { xcd_barrier_complete(bar, b.x, nloc, nx); b.nloc = nloc; b.nx = nx; }
        const unsigned old = xb_add(&bar[XB_XSUB(b.x)], 1u);
        const unsigned gen = old / nloc;
        if (old + 1u == (gen + 1u) * nloc) {
            __builtin_amdgcn_fence(__ATOMIC_RELEASE, "agent");
            asm volatile("s_waitcnt vmcnt(0)" ::: "memory");
            const unsigned og = xb_add(&bar[XB_TOP], 1u);
            const unsigned tg = og / nx;
            if (og + 1u == (tg + 1u) * nx) xb_add(&bar[XB_TOPGEN], 1u);
            else XB_SPIN(xb_ld(&bar[XB_TOPGEN]) == tg, bar);
            __builtin_amdgcn_fence(__ATOMIC_ACQUIRE, "agent");
            xb_add(&bar[XB_XGEN(b.x)], 1u);
            asm volatile("s_waitcnt vmcnt(0)" ::: "memory");
        } else {
            XB_SPIN(xb_ld(&bar[XB_XGEN(b.x)]) == gen, bar);
            __builtin_amdgcn_fence(__ATOMIC_ACQUIRE, "agent");
            asm volatile("s_waitcnt vmcnt(0)" ::: "memory");
        }
    }
    __syncthreads();
}

constexpr int N_PHASES = 11;
struct Args { const float* in[21]; float* out; unsigned char* ws; int ph_lo, ph_hi; };
static_assert(sizeof(Args) == 21 * 8 + 8 + 8 + 8, "Args has no padding");

__global__ void __launch_bounds__(NTHREADS, 2) mega_fwd(Args args) {
    extern __shared__ __attribute__((aligned(16))) unsigned char lds_raw[];
    LAS unsigned char* lds = (LAS unsigned char*)lds_raw;
    cg::grid_group grid = cg::this_grid();
    const int tid = threadIdx.x, lane = tid & 63, wave = __builtin_amdgcn_readfirstlane(tid >> 6);
    const int G = gridDim.x, bx = blockIdx.x;
    const int vcu = (G % 8 == 0) ? (bx % 8) * (G / 8) + bx / 8 : bx;
    const int gw = vcu * NWAVES + wave, ngw = G * NWAVES;
    unsigned char* ws = args.ws;
    const float* x_prompt = args.in[0]; const float* x_sample = args.in[1]; const float* rel_bias = args.in[2];
    const float* g_ffn1_pre = args.in[3]; const float* w_ffn1_gu = args.in[4]; const float* w_ffn1_down = args.in[5]; const float* g_ffn1_post = args.in[6];
    const float* g_mix_pre = args.in[7]; const float* w_in = args.in[8];
    const float* lq1 = args.in[9]; const float* lk1 = args.in[10]; const float* lq2 = args.in[11]; const float* lk2 = args.in[12];
    const float* g_subln = args.in[13]; const float* sink = args.in[14]; const float* w_out = args.in[15]; const float* g_mix_post = args.in[16];
    const float* g_ffn2_pre = args.in[17]; const float* w_ffn2_gu = args.in[18]; const float* w_ffn2_down = args.in[19]; const float* g_ffn2_post = args.in[20];
    float* out = args.out;
    bf16* Wgu1 = (bf16*)(ws + WS_WGU1); bf16* Wd1 = (bf16*)(ws + WS_WD1); bf16* Win = (bf16*)(ws + WS_WIN); bf16* Wout = (bf16*)(ws + WS_WOUT);
    bf16* Wgu2 = (bf16*)(ws + WS_WGU2); bf16* Wd2 = (bf16*)(ws + WS_WD2);
    float* PART = (float*)(ws + WS_PART); float* RS = (float*)(ws + WS_RS); bf16* XN = (bf16*)(ws + WS_XN); bf16* T = (bf16*)(ws + WS_T); bf16* ACT = (bf16*)(ws + WS_ACT); bf16* H = (bf16*)(ws + WS_H);
    const float* xs_off = x_sample - (size_t)M_P * D_MODEL;
    const int lo = args.ph_lo, hi = args.ph_hi;
    XcdBarrier xbar; xbar.bar = (unsigned*)(ws + WS_BAR); xbar.x = 0u; xbar.nloc = 0u; xbar.nx = 0u;
#ifndef PH_MASK
#define PH_MASK 0x7ff
#endif
#define IN(k) (((PH_MASK >> (k)) & 1) && lo <= (k) && (k) < hi)
#define SEAM(k) do { if ((k) + 1 < hi) { if ((k) == 0) grid.sync(); else xcd_barrier(xbar); } } while (0)

    if (IN(0)) for (int rep_ = 0; rep_ < REP_P0; ++rep_) {
        LAS float* scr = (LAS float*)(lds + wave * 16384);
        constexpr int I_GU = (D_MODEL / 64) * (2 * D_FF / 32), I_D = (D_FF / 64) * (D_MODEL / 32), I_IN = (D_MODEL / 64) * (D_IN / 32), I_OUT = (D_MODEL / 64) * (D_MODEL / 32);
        constexpr int NITEMS = 2 * I_GU + 2 * I_D + I_IN + I_OUT;
        for (int it = gw; it < NITEMS; it += ngw) {
            int r = it;
            if (r < I_GU) { transpose_item<true>(w_ffn1_gu, D_MODEL, 2 * D_FF, Wgu1, scr, r, lane, g_ffn1_pre); continue; } r -= I_GU;
            if (r < I_GU) { transpose_item<true>(w_ffn2_gu, D_MODEL, 2 * D_FF, Wgu2, scr, r, lane, g_ffn2_pre); continue; } r -= I_GU;
            if (r < I_D) { transpose_item<false>(w_ffn1_down, D_FF, D_MODEL, Wd1, scr, r, lane, nullptr); continue; } r -= I_D;
            if (r < I_D) { transpose_item<false>(w_ffn2_down, D_FF, D_MODEL, Wd2, scr, r, lane, nullptr); continue; } r -= I_D;
            if (r < I_IN) { transpose_item<false>(w_in, D_MODEL, D_IN, Win, scr, r, lane, g_mix_pre); continue; } r -= I_IN;
            transpose_item<false>(w_out, D_MODEL, D_MODEL, Wout, scr, r, lane, nullptr);
        }
        rowpass<false, true, false, false>(gw, ngw, lane, x_prompt, xs_off, nullptr, nullptr, nullptr, nullptr, 0.f, nullptr, nullptr, RS, XN, false);
        if (rep_ == 0 && bx == 0) { for (int i = tid; i < 4096; i += NTHREADS) ((unsigned*)(ws + WS_BAR))[i] = 0u; }
        SEAM(0);
        if (rep_ == 0) xbar = xcd_barrier_post((unsigned*)(ws + WS_BAR));
    }
    if (IN(1)) for (int rep_ = 0; rep_ < REP_P1; ++rep_) {
        pg8::Gemm g{XN, Wgu1, M_TOT, 2 * D_FF, D_MODEL}; pg8::StaticOrder S; S.init(M_TOT, 2 * D_FF, G, bx, 1);
        pg8::EpiSwiglu E{ACT, D_FF, RS};
        pg8::gemm_phase<pg8::EpiSwiglu, pg8::StaticOrder, PG8_ALIGN, PG8_SP2>(lds, g, S, E);
        SEAM(1);
    }
    if (IN(2)) for (int rep_ = 0; rep_ < REP_P2; ++rep_) {
        pg8::Gemm g{ACT, Wd1, M_TOT, D_MODEL, D_FF}; pg8::StaticOrder S; S.init(M_TOT, D_MODEL, G, bx);
        pg8::EpiT E{T, D_MODEL, PART};
        pg8::gemm_phase<pg8::EpiT, pg8::StaticOrder, PG8_ALIGN, PG8_SP2>(lds, g, S, E);
        SEAM(2);
    }
#ifdef PROBE_SYNCS
    for (int i_ = 0; i_ < PROBE_SYNCS; ++i_) grid.sync();
#endif
    if (IN(3)) for (int rep_ = 0; rep_ < REP_P3; ++rep_) {
        rowpass<true, true, false, true>(gw, ngw, lane, x_prompt, xs_off, nullptr, T, PART, g_ffn1_post, 0.5f, nullptr, H, RS, nullptr, true);
        SEAM(3);
    }
    if (IN(4)) for (int rep_ = 0; rep_ < REP_P4; ++rep_) {
        pg8::Gemm g{H, Win, M_TOT, D_IN, D_MODEL}; pg8::StaticOrder S; S.init(M_TOT, D_IN, G, bx);
        pg8::EpiProj E{(bf16*)(ws + WS_QDA), (bf16*)(ws + WS_KDA), (bf16*)(ws + WS_VTDA), (bf16*)(ws + WS_QSW), (bf16*)(ws + WS_KSW), (bf16*)(ws + WS_VTSW), QSCALE, lds + 131072, RS};
        pg8::gemm_phase<pg8::EpiProj, pg8::StaticOrder, PG8_ALIGN, PG8_SP2>(lds, g, S, E);
#ifdef PROBE_DUP_P4
        grid.sync();
        pg8::gemm_phase<pg8::EpiProj, pg8::StaticOrder, PG8_ALIGN, PG8_SP2>(lds, g, S, E);
#endif
        SEAM(4);
    }
    if (IN(5)) for (int rep_ = 0; rep_ < REP_P5; ++rep_) {
        AttnP P{(const bf16*)(ws + WS_QDA), (const bf16*)(ws + WS_KDA), (const bf16*)(ws + WS_VTDA), (const bf16*)(ws + WS_QSW), (const bf16*)(ws + WS_KSW), (const bf16*)(ws + WS_VTSW), XN, rel_bias, g_subln, sink, (float*)(ws + WS_T)};
        attn_phase(lds, P, vcu, G, lq1, lk1, lq2, lk2);
        SEAM(5);
    }
    if (IN(6)) for (int rep_ = 0; rep_ < REP_P6; ++rep_) {
        pg8::Gemm g{XN, Wout, M_TOT, D_MODEL, D_MODEL}; pg8::StaticOrder S; S.init(M_TOT, D_MODEL, G, bx);
        pg8::EpiT E{T, D_MODEL, PART};
        pg8::gemm_phase<pg8::EpiT, pg8::StaticOrder, PG8_ALIGN, PG8_SP2>(lds, g, S, E);
        SEAM(6);
    }
    if (IN(7)) for (int rep_ = 0; rep_ < REP_P7; ++rep_) {
        rowpass<true, true, true, true>(gw, ngw, lane, nullptr, nullptr, H, T, PART, g_mix_post, 1.0f, nullptr, H, RS, nullptr, true);
        SEAM(7);
    }
    if (IN(8)) for (int rep_ = 0; rep_ < REP_P8; ++rep_) {
        pg8::Gemm g{H, Wgu2, M_TOT, 2 * D_FF, D_MODEL}; pg8::StaticOrder S; S.init(M_TOT, 2 * D_FF, G, bx);
        pg8::EpiSwiglu E{ACT, D_FF, RS};
        pg8::gemm_phase<pg8::EpiSwiglu, pg8::StaticOrder, PG8_ALIGN, PG8_SP2>(lds, g, S, E);
        SEAM(8);
    }
    if (IN(9)) for (int rep_ = 0; rep_ < REP_P9; ++rep_) {
        pg8::Gemm g{ACT, Wd2, M_TOT, D_MODEL, D_FF}; pg8::StaticOrder S; S.init(M_TOT, D_MODEL, G, bx, 1);
        pg8::EpiT E{T, D_MODEL, PART};
        pg8::gemm_phase<pg8::EpiT, pg8::StaticOrder, PG8_ALIGN, PG8_SP2>(lds, g, S, E);
        SEAM(9);
    }
    if (IN(10)) for (int rep_ = 0; rep_ < REP_P10; ++rep_) {
        rowpass<true, false, true, false>(gw, ngw, lane, nullptr, nullptr, H, T, PART, g_ffn2_post, 0.5f, out, nullptr, nullptr, nullptr, false);
    }
#undef IN
#undef SEAM
}

#ifndef MK_MULTI_LAUNCH
#define MK_MULTI_LAUNCH 0
#endif
extern "C" void kernel_launch(void* const* d_in, const int* in_sizes, int n_in, void* d_out, int out_size, void* d_ws, size_t ws_size, hipStream_t stream) {
    static int grid = 0;
    if (grid == 0) {
        if (n_in != 21 || out_size != M_TOT * D_MODEL || ws_size < WS_END) { fprintf(stderr, "kernel_launch: unexpected shapes (n_in %d, out %d, ws %zu)\n", n_in, out_size, ws_size); grid = -1; return; }
        int dev = 0, cus = 0, per_cu = 0;
        hipGetDevice(&dev);
        hipDeviceGetAttribute(&cus, hipDeviceAttributeMultiprocessorCount, dev);
        if (hipFuncSetAttribute((const void*)mega_fwd, hipFuncAttributeMaxDynamicSharedMemorySize, LDS_BYTES) != hipSuccess) { fprintf(stderr, "kernel_launch: hipFuncSetAttribute failed\n"); grid = -1; return; }
        if (hipOccupancyMaxActiveBlocksPerMultiprocessor(&per_cu, (const void*)mega_fwd, NTHREADS, LDS_BYTES) != hipSuccess || per_cu < 1) { fprintf(stderr, "kernel_launch: occupancy query gave %d\n", per_cu); per_cu = 1; }
        (void)hipGetLastError();
        grid = cus * per_cu;
    }
    if (grid < 0) return;
    Args a{};
    for (int i = 0; i < 21; ++i) a.in[i] = (const float*)d_in[i];
    a.out = (float*)d_out; a.ws = (unsigned char*)d_ws;
#if MK_MULTI_LAUNCH
    for (int p = 0; p < N_PHASES; ++p) {
        a.ph_lo = p; a.ph_hi = p + 1;
        hipLaunchKernelGGL(mega_fwd, dim3(grid), dim3(NTHREADS), LDS_BYTES, stream, a);
    }
#else
    a.ph_lo = 0; a.ph_hi = N_PHASES;
    void* kargs[] = {&a};
    hipError_t e = hipLaunchCooperativeKernel((const void*)mega_fwd, dim3(grid), dim3(NTHREADS), kargs, LDS_BYTES, stream);
    if (e != hipSuccess) fprintf(stderr, "cooperative launch failed: %s (grid %d)\n", hipGetErrorString(e), grid);
#endif
}
```

```cpp
#include <hip/hip_runtime.h>
#include <hip/hip_cooperative_groups.h>
#include <cstdio>
#include <cstdint>
#include <cmath>
namespace cg = cooperative_groups;
#define MK_MULTI_LAUNCH 0
namespace pg8 {
#define PG8_LAS __attribute__((address_space(3)))
typedef unsigned short bf16_t;
typedef short bf16x8 __attribute__((ext_vector_type(8)));
typedef float f32x4 __attribute__((ext_vector_type(4)));
typedef unsigned u32x4 __attribute__((ext_vector_type(4)));
constexpr int BM = 256, BK = 64, HALF = 128, HTB = HALF * BK * 2  , STAGE_BYTES = 8 * HTB, NXCD = 8, WGM = 8;

__host__ __device__ __forceinline__ int lds_byte(int r, int c) { const int st = (r >> 4) * 2 + (c >> 5), rr = r & 15, cc = c & 31, ob = rr * 64 + cc * 2; return st * 1024 + (ob ^ (((ob >> 9) & 1) << 5)); }
__host__ __device__ __forceinline__ void stage_rc(int b, int& R, int& C) { const int st = b / 1024, sb = b % 1024, swz = sb ^ (((sb >> 9) & 1) << 5); R = (st >> 1) * 16 + swz / 64; C = (st & 1) * 32 + (swz % 64) / 2; }
__host__ __device__ __forceinline__ int perm32(int rho) { const int n = rho >> 4, i = rho & 15; return 8 * (i >> 2) + 4 * n + (i & 3); }

struct Unit { int pm, pn; };
struct Gemm { const bf16_t* A; const bf16_t* Bt; int M, N, K; };

struct StaticOrder {
    int nM, nN, nwg, G, c, rev;
    __host__ __device__ void init(int M, int N, int G_, int c_, int rev_ = 0) { nM = M / BM; nN = N / BM; nwg = nM * nN; G = G_; c = c_; rev = rev_; }
    __host__ __device__ bool next(int i, Unit& u) const {
        const long L = (long)i * G + c; if (L >= nwg) return false;
        int wgid = (int)L; { const int q = nwg / NXCD, r = nwg % NXCD, xcd = wgid % NXCD, off = wgid / NXCD; wgid = (xcd < r ? xcd * (q + 1) : r * (q + 1) + (xcd - r) * q) + off; }
        const int nig = WGM * nN, gid = wgid / nig, fm = gid * WGM, gsz = (nM - fm) < WGM ? (nM - fm) : WGM;
        u.pm = fm + ((wgid % nig) % gsz); u.pn = (wgid % nig) / gsz; if (rev) u.pm = nM - 1 - u.pm; return true;
    }
    __device__ __forceinline__ void a_ready(const Unit&) const {}
    __device__ __forceinline__ void done(const Unit&) const {}
};
__device__ __forceinline__ unsigned cvt_pk_bf16(float lo, float hi) { unsigned r; asm volatile("v_cvt_pk_bf16_f32 %0, %1, %2" : "=v"(r) : "v"(lo), "v"(hi)); return r; }
typedef unsigned u32x2 __attribute__((ext_vector_type(2)));
__device__ __forceinline__ float silu_mul(float g, float u) {
    const float e = __builtin_amdgcn_exp2f(g * -1.4426950408889634f);
    return g * __builtin_amdgcn_rcpf(1.0f + e) * u;
}
struct EpiSwiglu {
    static constexpr bool PERM = true, AFTER_DRAIN = false; static constexpr int NST = 8;
    bf16_t* O; int ldc; const float* rs;
    __device__ __forceinline__ void operator()(const f32x4 (&acc)[2][2][4][2], const Unit& u, int wr, int wc, int fr, int fq) const {
        const int row0 = u.pm * BM + wr * 64 + fr, col0 = u.pn * HALF + wc * 32 + 8 * fq;
        float rv[2][4];
#pragma unroll
        for (int ai = 0; ai < 2; ++ai)
#pragma unroll
            for (int m = 0; m < 4; ++m) rv[ai][m] = rs[row0 + ai * HALF + m * 16];
#pragma unroll
        for (int ai = 0; ai < 2; ++ai)
#pragma unroll
            for (int m = 0; m < 4; ++m) {
                bf16_t* rowp = O + (size_t)(row0 + ai * HALF + m * 16) * ldc + col0;
                const float r = rv[ai][m];
                const f32x4 g0 = acc[ai][0][m][0] * r, g1 = acc[ai][0][m][1] * r, u0 = acc[ai][1][m][0] * r, u1 = acc[ai][1][m][1] * r;
                u32x4 w;
                w.x = cvt_pk_bf16(silu_mul(g0[0], u0[0]), silu_mul(g0[1], u0[1]));
                w.y = cvt_pk_bf16(silu_mul(g0[2], u0[2]), silu_mul(g0[3], u0[3]));
                w.z = cvt_pk_bf16(silu_mul(g1[0], u1[0]), silu_mul(g1[1], u1[1]));
                w.w = cvt_pk_bf16(silu_mul(g1[2], u1[2]), silu_mul(g1[3], u1[3]));
                *(u32x4*)rowp = w;
            }
    }
};
struct EpiT {
    static constexpr bool PERM = true, AFTER_DRAIN = false; static constexpr int NST = 16;
    bf16_t* O; int ldc; float* part;
    __device__ __forceinline__ void operator()(const f32x4 (&acc)[2][2][4][2], const Unit& u, int wr, int wc, int fr, int fq) const {
        const int row0 = u.pm * BM + wr * 64 + fr, col0 = u.pn * BM + wc * 32 + 8 * fq;
#pragma unroll
        for (int ai = 0; ai < 2; ++ai)
#pragma unroll
            for (int m = 0; m < 4; ++m) {
                const int row = row0 + ai * HALF + m * 16;
                bf16_t* rowp = O + (size_t)row * ldc + col0;
                float ss = 0.f;
#pragma unroll
                for (int bj = 0; bj < 2; ++bj) {
                    const f32x4 v0 = acc[ai][bj][m][0], v1 = acc[ai][bj][m][1];
                    ss += (v0[0] * v0[0] + v0[1] * v0[1]) + (v0[2] * v0[2] + v0[3] * v0[3]) + (v1[0] * v1[0] + v1[1] * v1[1]) + (v1[2] * v1[2] + v1[3] * v1[3]);
                    u32x4 w; w.x = cvt_pk_bf16(v0[0], v0[1]); w.y = cvt_pk_bf16(v0[2], v0[3]); w.z = cvt_pk_bf16(v1[0], v1[1]); w.w = cvt_pk_bf16(v1[2], v1[3]);
                    *(u32x4*)(rowp + bj * HALF) = w;
                }
                ss += __shfl_xor(ss, 16); ss += __shfl_xor(ss, 32);
                if (fq == 0) part[(size_t)row * 32 + u.pn * 4 + wc] = ss;
            }
    }
};
struct EpiProj {
    static constexpr bool PERM = true, AFTER_DRAIN = false; static constexpr int NST = 16;
    bf16_t *Qda, *Kda, *VTda, *Qsw, *Ksw, *VTsw; float qscale; PG8_LAS unsigned char* epi_lds; const float* rs;
    __device__ __forceinline__ void operator()(const f32x4 (&acc)[2][2][4][2], const Unit& u, int wr, int wc, int fr, int fq) const {
        const int pn = u.pn;
        const int row0 = u.pm * BM + wr * 64 + fr;
        const int trow = u.pm * BM;
        int S, seqbase;
        if (trow < 32768) { S = 2048; seqbase = trow & ~2047; } else { S = 4096; seqbase = 32768 + ((trow - 32768) & ~4095); }
        const int s0 = row0 - seqbase;
        float rv[2][4];
#pragma unroll
        for (int ai = 0; ai < 2; ++ai)
#pragma unroll
            for (int m = 0; m < 4; ++m) rv[ai][m] = rs[row0 + ai * HALF + m * 16];
        if (pn < 8 || (pn >= 12 && pn < 17)) {
            bf16_t* base; int colt; float sc = 1.f;
            if (pn < 4) { base = Qda + (size_t)seqbase * 1024; colt = pn * BM; sc = qscale; }
            else if (pn < 8) { base = Kda + (size_t)seqbase * 1024; colt = (pn - 4) * BM; }
            else if (pn < 16) { base = Qsw + (size_t)seqbase * 1024; colt = (pn - 12) * BM; sc = qscale; }
            else { base = Ksw + (size_t)seqbase * 256; colt = 0; }
            const int d0 = (wc & 1) * 32 + 8 * fq;
#pragma unroll
            for (int bj = 0; bj < 2; ++bj) {
                bf16_t* hb = base + (size_t)((colt >> 6) + bj * 2 + (wc >> 1)) * 64 * S + d0;
#pragma unroll
                for (int ai = 0; ai < 2; ++ai)
#pragma unroll
                    for (int m = 0; m < 4; ++m) {
                        const float r = rv[ai][m] * sc;
                        const f32x4 v0 = acc[ai][bj][m][0] * r, v1 = acc[ai][bj][m][1] * r;
                        u32x4 w; w.x = cvt_pk_bf16(v0[0], v0[1]); w.y = cvt_pk_bf16(v0[2], v0[3]); w.z = cvt_pk_bf16(v1[0], v1[1]); w.w = cvt_pk_bf16(v1[2], v1[3]);
                        *(u32x4*)(hb + (size_t)(s0 + ai * HALF + m * 16) * 64) = w;
                    }
            }
        } else {
            bf16_t* base; int colt, dvh;
            if (pn < 12) { base = VTda + (size_t)seqbase * 1024; colt = (pn - 8) * BM; dvh = 128; } else { base = VTsw + (size_t)seqbase * 256; colt = 0; dvh = 64; }
            const int lane = fq * 16 + fr;
            PG8_LAS unsigned char* wl = epi_lds + (wr * 4 + wc) * 4096;
            const int stw = (u.pm * BM + wr * 64 - seqbase) >> 6;
#pragma unroll
            for (int ai = 0; ai < 2; ++ai)
#pragma unroll
                for (int bj = 0; bj < 2; ++bj) {
#pragma unroll
                    for (int m = 0; m < 4; ++m)
#pragma unroll
                        for (int n = 0; n < 2; ++n) {
                            const f32x4 v = acc[ai][bj][m][n] * rv[ai][m];
                            const unsigned p01 = cvt_pk_bf16(v[0], v[1]), p23 = cvt_pk_bf16(v[2], v[3]);
                            const int token = m * 16 + fr, d = 8 * fq + 4 * n;
                            PG8_LAS unsigned char* wp = wl + d * 128 + (((token >> 3) ^ fq) << 4) + (token & 7) * 2;
                            *(PG8_LAS bf16_t*)(wp) = (bf16_t)(p01 & 0xffffu); *(PG8_LAS bf16_t*)(wp + 128) = (bf16_t)(p01 >> 16);
                            *(PG8_LAS bf16_t*)(wp + 256) = (bf16_t)(p23 & 0xffffu); *(PG8_LAS bf16_t*)(wp + 384) = (bf16_t)(p23 >> 16);
                        }
                    const int c0 = colt + bj * HALF + wc * 32, h = (dvh == 128) ? (c0 >> 7) : (c0 >> 6), dd0 = c0 & (dvh - 1);
                    bf16_t* blk = base + (size_t)h * dvh * S + (size_t)(stw + 2 * ai) * (dvh * 64) + dd0 * 64;
#pragma unroll
                    for (int i = 0; i < 4; ++i) {
                        const int q = lane + 64 * i, d = q >> 3, c = q & 7;
                        const u32x4 w = *(const PG8_LAS u32x4*)(wl + d * 128 + ((c ^ ((d >> 3) & 7)) << 4));
                        *(u32x4*)(blk + q * 8) = w;
                    }
                }
        }
    }
};
template <class Epi, class Sched, bool ALIGN_EPI = false, bool SP2 = false>
__device__ __forceinline__ void gemm_phase(PG8_LAS unsigned char* lds, const Gemm g, const Sched& S, const Epi& E) {
    const int tid = threadIdx.x, wid = __builtin_amdgcn_readfirstlane(tid >> 6), lane = tid & 63, wr = wid >> 2, wc = wid & 3, fr = lane & 15, fq = lane >> 4;
    const int K = g.K, nt = K / BK;
    unsigned voffA[2], voffB[2];
#pragma unroll
    for (int i = 0; i < 2; ++i) { int R, C; stage_rc(tid * 16 + i * 8192, R, C); const int Rb = Epi::PERM ? ((R & ~31) + perm32(R & 31)) : R;
        voffA[i] = (unsigned)(R * K + C) * 2u; voffB[i] = (unsigned)(Rb * K + C) * 2u; }
    const size_t kstep = (size_t)(BK * 2);
    const size_t hstep = (size_t)HALF * K * 2;
    const size_t tstep = 2 * hstep;
    const unsigned ldsw = (unsigned)wid * 1024u;
    const int aoff = lds_byte(wr * 64 + fr, fq * 8), boff = lds_byte(wc * 32 + fr, fq * 8);
#define PG8_SA(b, h) (((b) * 2 + (h)) * HTB)
#define PG8_SB(b, h) ((4 + (b) * 2 + (h)) * HTB)
#define PG8_STAGE(bufoff, gbase, voff) do { _Pragma("unroll") for (int _i = 0; _i < 2; ++_i) \
        __builtin_amdgcn_global_load_lds((const unsigned*)((const char*)(gbase) + (voff)[_i]), (PG8_LAS unsigned*)(lds + (bufoff) + ldsw + _i * 8192), 16, 0, 0); } while (0)
#define PG8_LDA(dst, b, h) do { _Pragma("unroll") for (int m = 0; m < 4; ++m) _Pragma("unroll") for (int k = 0; k < 2; ++k) dst[m][k] = *(const PG8_LAS bf16x8*)(lds + PG8_SA(b, h) + aoff + m * 2048 + k * 1024); } while (0)
#define PG8_LDB(dst, b, h) do { _Pragma("unroll") for (int n = 0; n < 2; ++n) _Pragma("unroll") for (int k = 0; k < 2; ++k) dst[n][k] = *(const PG8_LAS bf16x8*)(lds + PG8_SB(b, h) + boff + n * 2048 + k * 1024); } while (0)
#define PG8_MMA(ai, bj, At, Bt) do { __builtin_amdgcn_s_setprio(1); _Pragma("unroll") for (int m = 0; m < 4; ++m) _Pragma("unroll") for (int n = 0; n < 2; ++n) _Pragma("unroll") for (int k = 0; k < 2; ++k) \
        acc[ai][bj][m][n] = __builtin_amdgcn_mfma_f32_16x16x32_bf16(Bt[n][k], At[m][k], acc[ai][bj][m][n], 0, 0, 0); __builtin_amdgcn_s_setprio(0); } while (0)
#define PG8_WAIT_V(n) asm volatile("s_waitcnt vmcnt(" #n ")" ::: "memory")
#define PG8_WAIT_L(n) asm volatile("s_waitcnt lgkmcnt(" #n ")" ::: "memory")
#define PG8_BAR __builtin_amdgcn_s_barrier()
#define PG8_SCHED __builtin_amdgcn_sched_barrier(0)
    Unit cur, nxt; int ui = 0;
    if (!S.next(0, cur)) return;
    f32x4 acc[2][2][4][2];
#pragma unroll
    for (int a = 0; a < 2; ++a)
#pragma unroll
        for (int b = 0; b < 2; ++b)
#pragma unroll
            for (int m = 0; m < 4; ++m)
#pragma unroll
                for (int n = 0; n < 2; ++n) acc[a][b][m][n] = (f32x4){0.f, 0.f, 0.f, 0.f};
    bf16x8 At[4][2], B0[2][2], B1[2][2];
    const char* cA = (const char*)g.A + (size_t)cur.pm * tstep; const char* cB = (const char*)g.Bt + (size_t)cur.pn * tstep;
    S.a_ready(cur);
    if constexpr (SP2) {
        PG8_STAGE(PG8_SB(0, 0), cB, voffB); PG8_STAGE(PG8_SB(0, 1), cB + hstep, voffB); PG8_STAGE(PG8_SA(0, 0), cA, voffA); PG8_STAGE(PG8_SA(0, 1), cA + hstep, voffA);
        if (wr == 1) PG8_BAR;
        PG8_WAIT_V(2); PG8_BAR;
        PG8_STAGE(PG8_SB(1, 0), cB + kstep, voffB); PG8_STAGE(PG8_SA(1, 0), cA + kstep, voffA); PG8_STAGE(PG8_SB(1, 1), cB + hstep + kstep, voffB);
        PG8_WAIT_V(6); PG8_BAR;
    } else {
        PG8_STAGE(PG8_SB(0, 0), cB, voffB); PG8_STAGE(PG8_SA(0, 0), cA, voffA); PG8_STAGE(PG8_SB(0, 1), cB + hstep, voffB); PG8_STAGE(PG8_SA(0, 1), cA + hstep, voffA);
        if (wr == 1) PG8_BAR;
        PG8_WAIT_V(4); PG8_BAR;
        PG8_STAGE(PG8_SB(1, 0), cB + kstep, voffB); PG8_STAGE(PG8_SA(1, 0), cA + kstep, voffA); PG8_STAGE(PG8_SB(1, 1), cB + hstep + kstep, voffB);
        PG8_WAIT_V(6); PG8_BAR;
    }
    for (;;) {
        const bool has_next = S.next(ui + 1, nxt);
        const char* nA = has_next ? (const char*)g.A + (size_t)nxt.pm * tstep : cA; const char* nB = has_next ? (const char*)g.Bt + (size_t)nxt.pn * tstep : cB;
        for (int t = 0; t < nt; t += 2) {
            const bool last = (t == nt - 2);
            const char* a1 = cA + (size_t)(t + 1) * kstep;
            const char* a2 = last ? nA : cA + (size_t)(t + 2) * kstep; const char* b2 = last ? nB : cB + (size_t)(t + 2) * kstep;
            const char* a3 = a2 + kstep; const char* b3 = b2 + kstep;
            if (last && has_next) S.a_ready(nxt);
            if constexpr (SP2) {
            PG8_LDB(B0, 0, 0); PG8_LDB(B1, 0, 1); PG8_SCHED; PG8_LDA(At, 0, 0); PG8_STAGE(PG8_SA(1, 1), a1 + hstep, voffA);
            PG8_WAIT_V(8); PG8_WAIT_L(0); PG8_BAR; PG8_MMA(0, 0, At, B0); PG8_MMA(0, 1, At, B1); PG8_BAR; PG8_SCHED;
            PG8_LDA(At, 0, 1); PG8_STAGE(PG8_SB(0, 0), b2, voffB); PG8_STAGE(PG8_SB(0, 1), b2 + hstep, voffB); PG8_STAGE(PG8_SA(0, 0), a2, voffA);
            PG8_WAIT_V(8); PG8_WAIT_L(0); PG8_BAR; PG8_MMA(1, 0, At, B0); PG8_MMA(1, 1, At, B1); PG8_BAR; PG8_SCHED;
            PG8_LDB(B0, 1, 0); PG8_LDB(B1, 1, 1); PG8_SCHED; PG8_LDA(At, 1, 0); PG8_STAGE(PG8_SA(0, 1), a2 + hstep, voffA);
            PG8_WAIT_V(8); PG8_WAIT_L(0); PG8_BAR; PG8_MMA(0, 0, At, B0); PG8_MMA(0, 1, At, B1); PG8_BAR; PG8_SCHED;
            PG8_LDA(At, 1, 1); PG8_STAGE(PG8_SB(1, 0), b3, voffB); PG8_STAGE(PG8_SB(1, 1), b3 + hstep, voffB); PG8_STAGE(PG8_SA(1, 0), a3, voffA);
            PG8_WAIT_V(8); PG8_WAIT_L(0); PG8_BAR; PG8_MMA(1, 0, At, B0); PG8_MMA(1, 1, At, B1); PG8_BAR; PG8_SCHED;
            } else {
            PG8_LDB(B0, 0, 0); PG8_SCHED; PG8_LDA(At, 0, 0); PG8_STAGE(PG8_SA(1, 1), a1 + hstep, voffA);
            PG8_WAIT_L(8); PG8_BAR; PG8_WAIT_L(0); PG8_MMA(0, 0, At, B0); PG8_BAR; PG8_SCHED;
            PG8_LDB(B1, 0, 1); PG8_STAGE(PG8_SB(0, 0), b2, voffB);
            PG8_BAR; PG8_WAIT_L(0); PG8_MMA(0, 1, At, B1); PG8_BAR;
            PG8_LDA(At, 0, 1); PG8_STAGE(PG8_SA(0, 0), a2, voffA);
            PG8_BAR; PG8_WAIT_L(0); PG8_MMA(1, 0, At, B0); PG8_BAR; PG8_SCHED;
            PG8_STAGE(PG8_SB(0, 1), b2 + hstep, voffB);
            PG8_WAIT_V(6); PG8_BAR; PG8_MMA(1, 1, At, B1); PG8_BAR;
            PG8_LDB(B0, 1, 0); PG8_SCHED; PG8_LDA(At, 1, 0); PG8_STAGE(PG8_SA(0, 1), a2 + hstep, voffA);
            PG8_WAIT_L(8); PG8_BAR; PG8_WAIT_L(0); PG8_MMA(0, 0, At, B0); PG8_BAR; PG8_SCHED;
            PG8_LDB(B1, 1, 1); PG8_STAGE(PG8_SB(1, 0), b3, voffB);
            PG8_BAR; PG8_WAIT_L(0); PG8_MMA(0, 1, At, B1); PG8_BAR;
            PG8_LDA(At, 1, 1); PG8_STAGE(PG8_SA(1, 0), a3, voffA);
            PG8_BAR; PG8_WAIT_L(0); PG8_MMA(1, 0, At, B0); PG8_BAR; PG8_SCHED;
            PG8_STAGE(PG8_SB(1, 1), b3 + hstep, voffB);
            PG8_WAIT_V(6); PG8_BAR; PG8_MMA(1, 1, At, B1); PG8_BAR;
            }
        }
        if constexpr (ALIGN_EPI) { if (wr == 0) PG8_BAR; }
        if constexpr (!Epi::AFTER_DRAIN) { E(acc, cur, wr, wc, fr, fq); S.done(cur); }
        if (!has_next) break;
#pragma unroll
        for (int a = 0; a < 2; ++a)
#pragma unroll
            for (int b = 0; b < 2; ++b)
#pragma unroll
                for (int m = 0; m < 4; ++m)
#pragma unroll
                    for (int n = 0; n < 2; ++n) acc[a][b][m][n] = (f32x4){0.f, 0.f, 0.f, 0.f};
        cur = nxt; cA = nA; cB = nB; ++ui;
        if constexpr (ALIGN_EPI) { if (wr == 1) PG8_BAR; }
    }
    PG8_WAIT_V(0);
    if constexpr (!ALIGN_EPI) { if (wr == 0) PG8_BAR; }
    PG8_BAR;
    if constexpr (Epi::AFTER_DRAIN) { E.fused(acc, cur, wr, wc, fr, fq, lds, wid, lane); S.done(cur); }
#undef PG8_SA
#undef PG8_SB
#undef PG8_STAGE
#undef PG8_LDA
#undef PG8_LDB
#undef PG8_MMA
#undef PG8_WAIT_V
#undef PG8_WAIT_L
#undef PG8_BAR
#undef PG8_SCHED
}
}

#ifndef PG8_SP2
#define PG8_SP2 true
#endif
#ifndef PG8_ALIGN
#define PG8_ALIGN true
#endif
constexpr int D_MODEL = 2048, D_FF = 5632, D_IN = 4608;
constexpr int M_P = 16 * 2048, M_TOT = 65536;
constexpr float EPS = 1e-6f;
constexpr float LOG2E = 1.4426950408889634f;
constexpr float QSCALE = 0.125f * LOG2E;
constexpr float LAMBDA_INIT = 0.2f;
constexpr int NWAVES = 8, NTHREADS = 512;
constexpr int LDS_BYTES = 163840;

#define LAS __attribute__((address_space(3)))
typedef unsigned short bf16;
typedef short bf16x8 __attribute__((ext_vector_type(8)));
typedef float f32x16 __attribute__((ext_vector_type(16)));
typedef float f32x4 __attribute__((ext_vector_type(4)));
typedef unsigned u32x4 __attribute__((ext_vector_type(4)));
typedef unsigned u32x2 __attribute__((ext_vector_type(2)));
typedef float f32x2_t __attribute__((ext_vector_type(2)));
typedef __bf16 bf16x2_t __attribute__((ext_vector_type(2)));

constexpr size_t MiB = 1u << 20;
constexpr size_t WS_WGU1 = 0, WS_WD1 = 44 * MiB, WS_WIN = 66 * MiB, WS_WOUT = 84 * MiB, WS_WGU2 = 92 * MiB, WS_WD2 = 136 * MiB;
constexpr size_t WS_RS = 158 * MiB;
constexpr size_t WS_BAR = 159 * MiB;
constexpr size_t WS_PART = 160 * MiB;
constexpr size_t WS_XN = 168 * MiB;
constexpr size_t WS_T = 424 * MiB;
constexpr size_t WS_ACT = 680 * MiB;
constexpr size_t WS_QDA = WS_ACT, WS_KDA = WS_ACT + 128 * MiB, WS_VTDA = WS_ACT + 256 * MiB, WS_QSW = WS_ACT + 384 * MiB, WS_KSW = WS_ACT + 512 * MiB, WS_VTSW = WS_ACT + 544 * MiB;
constexpr size_t WS_H = WS_ACT + 704 * MiB;
constexpr size_t WS_END = WS_H + 256 * MiB;

__device__ __forceinline__ unsigned cvtpk(float lo, float hi) { f32x2_t v = {lo, hi}; bf16x2_t b = __builtin_convertvector(v, bf16x2_t); return __builtin_bit_cast(unsigned, b); }
__device__ __forceinline__ float hmax(float v) { auto rr = __builtin_amdgcn_permlane32_swap(__float_as_uint(v), __float_as_uint(v), false, false); return fmaxf(__uint_as_float(rr[0]), __uint_as_float(rr[1])); }
__device__ __forceinline__ float hsum(float v) { auto rr = __builtin_amdgcn_permlane32_swap(__float_as_uint(v), __float_as_uint(v), false, false); return __uint_as_float(rr[0]) + __uint_as_float(rr[1]); }
__device__ __forceinline__ float wave_sum(float v) {
#pragma unroll
    for (int o = 1; o < 64; o <<= 1) v += __shfl_xor(v, o);
    return v;
}
__device__ __forceinline__ float bf_lo(unsigned w) { return __uint_as_float(w << 16); }
__device__ __forceinline__ float bf_hi(unsigned w) { return __uint_as_float(w & 0xffff0000u); }

constexpr int A_K = 0, A_V = 32768, A_BT = 114688, A_G = 115968;

__device__ __forceinline__ int t5_bucket(int rp) {
    const int n = rp < 0 ? -rp : rp;
    int b;
    if (n < 8) b = n; else if (n < 12) b = 8; else if (n < 16) b = 9; else if (n < 23) b = 10; else if (n < 32) b = 11; else if (n < 46) b = 12; else if (n < 64) b = 13; else if (n < 91) b = 14; else b = 15;
    return b + (rp > 0 ? 16 : 0);
}

__device__ __forceinline__ float max3f(float a, float b, float c) { float r; asm("v_max3_f32 %0, %1, %2, %3" : "=v"(r) : "v"(a), "v"(b), "v"(c)); return r; }
#define SBAR() __builtin_amdgcn_sched_barrier(0)
__device__ __forceinline__ void v_reads(bf16x8 (&vf)[4], LAS unsigned char* lds, const unsigned (&vaddr)[4], unsigned off) {
#pragma unroll
    for (int c4 = 0; c4 < 4; ++c4) vf[c4] = *(const LAS bf16x8*)(lds + vaddr[c4] + off);
}
__device__ __forceinline__ void pv_mma(f32x16& o, const bf16x8 (&vf)[4], const bf16x8 (&p)[4]) {
#pragma unroll
    for (int c4 = 0; c4 < 4; ++c4) o = __builtin_amdgcn_mfma_f32_32x32x16_bf16(vf[c4], p[c4], o, 0, 0, 0);
}
template <int DV>
__device__ __forceinline__ void pv_rest(f32x16 (&o)[DV / 32], const bf16x8 (&p)[4], bf16x8 (&va)[4], bf16x8 (&vb)[4], LAS unsigned char* lds, const unsigned (&vaddr)[4], unsigned vb_) {
    if (DV == 128) {
        pv_mma(o[0], va, p); v_reads(va, lds, vaddr, vb_ + 2 * 4096); SBAR();
        pv_mma(o[1], vb, p); v_reads(vb, lds, vaddr, vb_ + 3 * 4096); SBAR();
        pv_mma(o[2], va, p); SBAR();
        pv_mma(o[DV / 32 - 1], vb, p);
    } else {
        pv_mma(o[0], va, p); SBAR();
        pv_mma(o[1], vb, p);
    }
}
__device__ __forceinline__ void glds16(const void* gsrc, unsigned lds_dst) {
    unsigned keep;
    asm volatile("s_mov_b32 %0, m0\n\ts_mov_b32 m0, %2\n\ts_nop 0\n\tglobal_load_lds_dwordx4 %1, off\n\ts_mov_b32 m0, %0" : "=&s"(keep) : "v"(gsrc), "s"(lds_dst) : "memory");
}
constexpr int NKS = 4, NVS = 5, PFD = 3;
template <int DV, bool SW>
__device__ __forceinline__ void flash(LAS unsigned char* lds, const bf16* __restrict__ Qw, int qpitch, const bf16* __restrict__ Kb, int kpitch,
                                      const bf16* __restrict__ VTb, int S, int t_lo, int t_hi, int qpos_w, bool grpB, f32x16 (&o)[DV / 32], float& mref, float& lsum) {
    const int tid = threadIdx.x, lane = tid & 63, r32 = lane & 31, hi = lane >> 5;
    const int wid = __builtin_amdgcn_readfirstlane(tid >> 6);
    const LAS float* bt = (const LAS float*)(lds + A_BT);
    const unsigned lds0 = (unsigned)(uintptr_t)lds;
    bf16x8 qf[4];
#pragma unroll
    for (int d0 = 0; d0 < 4; ++d0) qf[d0] = *(const bf16x8*)(Qw + (size_t)r32 * qpitch + d0 * 16 + hi * 8);
    const int lrow = wid * 8 + (lane >> 3), pch = lane & 7, lch = pch ^ ((lrow >> 1) & 7);
    const int rho = lrow & 31, key = (lrow & 32) + 16 * ((rho >> 2) & 1) + 4 * (rho >> 3) + (rho & 3);
    const bf16* ksrc = Kb + key * 64 + lch * 8;
    const bf16* vsrc = VTb + lrow * 64 + lch * 8;
    const unsigned kdst = lds0 + A_K + wid * 1024, vdst = lds0 + A_V + wid * 1024;
    const int sw = (r32 >> 1) & 7;
    unsigned kaddr[4], vaddr[4];
#pragma unroll
    for (int d0 = 0; d0 < 4; ++d0) kaddr[d0] = A_K + r32 * 128 + (((2 * d0 + hi) ^ sw) << 4);
#pragma unroll
    for (int c4 = 0; c4 < 4; ++c4) vaddr[c4] = A_V + r32 * 128 + (((4 * (c4 >> 1) + 2 * hi + (c4 & 1)) ^ sw) << 4);
#define FL_ISSUE(tt, ks, vs) do { const int tc_ = min((tt), t_hi - 1); \
        glds16(ksrc + (size_t)tc_ * 4096, (unsigned)__builtin_amdgcn_readfirstlane(kdst + (ks) * 8192)); \
        _Pragma("unroll") for (int i_ = 0; i_ < DV / 64; ++i_) glds16(vsrc + (size_t)tc_ * (DV * 64) + i_ * 4096, (unsigned)__builtin_amdgcn_readfirstlane(vdst + (vs) * 16384 + i_ * 8192)); } while (0)
    FL_ISSUE(t_lo, 0, 0); FL_ISSUE(t_lo + 1, 1, 1); FL_ISSUE(t_lo + 2, 2, 2);
    asm volatile("" :: "v"(qf[0]), "v"(qf[1]), "v"(qf[2]), "v"(qf[3]));
    if (DV == 128) asm volatile("s_waitcnt vmcnt(6) lgkmcnt(0)\n\ts_barrier" ::: "memory"); else asm volatile("s_waitcnt vmcnt(4) lgkmcnt(0)\n\ts_barrier" ::: "memory");
    int ks_cur = 0, ks_iss = 3;
    int vs_prev = 4, vs_cur = 0, vs_iss = 3;
    int cls_cur = 0; float cb = 0.f;
    bf16x8 p[4];
    bool have_prev = false;
    for (int t = t_lo; t <= t_hi; ++t) {
        bool issued = false;
        if (grpB && have_prev) {
            bf16x8 va[4], vb[4];
            v_reads(va, lds, vaddr, (unsigned)vs_prev * 16384); v_reads(vb, lds, vaddr, (unsigned)vs_prev * 16384 + 4096); SBAR();
            pv_rest<DV>(o, p, va, vb, lds, vaddr, (unsigned)vs_prev * 16384);
        }
        const int kt = t * 64;
        bool active = (t < t_hi);
        if (SW) active = active && (kt + 63 >= qpos_w - 128) && (kt <= qpos_w + 31 + 128);
        if (active) {
            const unsigned kb_ = (unsigned)ks_cur * 8192;
            bf16x8 kf[8];
#pragma unroll
            for (int d0 = 0; d0 < 4; ++d0) { kf[2 * d0] = *(const LAS bf16x8*)(lds + kaddr[d0] + kb_); kf[2 * d0 + 1] = *(const LAS bf16x8*)(lds + kaddr[d0] + kb_ + 4096); }
            SBAR();
            const int rpmin = kt - (qpos_w + 31), rpmax = kt + 63 - qpos_w;
            const int cls = SW ? 0 : (rpmax <= -91 ? 1 : (rpmin >= 91 ? 2 : 0));
            if (cls != cls_cur) { cls_cur = cls; cb = (cls == 0) ? 0.f : (cls == 1 ? bt[0] : bt[258]); }
            f32x16 s0, s1;
            s0 = __builtin_amdgcn_mfma_f32_32x32x16_bf16(kf[0], qf[0], f32x16{}, 0, 0, 0);
            s1 = __builtin_amdgcn_mfma_f32_32x32x16_bf16(kf[1], qf[0], f32x16{}, 0, 0, 0);
#pragma unroll
            for (int d0 = 1; d0 < 4; ++d0) {
                s0 = __builtin_amdgcn_mfma_f32_32x32x16_bf16(kf[2 * d0], qf[d0], s0, 0, 0, 0);
                s1 = __builtin_amdgcn_mfma_f32_32x32x16_bf16(kf[2 * d0 + 1], qf[d0], s1, 0, 0, 0);
            }
#ifdef PROBE_EXTRA_MFMA
            { f32x16 dm_;
#pragma unroll
              for (int d0 = 0; d0 < 4; ++d0) { asm volatile("v_mfma_f32_32x32x16_bf16 %0, %1, %2, 0" : "=v"(dm_) : "v"(kf[2 * d0]), "v"(qf[d0])); asm volatile("v_mfma_f32_32x32x16_bf16 %0, %1, %2, 0" : "=v"(dm_) : "v"(kf[2 * d0 + 1]), "v"(qf[d0])); } }
#endif
            bf16x8 va[4], vb[4];
            if (!grpB) { v_reads(va, lds, vaddr, (unsigned)vs_cur * 16384); v_reads(vb, lds, vaddr, (unsigned)vs_cur * 16384 + 4096); }
            SBAR();
            if (cls == 0) {
                const int a0 = (kt + 16 * hi - (qpos_w + r32) + 129) * 4 + A_BT;
#pragma unroll
                for (int rg = 0; rg < 4; ++rg) {
#pragma unroll
                    for (int r = 4 * rg; r < 4 * rg + 4; ++r) {
                        const int aa = min(max(a0 + 4 * r, A_BT), A_BT + 258 * 4), ab = min(max(a0 + 4 * r + 128, A_BT), A_BT + 258 * 4);
                        s0[r] += *(const LAS float*)(lds + aa);
                        s1[r] += *(const LAS float*)(lds + ab);
                    }
                    SBAR();
                }
            }
            float mx = max3f(s0[0], s1[0], s0[1]);
            mx = max3f(mx, s1[1], s0[2]);
#pragma unroll
            for (int r = 2; r < 15; ++r) mx = max3f(mx, s1[r], s0[r + 1]);
            mx = fmaxf(mx, s1[15]);
            mx = hmax(mx) + (cb - mref);
            if (__any(mx > 8.0f)) {
                const float dl = fmaxf(mx, 0.f);
                mref += dl;
                const float f = __builtin_amdgcn_exp2f(-dl);
                lsum *= f;
#pragma unroll
                for (int db = 0; db < DV / 32; ++db) o[db] *= f;
            }
            FL_ISSUE(t + PFD, ks_iss, vs_iss); issued = true;
            const float off = mref - cb;
            s0 = s0 - off; s1 = s1 - off;
#pragma unroll
            for (int r = 0; r < 16; ++r) { s0[r] = __builtin_amdgcn_exp2f(s0[r]); s1[r] = __builtin_amdgcn_exp2f(s1[r]); }
#ifdef PROBE_EXTRA_EXP
#pragma unroll
            for (int r = 0; r < 16; ++r) { float t0_, t1_; asm volatile("v_exp_f32 %0, %1" : "=v"(t0_) : "v"(s0[r])); asm volatile("v_exp_f32 %0, %1" : "=v"(t1_) : "v"(s1[r])); }
#endif
#ifdef PROBE_EXTRA_VALU
#pragma unroll
            for (int r = 0; r < 16; ++r) { float t0_, t1_, t2_, t3_; asm volatile("v_add_f32 %0, %1, %1" : "=v"(t0_) : "v"(s0[r])); asm volatile("v_add_f32 %0, %1, %1" : "=v"(t1_) : "v"(s1[r])); asm volatile("v_add_f32 %0, %1, %1" : "=v"(t2_) : "v"(s0[r])); asm volatile("v_add_f32 %0, %1, %1" : "=v"(t3_) : "v"(s1[r])); }
#endif
            {
                const f32x16 sm = s0 + s1;
                lsum += ((sm[0] + sm[1]) + (sm[2] + sm[3])) + ((sm[4] + sm[5]) + (sm[6] + sm[7])) + (((sm[8] + sm[9]) + (sm[10] + sm[11])) + ((sm[12] + sm[13]) + (sm[14] + sm[15])));
            }
            {
                u32x4 w;
                w.x = cvtpk(s0[0], s0[1]); w.y = cvtpk(s0[2], s0[3]); w.z = cvtpk(s0[4], s0[5]); w.w = cvtpk(s0[6], s0[7]); p[0] = __builtin_bit_cast(bf16x8, w);
                w.x = cvtpk(s0[8], s0[9]); w.y = cvtpk(s0[10], s0[11]); w.z = cvtpk(s0[12], s0[13]); w.w = cvtpk(s0[14], s0[15]); p[1] = __builtin_bit_cast(bf16x8, w);
                w.x = cvtpk(s1[0], s1[1]); w.y = cvtpk(s1[2], s1[3]); w.z = cvtpk(s1[4], s1[5]); w.w = cvtpk(s1[6], s1[7]); p[2] = __builtin_bit_cast(bf16x8, w);
                w.x = cvtpk(s1[8], s1[9]); w.y = cvtpk(s1[10], s1[11]); w.z = cvtpk(s1[12], s1[13]); w.w = cvtpk(s1[14], s1[15]); p[3] = __builtin_bit_cast(bf16x8, w);
            }
            if (!grpB) { SBAR(); pv_rest<DV>(o, p, va, vb, lds, vaddr, (unsigned)vs_cur * 16384); }
        }
        if (!issued) FL_ISSUE(t + PFD, ks_iss, vs_iss);
        have_prev = active;
        if (DV == 128) asm volatile("s_waitcnt vmcnt(6) lgkmcnt(0)\n\ts_barrier" ::: "memory"); else asm volatile("s_waitcnt vmcnt(4) lgkmcnt(0)\n\ts_barrier" ::: "memory");
        ks_cur = (ks_cur + 1) & 3; ks_iss = (ks_iss + 1) & 3;
        vs_prev = vs_cur; vs_cur = (vs_cur == NVS - 1) ? 0 : vs_cur + 1; vs_iss = (vs_iss == NVS - 1) ? 0 : vs_iss + 1;
    }
    asm volatile("s_waitcnt vmcnt(0)" ::: "memory");
    __syncthreads();
#undef FL_ISSUE
}

template <bool ISSUE>
__device__ __forceinline__ void da_tile(LAS unsigned char* lds, int t, int NT, int qpos_w, int r32, int hi, const bf16x8 (&qf)[4], const unsigned (&kaddr)[4], const unsigned (&vaddr)[4],
                                        const bf16* ksrc, const bf16* vsrc, unsigned kdst, unsigned vdst, int& cls_cur, float& cb, f32x16 (&o)[4], float& mref, float& lsum) {
    const LAS float* bt = (const LAS float*)(lds + A_BT);
    const unsigned kb_ = (unsigned)(t & 3) * 8192, vb_ = (unsigned)(t & 3) * 16384;
    bf16x8 kf[8];
#pragma unroll
    for (int d0 = 0; d0 < 4; ++d0) { kf[2 * d0] = *(const LAS bf16x8*)(lds + kaddr[d0] + kb_); kf[2 * d0 + 1] = *(const LAS bf16x8*)(lds + kaddr[d0] + kb_ + 4096); }
    SBAR();
    const int kt = t * 64;
    const int rpmin = kt - (qpos_w + 31), rpmax = kt + 63 - qpos_w;
    const int cls = (rpmax <= -91 ? 1 : (rpmin >= 91 ? 2 : 0));
    if (cls != cls_cur) { cls_cur = cls; cb = (cls == 0) ? 0.f : (cls == 1 ? bt[0] : bt[258]); }
    f32x16 s0, s1;
    s0 = __builtin_amdgcn_mfma_f32_32x32x16_bf16(kf[0], qf[0], f32x16{}, 0, 0, 0);
    s1 = __builtin_amdgcn_mfma_f32_32x32x16_bf16(kf[1], qf[0], f32x16{}, 0, 0, 0);
#pragma unroll
    for (int d0 = 1; d0 < 4; ++d0) {
        s0 = __builtin_amdgcn_mfma_f32_32x32x16_bf16(kf[2 * d0], qf[d0], s0, 0, 0, 0);
        s1 = __builtin_amdgcn_mfma_f32_32x32x16_bf16(kf[2 * d0 + 1], qf[d0], s1, 0, 0, 0);
    }
    bf16x8 va[4], vb[4];
    v_reads(va, lds, vaddr, vb_);
    SBAR();
    if (cls == 0) {
        int a0 = (kt + 16 * hi - (qpos_w + r32) + 129) * 4 + A_BT; asm volatile("" : "+v"(a0));
#pragma unroll
        for (int rg = 0; rg < 4; ++rg) {
#pragma unroll
            for (int r = 4 * rg; r < 4 * rg + 4; ++r) {
                const int aa = min(max(a0 + 4 * r, A_BT), A_BT + 258 * 4), ab = min(max(a0 + 4 * r + 128, A_BT), A_BT + 258 * 4);
                s0[r] += *(const LAS float*)(lds + aa);
                s1[r] += *(const LAS float*)(lds + ab);
            }
            SBAR();
        }
    }
    float mx;
    {
        float m0 = max3f(s0[0], s0[1], s0[2]), m1 = max3f(s0[8], s0[9], s0[10]), m2 = max3f(s1[0], s1[1], s1[2]), m3 = max3f(s1[8], s1[9], s1[10]);
        m0 = max3f(m0, s0[3], s0[4]); m1 = max3f(m1, s0[11], s0[12]); m2 = max3f(m2, s1[3], s1[4]); m3 = max3f(m3, s1[11], s1[12]);
        m0 = max3f(m0, s0[5], s0[6]); m1 = max3f(m1, s0[13], s0[14]); m2 = max3f(m2, s1[5], s1[6]); m3 = max3f(m3, s1[13], s1[14]);
        m0 = max3f(m0, s0[7], s0[15]); m2 = max3f(m2, s1[7], s1[15]);
        mx = max3f(max3f(m0, m1, m2), m3, m3);
    }
    mx = hmax(mx) + (cb - mref);
    if (__any(mx > 8.0f)) {
        const float dl = fmaxf(mx, 0.f);
        mref += dl;
        const float f = __builtin_amdgcn_exp2f(-dl);
        lsum *= f;
#pragma unroll
        for (int db = 0; db < 4; ++db) o[db] *= f;
    }
    if (ISSUE) {
        if (t + 2 < NT) {
            glds16(ksrc + (size_t)(t + 2) * 4096, (unsigned)__builtin_amdgcn_readfirstlane(kdst + ((t + 2) & 3) * 8192));
            glds16(vsrc + (size_t)(t + 2) * 8192, (unsigned)__builtin_amdgcn_readfirstlane(vdst + ((t + 2) & 3) * 16384));
            glds16(vsrc + (size_t)(t + 2) * 8192 + 4096, (unsigned)__builtin_amdgcn_readfirstlane(vdst + ((t + 2) & 3) * 16384 + 8192));
            glds16(ksrc + (size_t)(t + 3) * 4096, (unsigned)__builtin_amdgcn_readfirstlane(kdst + ((t + 3) & 3) * 8192));
            glds16(vsrc + (size_t)(t + 3) * 8192, (unsigned)__builtin_amdgcn_readfirstlane(vdst + ((t + 3) & 3) * 16384));
            glds16(vsrc + (size_t)(t + 3) * 8192 + 4096, (unsigned)__builtin_amdgcn_readfirstlane(vdst + ((t + 3) & 3) * 16384 + 8192));
        }
    }
    const float off = mref - cb;
    s0 = s0 - off; s1 = s1 - off;
#pragma unroll
    for (int r = 0; r < 16; ++r) { s0[r] = __builtin_amdgcn_exp2f(s0[r]); s1[r] = __builtin_amdgcn_exp2f(s1[r]); }
    {
        const f32x16 sm = s0 + s1;
        lsum += ((sm[0] + sm[1]) + (sm[2] + sm[3])) + ((sm[4] + sm[5]) + (sm[6] + sm[7])) + (((sm[8] + sm[9]) + (sm[10] + sm[11])) + ((sm[12] + sm[13]) + (sm[14] + sm[15])));
    }
    bf16x8 p[4];
    {
        u32x4 w;
        w.x = cvtpk(s0[0], s0[1]); w.y = cvtpk(s0[2], s0[3]); w.z = cvtpk(s0[4], s0[5]); w.w = cvtpk(s0[6], s0[7]); p[0] = __builtin_bit_cast(bf16x8, w);
        w.x = cvtpk(s0[8], s0[9]); w.y = cvtpk(s0[10], s0[11]); w.z = cvtpk(s0[12], s0[13]); w.w = cvtpk(s0[14], s0[15]); p[1] = __builtin_bit_cast(bf16x8, w);
        w.x = cvtpk(s1[0], s1[1]); w.y = cvtpk(s1[2], s1[3]); w.z = cvtpk(s1[4], s1[5]); w.w = cvtpk(s1[6], s1[7]); p[2] = __builtin_bit_cast(bf16x8, w);
        w.x = cvtpk(s1[8], s1[9]); w.y = cvtpk(s1[10], s1[11]); w.z = cvtpk(s1[12], s1[13]); w.w = cvtpk(s1[14], s1[15]); p[3] = __builtin_bit_cast(bf16x8, w);
    }
    v_reads(vb, lds, vaddr, vb_ + 4096);
    SBAR();
    pv_rest<128>(o, p, va, vb, lds, vaddr, vb_);
}
__device__ __forceinline__ void flash_da2(LAS unsigned char* lds, const bf16* __restrict__ Qw, const bf16* __restrict__ Kb, const bf16* __restrict__ VTb,
                                          int NT, int qpos_w, f32x16 (&o)[4], float& mref, float& lsum) {
    const int tid = threadIdx.x, lane = tid & 63, r32 = lane & 31, hi = lane >> 5;
    const int wid = __builtin_amdgcn_readfirstlane(tid >> 6);
    const unsigned lds0 = (unsigned)(uintptr_t)lds;
    bf16x8 qf[4];
#pragma unroll
    for (int d0 = 0; d0 < 4; ++d0) qf[d0] = *(const bf16x8*)(Qw + (size_t)r32 * 64 + d0 * 16 + hi * 8);
    const int lrow = wid * 8 + (lane >> 3), pch = lane & 7, lch = pch ^ ((lrow >> 1) & 7);
    const int rho = lrow & 31, key = (lrow & 32) + 16 * ((rho >> 2) & 1) + 4 * (rho >> 3) + (rho & 3);
    const bf16* ksrc = Kb + key * 64 + lch * 8;
    const bf16* vsrc = VTb + lrow * 64 + lch * 8;
    const unsigned kdst = lds0 + A_K + wid * 1024, vdst = lds0 + A_V + wid * 1024;
    const int sw = (r32 >> 1) & 7;
    unsigned kaddr[4], vaddr[4];
#pragma unroll
    for (int d0 = 0; d0 < 4; ++d0) kaddr[d0] = A_K + r32 * 128 + (((2 * d0 + hi) ^ sw) << 4);
#pragma unroll
    for (int c4 = 0; c4 < 4; ++c4) vaddr[c4] = A_V + r32 * 128 + (((4 * (c4 >> 1) + 2 * hi + (c4 & 1)) ^ sw) << 4);
#pragma unroll
    for (int j = 0; j < 2; ++j) {
        glds16(ksrc + (size_t)j * 4096, (unsigned)__builtin_amdgcn_readfirstlane(kdst + j * 8192));
        glds16(vsrc + (size_t)j * 8192, (unsigned)__builtin_amdgcn_readfirstlane(vdst + j * 16384));
        glds16(vsrc + (size_t)j * 8192 + 4096, (unsigned)__builtin_amdgcn_readfirstlane(vdst + j * 16384 + 8192));
    }
    asm volatile("" :: "v"(qf[0]), "v"(qf[1]), "v"(qf[2]), "v"(qf[3]));
    asm volatile("s_waitcnt vmcnt(0) lgkmcnt(0)\n\ts_barrier" ::: "memory");
    int cls_cur = 0; float cb = 0.f;
#pragma unroll 1
    for (int t = 0; t < NT; t += 2) {
        da_tile<true>(lds, t, NT, qpos_w, r32, hi, qf, kaddr, vaddr, ksrc, vsrc, kdst, vdst, cls_cur, cb, o, mref, lsum);
        da_tile<false>(lds, t + 1, NT, qpos_w, r32, hi, qf, kaddr, vaddr, ksrc, vsrc, kdst, vdst, cls_cur, cb, o, mref, lsum);
        asm volatile("s_waitcnt vmcnt(0) lgkmcnt(0)\n\ts_barrier" ::: "memory");
    }
}

struct AttnP {
    const bf16 *Qda, *Kda, *VTda, *Qsw, *Ksw, *VTsw; bf16* O;
    const float *rel_bias, *subln_g, *sink; float* stash;
};

__device__ __forceinline__ void bias_table(LAS unsigned char* lds, const float* rel_bias, int head, bool mask) {
    LAS float* bt = (LAS float*)(lds + A_BT);
    for (int i = threadIdx.x; i < 259; i += NTHREADS) {
        const int rp = i - 129;
        bt[i] = (mask && (rp < -128 || rp > 128)) ? -INFINITY : rel_bias[t5_bucket(rp) * 24 + head] * LOG2E;
    }
}

__device__ __forceinline__ void da_unit(LAS unsigned char* lds, const AttnP& P, int seqbase, int S, int h, int qb, float lam) {
    const int tid = threadIdx.x, lane = tid & 63, r32 = lane & 31, hi = lane >> 5, wid = __builtin_amdgcn_readfirstlane(tid >> 6);
    bias_table(lds, P.rel_bias, h, false);
    const int qpos_w = qb * 256 + wid * 32;
    const size_t row_w = (size_t)seqbase + qpos_w;
    const bf16* Kb = P.Kda + (size_t)seqbase * 1024 + (size_t)(h * 2) * 64 * S;
    const bf16* Qb = P.Qda + (size_t)seqbase * 1024 + (size_t)(h * 2) * 64 * S + (size_t)qpos_w * 64;
    const bf16* VTb = P.VTda + (size_t)seqbase * 1024 + (size_t)(h * 128) * S;
    f32x16 o[4];
    float ss = 0.f;
#pragma unroll 1
    for (int map = 0; map < 2; ++map) {
#pragma unroll
        for (int db = 0; db < 4; ++db) o[db] = f32x16{};
        float mref = 0.f, l = 0.f;
        flash_da2(lds, Qb + (size_t)map * 64 * S, Kb + (size_t)map * 64 * S, VTb, S / 64, qpos_w, o, mref, l);
        int tid3 = threadIdx.x; asm volatile("" : "+v"(tid3));
        f32x4* stash = (f32x4*)(P.stash + (size_t)blockIdx.x * 32768 + tid3 * 64);
        if (map == 0) {
            const float inv = 1.0f / hsum(l);
#pragma unroll
            for (int db = 0; db < 4; ++db)
#pragma unroll
                for (int g = 0; g < 4; ++g) stash[db * 4 + g] = (f32x4){o[db][4 * g], o[db][4 * g + 1], o[db][4 * g + 2], o[db][4 * g + 3]} * inv;
        } else {
            const float inv = lam / hsum(l);
#pragma unroll
            for (int db = 0; db < 4; ++db)
#pragma unroll
                for (int g = 0; g < 4; ++g) {
                    const f32x4 st = stash[db * 4 + g];
#pragma unroll
                    for (int e = 0; e < 4; ++e) { const float a = st[e] - o[db][4 * g + e] * inv; o[db][4 * g + e] = a; ss += a * a; }
                }
        }
    }
    ss = hsum(ss);
    const float rstd = __builtin_amdgcn_rsqf(ss * (1.0f / 128.0f) + EPS) * (1.0f - LAMBDA_INIT);
    int tid2 = threadIdx.x; asm volatile("" : "+v"(tid2));
    const int r32e = tid2 & 31, hie = (tid2 >> 5) & 1;
    bf16* orow = P.O + (row_w + r32e) * 2048 + h * 128 + 4 * hie;
    const LAS unsigned char* gb = lds + A_G + hie * 16;
#pragma unroll
    for (int db = 0; db < 4; ++db)
#pragma unroll
        for (int g4 = 0; g4 < 4; ++g4) {
            const int d0 = 32 * db + 8 * g4;
            const f32x4 gv = *(const LAS f32x4*)(gb + d0 * 4);
            u32x2 w;
            w.x = cvtpk(o[db][4 * g4] * rstd * gv[0], o[db][4 * g4 + 1] * rstd * gv[1]);
            w.y = cvtpk(o[db][4 * g4 + 2] * rstd * gv[2], o[db][4 * g4 + 3] * rstd * gv[3]);
            *(u32x2*)(orow + d0) = w;
        }
}

__device__ __forceinline__ void sw_unit(LAS unsigned char* lds, const AttnP& P, int blk, int qh) {
    const int tid = threadIdx.x, lane = tid & 63, r32 = lane & 31, hi = lane >> 5, wid = __builtin_amdgcn_readfirstlane(tid >> 6);
    const int row0 = blk * 256;
    int S, seqbase;
    if (row0 < M_P) { S = 2048; seqbase = row0 & ~2047; } else { S = 4096; seqbase = M_P + ((row0 - M_P) & ~4095); }
    const int q0 = row0 - seqbase;
    bias_table(lds, P.rel_bias, 8 + qh, true);
    const int kvh = qh >> 2;
    const int t_lo = max(0, q0 - 128) >> 6, t_hi = min(S, q0 + 384) >> 6;
    const int qpos_w = q0 + wid * 32;
    const size_t row_w = (size_t)row0 + wid * 32;
    f32x16 o[2];
    o[0] = f32x16{}; o[1] = f32x16{};
    float mref = 0.f, l = 0.f;
    flash<64, true>(lds, P.Qsw + (size_t)seqbase * 1024 + (size_t)qh * 64 * S + (size_t)qpos_w * 64, 64, P.Ksw + (size_t)seqbase * 256 + (size_t)kvh * 64 * S, 64, P.VTsw + (size_t)seqbase * 256 + (size_t)(kvh * 64) * S, S, t_lo, t_hi, qpos_w, wid >= 4, o, mref, l);
    const float lt = hsum(l) + __builtin_amdgcn_exp2f(P.sink[qh] * LOG2E - mref);
    const float inv = 1.0f / lt;
    bf16* orow = P.O + (row_w + r32) * 2048 + 1024 + qh * 64;
#pragma unroll
    for (int db = 0; db < 2; ++db)
#pragma unroll
        for (int g4 = 0; g4 < 4; ++g4) {
            const int d0 = 32 * db + 8 * g4 + 4 * hi;
            u32x2 w;
            w.x = cvtpk(o[db][4 * g4] * inv, o[db][4 * g4 + 1] * inv);
            w.y = cvtpk(o[db][4 * g4 + 2] * inv, o[db][4 * g4 + 3] * inv);
            *(u32x2*)(orow + d0) = w;
        }
}

constexpr int A_K8 = 0, A_V8 = 65536, A_BT4 = 131072;
__device__ __forceinline__ void sw_unit4(LAS unsigned char* lds, const AttnP& P, int blk, int kvh) {
    const int tid = threadIdx.x, lane = tid & 63, r32 = lane & 31, hi = lane >> 5, wid = __builtin_amdgcn_readfirstlane(tid >> 6);
    const unsigned lds0 = (unsigned)(uintptr_t)lds;
    const int row0 = blk * 256;
    int S, seqbase;
    if (row0 < M_P) { S = 2048; seqbase = row0 & ~2047; } else { S = 4096; seqbase = M_P + ((row0 - M_P) & ~4095); }
    const int q0 = row0 - seqbase;
    const int t_lo = max(0, q0 - 128) >> 6, t_hi = min(S, q0 + 384) >> 6;
    for (int i = tid; i < 4 * 452; i += NTHREADS) {
        const int g = i / 452, e = i - g * 452, rp = e - 224;
        ((LAS float*)(lds + A_BT4))[i] = (rp < -128 || rp > 128) ? -INFINITY : P.rel_bias[t5_bucket(rp) * 24 + 8 + kvh * 4 + g] * LOG2E;
    }
    {
        const int lrow = wid * 8 + (lane >> 3), pch = lane & 7, lch = pch ^ ((lrow >> 1) & 7);
        const int rho = lrow & 31, key = (lrow & 32) + 16 * ((rho >> 2) & 1) + 4 * (rho >> 3) + (rho & 3);
        const bf16* ksrc = P.Ksw + (size_t)seqbase * 256 + (size_t)kvh * 64 * S + key * 64 + lch * 8;
        const bf16* vsrc = P.VTsw + (size_t)seqbase * 256 + (size_t)(kvh * 64) * S + lrow * 64 + lch * 8;
        for (int t = t_lo; t < t_hi; ++t) {
            glds16(ksrc + (size_t)t * 4096, (unsigned)__builtin_amdgcn_readfirstlane(lds0 + A_K8 + (t - t_lo) * 8192 + wid * 1024));
            glds16(vsrc + (size_t)t * 4096, (unsigned)__builtin_amdgcn_readfirstlane(lds0 + A_V8 + (t - t_lo) * 8192 + wid * 1024));
        }
    }
    const int sw = (r32 >> 1) & 7;
    unsigned kaddr[4], vaddr[4];
#pragma unroll
    for (int d0 = 0; d0 < 4; ++d0) kaddr[d0] = A_K8 + r32 * 128 + (((2 * d0 + hi) ^ sw) << 4);
#pragma unroll
    for (int c4 = 0; c4 < 4; ++c4) vaddr[c4] = A_V8 + r32 * 128 + (((4 * (c4 >> 1) + 2 * hi + (c4 & 1)) ^ sw) << 4);
    const int qpos_w = q0 + wid * 32;
    const size_t row_w = (size_t)row0 + wid * 32;
    asm volatile("s_waitcnt vmcnt(0) lgkmcnt(0)\n\ts_barrier" ::: "memory");
    const bf16* Qg = P.Qsw + (size_t)seqbase * 1024 + (size_t)(kvh * 4) * 64 * S + (size_t)qpos_w * 64 + (size_t)r32 * 64 + hi * 8;
    bf16x8 qn[4];
#pragma unroll
    for (int d0 = 0; d0 < 4; ++d0) qn[d0] = *(const bf16x8*)(Qg + d0 * 16);
#pragma unroll 1
    for (int g = 0; g < 4; ++g) {
        const int qh = kvh * 4 + g;
        bf16x8 qf[4];
#pragma unroll
        for (int d0 = 0; d0 < 4; ++d0) qf[d0] = qn[d0];
        if (g < 3) {
#pragma unroll
            for (int d0 = 0; d0 < 4; ++d0) qn[d0] = *(const bf16x8*)(Qg + (size_t)(g + 1) * 64 * S + d0 * 16);
        }
        const int btg = A_BT4 + g * 1808;
        f32x16 o[2]; o[0] = f32x16{}; o[1] = f32x16{};
        float mref = 0.f, lsum = 0.f;
#pragma unroll 1
        for (int t = t_lo; t < t_hi; ++t) {
            const int kt = t * 64;
            if (!((kt + 63 >= qpos_w - 128) && (kt <= qpos_w + 31 + 128))) continue;
            const unsigned sl = (unsigned)(t - t_lo) * 8192;
            bf16x8 kf[8];
#pragma unroll
            for (int d0 = 0; d0 < 4; ++d0) { kf[2 * d0] = *(const LAS bf16x8*)(lds + kaddr[d0] + sl); kf[2 * d0 + 1] = *(const LAS bf16x8*)(lds + kaddr[d0] + sl + 4096); }
            f32x16 s0, s1;
            s0 = __builtin_amdgcn_mfma_f32_32x32x16_bf16(kf[0], qf[0], f32x16{}, 0, 0, 0);
            s1 = __builtin_amdgcn_mfma_f32_32x32x16_bf16(kf[1], qf[0], f32x16{}, 0, 0, 0);
#pragma unroll
            for (int d0 = 1; d0 < 4; ++d0) {
                s0 = __builtin_amdgcn_mfma_f32_32x32x16_bf16(kf[2 * d0], qf[d0], s0, 0, 0, 0);
                s1 = __builtin_amdgcn_mfma_f32_32x32x16_bf16(kf[2 * d0 + 1], qf[d0], s1, 0, 0, 0);
            }
            bf16x8 va[4], vb[4];
            v_reads(va, lds, vaddr, sl); v_reads(vb, lds, vaddr, sl + 4096);
            SBAR();
            {
                const LAS float* tb = (const LAS float*)(lds + btg) + (kt + 16 * hi - (qpos_w + r32) + 224);
#pragma unroll
                for (int rg = 0; rg < 4; ++rg) {
#pragma unroll
                    for (int r = 4 * rg; r < 4 * rg + 4; ++r) { s0[r] += tb[r]; s1[r] += tb[r + 32]; }
                    SBAR();
                }
            }
            float mx;
            {
                float m0 = max3f(s0[0], s0[1], s0[2]), m1 = max3f(s0[8], s0[9], s0[10]), m2 = max3f(s1[0], s1[1], s1[2]), m3 = max3f(s1[8], s1[9], s1[10]);
                m0 = max3f(m0, s0[3], s0[4]); m1 = max3f(m1, s0[11], s0[12]); m2 = max3f(m2, s1[3], s1[4]); m3 = max3f(m3, s1[11], s1[12]);
                m0 = max3f(m0, s0[5], s0[6]); m1 = max3f(m1, s0[13], s0[14]); m2 = max3f(m2, s1[5], s1[6]); m3 = max3f(m3, s1[13], s1[14]);
                m0 = max3f(m0, s0[7], s0[15]); m2 = max3f(m2, s1[7], s1[15]);
                mx = max3f(max3f(m0, m1, m2), m3, m3);
            }
            mx = hmax(mx) - mref;
            if (__any(mx > 8.0f)) {
                const float dl = fmaxf(mx, 0.f);
                mref += dl;
                const float f = __builtin_amdgcn_exp2f(-dl);
                lsum *= f; o[0] *= f; o[1] *= f;
            }
            s0 = s0 - mref; s1 = s1 - mref;
#pragma unroll
            for (int r = 0; r < 16; ++r) { s0[r] = __builtin_amdgcn_exp2f(s0[r]); s1[r] = __builtin_amdgcn_exp2f(s1[r]); }
            {
                const f32x16 sm = s0 + s1;
                lsum += ((sm[0] + sm[1]) + (sm[2] + sm[3])) + ((sm[4] + sm[5]) + (sm[6] + sm[7])) + (((sm[8] + sm[9]) + (sm[10] + sm[11])) + ((sm[12] + sm[13]) + (sm[14] + sm[15])));
            }
            bf16x8 p[4];
            {
                u32x4 w;
                w.x = cvtpk(s0[0], s0[1]); w.y = cvtpk(s0[2], s0[3]); w.z = cvtpk(s0[4], s0[5]); w.w = cvtpk(s0[6], s0[7]); p[0] = __builtin_bit_cast(bf16x8, w);
                w.x = cvtpk(s0[8], s0[9]); w.y = cvtpk(s0[10], s0[11]); w.z = cvtpk(s0[12], s0[13]); w.w = cvtpk(s0[14], s0[15]); p[1] = __builtin_bit_cast(bf16x8, w);
                w.x = cvtpk(s1[0], s1[1]); w.y = cvtpk(s1[2], s1[3]); w.z = cvtpk(s1[4], s1[5]); w.w = cvtpk(s1[6], s1[7]); p[2] = __builtin_bit_cast(bf16x8, w);
                w.x = cvtpk(s1[8], s1[9]); w.y = cvtpk(s1[10], s1[11]); w.z = cvtpk(s1[12], s1[13]); w.w = cvtpk(s1[14], s1[15]); p[3] = __builtin_bit_cast(bf16x8, w);
            }
            SBAR();
            pv_mma(o[0], va, p); pv_mma(o[1], vb, p);
        }
        const float lt = hsum(lsum) + __builtin_amdgcn_exp2f(P.sink[qh] * LOG2E - mref);
        const float inv = 1.0f / lt;
        bf16* orow = P.O + (row_w + r32) * 2048 + 1024 + qh * 64 + 4 * hi;
#pragma unroll
        for (int db = 0; db < 2; ++db)
#pragma unroll
            for (int g4 = 0; g4 < 4; ++g4) {
                u32x2 w;
                w.x = cvtpk(o[db][4 * g4] * inv, o[db][4 * g4 + 1] * inv);
                w.y = cvtpk(o[db][4 * g4 + 2] * inv, o[db][4 * g4 + 3] * inv);
                *(u32x2*)(orow + 32 * db + 8 * g4) = w;
            }
    }
    asm volatile("s_waitcnt vmcnt(0) lgkmcnt(0)\n\ts_barrier" ::: "memory");
}

__device__ __forceinline__ void attn_phase(LAS unsigned char* lds, const AttnP& P, int vcu, int G, const float* lq1, const float* lk1, const float* lq2, const float* lk2) {
    const int lane = threadIdx.x & 63;
    const float s1 = wave_sum(lq1[lane] * lk1[lane]), s2 = wave_sum(lq2[lane] * lk2[lane]);
    const float lam = __expf(s1) - __expf(s2) + LAMBDA_INIT;
    if (threadIdx.x < 128) ((LAS float*)(lds + A_G))[threadIdx.x] = P.subln_g[threadIdx.x];
#ifndef REP_DA
#define REP_DA 1
#endif
#ifndef REP_SW
#define REP_SW 1
#endif
#ifndef NO_DA
    const int nda = (G == 256) ? 8 : (2048 - vcu + G - 1) / G;
#pragma unroll 1
    for (int j0 = 0; j0 < nda * REP_DA; ++j0) {
        const int j = j0 % nda;
        int grp, qb, seqbase, S;
        if (G == 256) {
            const int x = vcu >> 5, i = vcu & 31;
            if (j < 4) { grp = x * 16 + j * 4 + (i >> 3); qb = i & 7; seqbase = (grp >> 3) * 2048; S = 2048; }
            else { grp = x * 8 + (j - 4) * 2 + (i >> 4); qb = i & 15; seqbase = M_P + (grp >> 3) * 4096; S = 4096; }
        } else {
            const int u = vcu + j * G;
            if (u < 1024) { grp = u >> 3; qb = u & 7; seqbase = (grp >> 3) * 2048; S = 2048; }
            else { const int u2 = u - 1024; grp = u2 >> 4; qb = u2 & 15; seqbase = M_P + (grp >> 3) * 4096; S = 4096; }
        }
        da_unit(lds, P, seqbase, S, grp & 7, qb, lam);
    }
#endif
#ifndef NO_SW
    __syncthreads();
#pragma unroll 1
    for (int u = vcu; u < 256; u += G)
#pragma unroll 1
        for (int kv0 = 0; kv0 < 4 * REP_SW; ++kv0) sw_unit4(lds, P, u, kv0 & 3);
#endif
}

__device__ __forceinline__ unsigned f2bf(float f) { unsigned u = __builtin_bit_cast(unsigned, f); return (u + 0x7fffu + ((u >> 16) & 1u)) >> 16; }
__device__ __forceinline__ unsigned pk2(float lo, float hi) { return f2bf(lo) | (f2bf(hi) << 16); }
template <bool GU>
__device__ __forceinline__ void transpose_item(const float* __restrict__ W, int K, int N, bf16* __restrict__ WT, LAS float* scr, int item, int lane, const float* __restrict__ gk) {
    const int nblk = N / 32, kb = item / nblk, nb = item % nblk, k0 = 64 * kb, n0 = 32 * nb;
    int r0 = n0;
    if (GU) { r0 = (n0 < D_FF) ? (n0 >> 7) * 256 + (n0 & 127) : ((n0 - D_FF) >> 7) * 256 + 128 + ((n0 - D_FF) & 127); }
    float wv[32];
#pragma unroll
    for (int i = 0; i < 32; ++i) wv[i] = W[(size_t)(k0 + 2 * i + (lane >> 5)) * N + n0 + (lane & 31)];
#pragma unroll
    for (int i = 0; i < 32; ++i) scr[(2 * i + (lane >> 5)) * 33 + (lane & 31)] = gk ? wv[i] * gk[k0 + 2 * i + (lane >> 5)] : wv[i];
    asm volatile("s_waitcnt lgkmcnt(0)" ::: "memory");
    const int c = lane & 7;
#pragma unroll
    for (int j = 0; j < 4; ++j) { const int n = (lane >> 3) + 8 * j; const LAS float* s = scr + (8 * c) * 33 + n;
        u32x4 o; o.x = pk2(s[0 * 33], s[1 * 33]); o.y = pk2(s[2 * 33], s[3 * 33]); o.z = pk2(s[4 * 33], s[5 * 33]); o.w = pk2(s[6 * 33], s[7 * 33]);
        *(u32x4*)(WT + (size_t)(r0 + n) * K + k0 + 8 * c) = o; }
    asm volatile("s_waitcnt lgkmcnt(0)" ::: "memory");
}

template <bool HAS_T, bool NEXT, bool BASE_BF, bool OUT_BF>
__device__ __forceinline__ void rowpass(int gw, int ngw, int lane, const float* base0, const float* base1, const bf16* hin, const bf16* T, const float* part, const float* gpost, float alpha,
                                        float* out, bf16* hout, float* rs, bf16* xn, bool rev) {
    f32x4 gp[4][2];
#pragma unroll
    for (int j = 0; j < 4; ++j)
#pragma unroll
        for (int e = 0; e < 2; ++e) {
            if (HAS_T) gp[j][e] = *(const f32x4*)(gpost + j * 512 + lane * 8 + e * 4) * alpha;
        }
    for (int row_ = gw; row_ < M_TOT; row_ += ngw) {
        const int row = rev ? (M_TOT - 1 - row_) : row_;
        f32x4 v[4][2];
        if (BASE_BF) {
            u32x4 hw[4];
#pragma unroll
            for (int j = 0; j < 4; ++j) hw[j] = *(const u32x4*)(hin + (size_t)row * D_MODEL + j * 512 + lane * 8);
#pragma unroll
            for (int j = 0; j < 4; ++j) { v[j][0] = (f32x4){bf_lo(hw[j].x), bf_hi(hw[j].x), bf_lo(hw[j].y), bf_hi(hw[j].y)}; v[j][1] = (f32x4){bf_lo(hw[j].z), bf_hi(hw[j].z), bf_lo(hw[j].w), bf_hi(hw[j].w)}; }
        } else {
            const float* brow = (row < M_P ? base0 : base1) + (size_t)row * D_MODEL;
#pragma unroll
            for (int j = 0; j < 4; ++j) { v[j][0] = *(const f32x4*)(brow + j * 512 + lane * 8); v[j][1] = *(const f32x4*)(brow + j * 512 + lane * 8 + 4); }
        }
        if (HAS_T) {
            u32x4 tw[4];
#pragma unroll
            for (int j = 0; j < 4; ++j) tw[j] = *(const u32x4*)(T + (size_t)row * D_MODEL + j * 512 + lane * 8);
            float ps = (lane < 32) ? part[(size_t)row * 32 + lane] : 0.f;
            ps = wave_sum(ps);
            const float rstd = __builtin_amdgcn_rsqf(ps * (1.0f / D_MODEL) + EPS);
#pragma unroll
            for (int j = 0; j < 4; ++j) {
                const f32x4 t0 = {bf_lo(tw[j].x), bf_hi(tw[j].x), bf_lo(tw[j].y), bf_hi(tw[j].y)}, t1 = {bf_lo(tw[j].z), bf_hi(tw[j].z), bf_lo(tw[j].w), bf_hi(tw[j].w)};
                v[j][0] += t0 * rstd * gp[j][0]; v[j][1] += t1 * rstd * gp[j][1];
            }
            if (OUT_BF) {
                bf16* hr = hout + (size_t)row * D_MODEL;
#pragma unroll
                for (int j = 0; j < 4; ++j) {
                    u32x4 w; w.x = cvtpk(v[j][0][0], v[j][0][1]); w.y = cvtpk(v[j][0][2], v[j][0][3]); w.z = cvtpk(v[j][1][0], v[j][1][1]); w.w = cvtpk(v[j][1][2], v[j][1][3]);
                    *(u32x4*)(hr + j * 512 + lane * 8) = w;
                }
            } else {
                float* orow = out + (size_t)row * D_MODEL;
#pragma unroll
                for (int j = 0; j < 4; ++j) { *(f32x4*)(orow + j * 512 + lane * 8) = v[j][0]; *(f32x4*)(orow + j * 512 + lane * 8 + 4) = v[j][1]; }
            }
        }
        if (NEXT) {
            float ss = 0.f;
#pragma unroll
            for (int j = 0; j < 4; ++j)
#pragma unroll
                for (int e = 0; e < 2; ++e) ss += (v[j][e][0] * v[j][e][0] + v[j][e][1] * v[j][e][1]) + (v[j][e][2] * v[j][e][2] + v[j][e][3] * v[j][e][3]);
            ss = wave_sum(ss);
            if (lane == 0) rs[row] = __builtin_amdgcn_rsqf(ss * (1.0f / D_MODEL) + EPS);
            if (!HAS_T) {
                bf16* xr = xn + (size_t)row * D_MODEL;
#pragma unroll
                for (int j = 0; j < 4; ++j) {
                    u32x4 w; w.x = cvtpk(v[j][0][0], v[j][0][1]); w.y = cvtpk(v[j][0][2], v[j][0][3]); w.z = cvtpk(v[j][1][0], v[j][1][1]); w.w = cvtpk(v[j][1][2], v[j][1][3]);
                    *(u32x4*)(xr + j * 512 + lane * 8) = w;
                }
            }
        }
    }
}

#ifndef REP_P0
#define REP_P0 1
#endif
#ifndef REP_P1
#define REP_P1 1
#endif
#ifndef REP_P2
#define REP_P2 1
#endif
#ifndef REP_P3
#define REP_P3 1
#endif
#ifndef REP_P4
#define REP_P4 1
#endif
#ifndef REP_P5
#define REP_P5 1
#endif
#ifndef REP_P6
#define REP_P6 1
#endif
#ifndef REP_P7
#define REP_P7 1
#endif
#ifndef REP_P8
#define REP_P8 1
#endif
#ifndef REP_P9
#define REP_P9 1
#endif
#ifndef REP_P10
#define REP_P10 1
#endif
#define XB_TMO      128
#define XB_XCNT(j)  (256  + 64 * (j))
#define XB_XSUB(j)  (1280 + 64 * (j))
#define XB_XGEN(j)  (2304 + 64 * (j))
#define XB_TOP      3328
#define XB_TOPGEN   3392
#define XCD_BAR_WORDS 3456
#define XB_SPIN_CAP (1u << 18)

__device__ __forceinline__ unsigned xb_ld(unsigned* p)              { return __hip_atomic_load(p, __ATOMIC_RELAXED, __HIP_MEMORY_SCOPE_AGENT); }
__device__ __forceinline__ unsigned xb_add(unsigned* p, unsigned v) { return __hip_atomic_fetch_add(p, v, __ATOMIC_RELAXED, __HIP_MEMORY_SCOPE_AGENT); }
__device__ __forceinline__ unsigned xb_xcc_id() { return (unsigned)__builtin_amdgcn_s_getreg((3 << 11) | 20) & 0xFu; }
#define XB_SPIN(cond, bar) do { unsigned _sp = 0; while (cond) { __builtin_amdgcn_s_sleep(1); \
    if ((++_sp & 255u) == 0u) { if (xb_ld(&(bar)[XB_TMO])) break; if (_sp > XB_SPIN_CAP) { atomicAdd(&(bar)[XB_TMO], 1u); break; } } } } while (0)

struct XcdBarrier {
    unsigned* bar; unsigned x;
    unsigned nloc, nx;
};

__device__ __forceinline__ XcdBarrier xcd_barrier_post(unsigned* bar) {
    XcdBarrier b; b.bar = bar; b.x = xb_xcc_id(); b.nloc = 0u; b.nx = 0u;
    if (threadIdx.x == 0) (void)xb_add(&bar[XB_XCNT(b.x)], 1u);
    return b;
}
__device__ __forceinline__ void xcd_barrier_complete(unsigned* bar, unsigned x, unsigned& nloc, unsigned& nx) {
    const unsigned G = gridDim.x * gridDim.y * gridDim.z;
    unsigned sum, cnt, mine, sp = 0u;
    for (;;) {
        sum = 0u; cnt = 0u; mine = 0u;
#pragma unroll
        for (unsigned j = 0; j < 16; ++j) { const unsigned c = xb_ld(&bar[XB_XCNT(j)]); sum += c; cnt += (c > 0u) ? 1u : 0u; mine = (j == x) ? c : mine; }
        if (sum == G) break;
        __builtin_amdgcn_s_sleep(1);
        if ((++sp & 255u) == 0u) { if (xb_ld(&bar[XB_TMO])) break; if (sp > XB_SPIN_CAP) { atomicAdd(&bar[XB_TMO], 1u); break; } }
    }
    nloc = mine > 0u ? mine : 1u; nx = cnt > 0u ? cnt : 1u;
}

__device__ __forceinline__ void xcd_barrier(XcdBarrier& b) {
    asm volatile("s_waitcnt vmcnt(0)" ::: "memory");
    __syncthreads();
    if (threadIdx.x == 0) {
        unsigned* bar = b.bar;
        __builtin_amdgcn_s_waitcnt(0);
        unsigned nloc = b.nloc, nx = b.nx;
        if (nloc == 0u) { xcd_barrier_complete(bar, b.x, nloc, nx); b.nloc = nloc; b.nx = nx; }
        const unsigned old = xb_add(&bar[XB_XSUB(b.x)], 1u);
        const unsigned gen = old / nloc;
        if (old + 1u == (gen + 1u) * nloc) {
            __builtin_amdgcn_fence(__ATOMIC_RELEASE, "agent");
            asm volatile("s_waitcnt vmcnt(0)" ::: "memory");
            const unsigned og = xb_add(&bar[XB_TOP], 1u);
            const unsigned tg = og / nx;
            if (og + 1u == (tg + 1u) * nx) xb_add(&bar[XB_TOPGEN], 1u);
            else XB_SPIN(xb_ld(&bar[XB_TOPGEN]) == tg, bar);
            __builtin_amdgcn_fence(__ATOMIC_ACQUIRE, "agent");
            xb_add(&bar[XB_XGEN(b.x)], 1u);
            asm volatile("s_waitcnt vmcnt(0)" ::: "memory");
        } else {
            XB_SPIN(xb_ld(&bar[XB_XGEN(b.x)]) == gen, bar);
            __builtin_amdgcn_fence(__ATOMIC_ACQUIRE, "agent");
            asm volatile("s_waitcnt vmcnt(0)" ::: "memory");
        }
    }
    __syncthreads();
}

constexpr int N_PHASES = 11;
struct Args { const float* in[21]; float* out; unsigned char* ws; int ph_lo, ph_hi; };
static_assert(sizeof(Args) == 21 * 8 + 8 + 8 + 8, "Args has no padding");

__global__ void __launch_bounds__(NTHREADS, 2) mega_fwd(Args args) {
    extern __shared__ __attribute__((aligned(16))) unsigned char lds_raw[];
    LAS unsigned char* lds = (LAS unsigned char*)lds_raw;
    cg::grid_group grid = cg::this_grid();
    const int tid = threadIdx.x, lane = tid & 63, wave = __builtin_amdgcn_readfirstlane(tid >> 6);
    const int G = gridDim.x, bx = blockIdx.x;
    const int vcu = (G % 8 == 0) ? (bx % 8) * (G / 8) + bx / 8 : bx;
    const int gw = vcu * NWAVES + wave, ngw = G * NWAVES;
    unsigned char* ws = args.ws;
    const float* x_prompt = args.in[0]; const float* x_sample = args.in[1]; const float* rel_bias = args.in[2];
    const float* g_ffn1_pre = args.in[3]; const float* w_ffn1_gu = args.in[4]; const float* w_ffn1_down = args.in[5]; const float* g_ffn1_post = args.in[6];
    const float* g_mix_pre = args.in[7]; const float* w_in = args.in[8];
    const float* lq1 = args.in[9]; const float* lk1 = args.in[10]; const float* lq2 = args.in[11]; const float* lk2 = args.in[12];
    const float* g_subln = args.in[13]; const float* sink = args.in[14]; const float* w_out = args.in[15]; const float* g_mix_post = args.in[16];
    const float* g_ffn2_pre = args.in[17]; const float* w_ffn2_gu = args.in[18]; const float* w_ffn2_down = args.in[19]; const float* g_ffn2_post = args.in[20];
    float* out = args.out;
    bf16* Wgu1 = (bf16*)(ws + WS_WGU1); bf16* Wd1 = (bf16*)(ws + WS_WD1); bf16* Win = (bf16*)(ws + WS_WIN); bf16* Wout = (bf16*)(ws + WS_WOUT);
    bf16* Wgu2 = (bf16*)(ws + WS_WGU2); bf16* Wd2 = (bf16*)(ws + WS_WD2);
    float* PART = (float*)(ws + WS_PART); float* RS = (float*)(ws + WS_RS); bf16* XN = (bf16*)(ws + WS_XN); bf16* T = (bf16*)(ws + WS_T); bf16* ACT = (bf16*)(ws + WS_ACT); bf16* H = (bf16*)(ws + WS_H);
    const float* xs_off = x_sample - (size_t)M_P * D_MODEL;
    const int lo = args.ph_lo, hi = args.ph_hi;
    XcdBarrier xbar; xbar.bar = (unsigned*)(ws + WS_BAR); xbar.x = 0u; xbar.nloc = 0u; xbar.nx = 0u;
#ifndef PH_MASK
#define PH_MASK 0x7ff
#endif
#define IN(k) (((PH_MASK >> (k)) & 1) && lo <= (k) && (k) < hi)
#define SEAM(k) do { if ((k) + 1 < hi) { if ((k) == 0) grid.sync(); else xcd_barrier(xbar); } } while (0)

    if (IN(0)) for (int rep_ = 0; rep_ < REP_P0; ++rep_) {
        LAS float* scr = (LAS float*)(lds + wave * 16384);
        constexpr int I_GU = (D_MODEL / 64) * (2 * D_FF / 32), I_D = (D_FF / 64) * (D_MODEL / 32), I_IN = (D_MODEL / 64) * (D_IN / 32), I_OUT = (D_MODEL / 64) * (D_MODEL / 32);
        constexpr int NITEMS = 2 * I_GU + 2 * I_D + I_IN + I_OUT;
        for (int it = gw; it < NITEMS; it += ngw) {
            int r = it;
            if (r < I_GU) { transpose_item<true>(w_ffn1_gu, D_MODEL, 2 * D_FF, Wgu1, scr, r, lane, g_ffn1_pre); continue; } r -= I_GU;
            if (r < I_GU) { transpose_item<true>(w_ffn2_gu, D_MODEL, 2 * D_FF, Wgu2, scr, r, lane, g_ffn2_pre); continue; } r -= I_GU;
            if (r < I_D) { transpose_item<false>(w_ffn1_down, D_FF, D_MODEL, Wd1, scr, r, lane, nullptr); continue; } r -= I_D;
            if (r < I_D) { transpose_item<false>(w_ffn2_down, D_FF, D_MODEL, Wd2, scr, r, lane, nullptr); continue; } r -= I_D;
            if (r < I_IN) { transpose_item<false>(w_in, D_MODEL, D_IN, Win, scr, r, lane, g_mix_pre); continue; } r -= I_IN;
            transpose_item<false>(w_out, D_MODEL, D_MODEL, Wout, scr, r, lane, nullptr);
        }
        rowpass<false, true, false, false>(gw, ngw, lane, x_prompt, xs_off, nullptr, nullptr, nullptr, nullptr, 0.f, nullptr, nullptr, RS, XN, false);
        if (rep_ == 0 && bx == 0) { for (int i = tid; i < 4096; i += NTHREADS) ((unsigned*)(ws + WS_BAR))[i] = 0u; }
        SEAM(0);
        if (rep_ == 0) xbar = xcd_barrier_post((unsigned*)(ws + WS_BAR));
    }
    if (IN(1)) for (int rep_ = 0; rep_ < REP_P1; ++rep_) {
        pg8::Gemm g{XN, Wgu1, M_TOT, 2 * D_FF, D_MODEL}; pg8::StaticOrder S; S.init(M_TOT, 2 * D_FF, G, bx, 1);
        pg8::EpiSwiglu E{ACT, D_FF, RS};
        pg8::gemm_phase<pg8::EpiSwiglu, pg8::StaticOrder, PG8_ALIGN, PG8_SP2>(lds, g, S, E);
        SEAM(1);
    }
    if (IN(2)) for (int rep_ = 0; rep_ < REP_P2; ++rep_) {
        pg8::Gemm g{ACT, Wd1, M_TOT, D_MODEL, D_FF}; pg8::StaticOrder S; S.init(M_TOT, D_MODEL, G, bx);
        pg8::EpiT E{T, D_MODEL, PART};
        pg8::gemm_phase<pg8::EpiT, pg8::StaticOrder, PG8_ALIGN, PG8_SP2>(lds, g, S, E);
        SEAM(2);
    }
#ifdef PROBE_SYNCS
    for (int i_ = 0; i_ < PROBE_SYNCS; ++i_) grid.sync();
#endif
    if (IN(3)) for (int rep_ = 0; rep_ < REP_P3; ++rep_) {
        rowpass<true, true, false, true>(gw, ngw, lane, x_prompt, xs_off, nullptr, T, PART, g_ffn1_post, 0.5f, nullptr, H, RS, nullptr, true);
        SEAM(3);
    }
    if (IN(4)) for (int rep_ = 0; rep_ < REP_P4; ++rep_) {
        pg8::Gemm g{H, Win, M_TOT, D_IN, D_MODEL}; pg8::StaticOrder S; S.init(M_TOT, D_IN, G, bx);
        pg8::EpiProj E{(bf16*)(ws + WS_QDA), (bf16*)(ws + WS_KDA), (bf16*)(ws + WS_VTDA), (bf16*)(ws + WS_QSW), (bf16*)(ws + WS_KSW), (bf16*)(ws + WS_VTSW), QSCALE, lds + 131072, RS};
        pg8::gemm_phase<pg8::EpiProj, pg8::StaticOrder, PG8_ALIGN, PG8_SP2>(lds, g, S, E);
#ifdef PROBE_DUP_P4
        grid.sync();
        pg8::gemm_phase<pg8::EpiProj, pg8::StaticOrder, PG8_ALIGN, PG8_SP2>(lds, g, S, E);
#endif
        SEAM(4);
    }
    if (IN(5)) for (int rep_ = 0; rep_ < REP_P5; ++rep_) {
        AttnP P{(const bf16*)(ws + WS_QDA), (const bf16*)(ws + WS_KDA), (const bf16*)(ws + WS_VTDA), (const bf16*)(ws + WS_QSW), (const bf16*)(ws + WS_KSW), (const bf16*)(ws + WS_VTSW), XN, rel_bias, g_subln, sink, (float*)(ws + WS_T)};
        attn_phase(lds, P, vcu, G, lq1, lk1, lq2, lk2);
        SEAM(5);
    }
    if (IN(6)) for (int rep_ = 0; rep_ < REP_P6; ++rep_) {
        pg8::Gemm g{XN, Wout, M_TOT, D_MODEL, D_MODEL}; pg8::StaticOrder S; S.init(M_TOT, D_MODEL, G, bx);
        pg8::EpiT E{T, D_MODEL, PART};
        pg8::gemm_phase<pg8::EpiT, pg8::StaticOrder, PG8_ALIGN, PG8_SP2>(lds, g, S, E);
        SEAM(6);
    }
    if (IN(7)) for (int rep_ = 0; rep_ < REP_P7; ++rep_) {
        rowpass<true, true, true, true>(gw, ngw, lane, nullptr, nullptr, H, T, PART, g_mix_post, 1.0f, nullptr, H, RS, nullptr, true);
        SEAM(7);
    }
    if (IN(8)) for (int rep_ = 0; rep_ < REP_P8; ++rep_) {
        pg8::Gemm g{H, Wgu2, M_TOT, 2 * D_FF, D_MODEL}; pg8::StaticOrder S; S.init(M_TOT, 2 * D_FF, G, bx);
        pg8::EpiSwiglu E{ACT, D_FF, RS};
        pg8::gemm_phase<pg8::EpiSwiglu, pg8::StaticOrder, PG8_ALIGN, PG8_SP2>(lds, g, S, E);
        SEAM(8);
    }
    if (IN(9)) for (int rep_ = 0; rep_ < REP_P9; ++rep_) {
        pg8::Gemm g{ACT, Wd2, M_TOT, D_MODEL, D_FF}; pg8::StaticOrder S; S.init(M_TOT, D_MODEL, G, bx, 1);
        pg8::EpiT E{T, D_MODEL, PART};
        pg8::gemm_phase<pg8::EpiT, pg8::StaticOrder, PG8_ALIGN, PG8_SP2>(lds, g, S, E);
        SEAM(9);
    }
    if (IN(10)) for (int rep_ = 0; rep_ < REP_P10; ++rep_) {
        rowpass<true, false, true, false>(gw, ngw, lane, nullptr, nullptr, H, T, PART, g_ffn2_post, 0.5f, out, nullptr, nullptr, nullptr, false);
    }
#undef IN
#undef SEAM
}

#ifndef MK_MULTI_LAUNCH
#define MK_MULTI_LAUNCH 0
#endif
extern "C" void kernel_launch(void* const* d_in, const int* in_sizes, int n_in, void* d_out, int out_size, void* d_ws, size_t ws_size, hipStream_t stream) {
    static int grid = 0;
    if (grid == 0) {
        if (n_in != 21 || out_size != M_TOT * D_MODEL || ws_size < WS_END) { fprintf(stderr, "kernel_launch: unexpected shapes (n_in %d, out %d, ws %zu)\n", n_in, out_size, ws_size); grid = -1; return; }
        int dev = 0, cus = 0, per_cu = 0;
        hipGetDevice(&dev);
        hipDeviceGetAttribute(&cus, hipDeviceAttributeMultiprocessorCount, dev);
        if (hipFuncSetAttribute((const void*)mega_fwd, hipFuncAttributeMaxDynamicSharedMemorySize, LDS_BYTES) != hipSuccess) { fprintf(stderr, "kernel_launch: hipFuncSetAttribute failed\n"); grid = -1; return; }
        if (hipOccupancyMaxActiveBlocksPerMultiprocessor(&per_cu, (const void*)mega_fwd, NTHREADS, LDS_BYTES) != hipSuccess || per_cu < 1) { fprintf(stderr, "kernel_launch: occupancy query gave %d\n", per_cu); per_cu = 1; }
        (void)hipGetLastError();
        grid = cus * per_cu;
    }
    if (grid < 0) return;
    Args a{};
    for (int i = 0; i < 21; ++i) a.in[i] = (const float*)d_in[i];
    a.out = (float*)d_out; a.ws = (unsigned char*)d_ws;
#if MK_MULTI_LAUNCH
    for (int p = 0; p < N_PHASES; ++p) {
        a.ph_lo = p; a.ph_hi = p + 1;
        hipLaunchKernelGGL(mega_fwd, dim3(grid), dim3(NTHREADS), LDS_BYTES, stream, a);
    }
#else
    a.ph_lo = 0; a.ph_hi = N_PHASES;
    void* kargs[] = {&a};
    hipError_t e = hipLaunchCooperativeKernel((const void*)mega_fwd, dim3(grid), dim3(NTHREADS), kargs, LDS_BYTES, stream);
    if (e != hipSuccess) fprintf(stderr, "cooperative launch failed: %s (grid %d)\n", hipGetErrorString(e), grid);
#endif
}
```

```cpp
#include <hip/hip_runtime.h>
#include <hip/hip_cooperative_groups.h>
#include <cstdio>
#include <cstdint>
#include <cmath>
namespace cg = cooperative_groups;
#define MK_MULTI_LAUNCH 0
namespace pg8 {
#define PG8_LAS __attribute__((address_space(3)))
typedef unsigned short bf16_t;
typedef short bf16x8 __attribute__((ext_vector_type(8)));
typedef float f32x4 __attribute__((ext_vector_type(4)));
typedef unsigned u32x4 __attribute__((ext_vector_type(4)));
constexpr int BM = 256, BK = 64, HALF = 128, HTB = HALF * BK * 2  , STAGE_BYTES = 8 * HTB, NXCD = 8, WGM = 8;

__host__ __device__ __forceinline__ int lds_byte(int r, int c) { const int st = (r >> 4) * 2 + (c >> 5), rr = r & 15, cc = c & 31, ob = rr * 64 + cc * 2; return st * 1024 + (ob ^ (((ob >> 9) & 1) << 5)); }
__host__ __device__ __forceinline__ void stage_rc(int b, int& R, int& C) { const int st = b / 1024, sb = b % 1024, swz = sb ^ (((sb >> 9) & 1) << 5); R = (st >> 1) * 16 + swz / 64; C = (st & 1) * 32 + (swz % 64) / 2; }
__host__ __device__ __forceinline__ int perm32(int rho) { const int n = rho >> 4, i = rho & 15; return 8 * (i >> 2) + 4 * n + (i & 3); }

struct Unit { int pm, pn; };
struct Gemm { const bf16_t* A; const bf16_t* Bt; int M, N, K; };

struct StaticOrder {
    int nM, nN, nwg, G, c, rev;
    __host__ __device__ void init(int M, int N, int G_, int c_, int rev_ = 0) { nM = M / BM; nN = N / BM; nwg = nM * nN; G = G_; c = c_; rev = rev_; }
    __host__ __device__ bool next(int i, Unit& u) const {
        const long L = (long)i * G + c; if (L >= nwg) return false;
        int wgid = (int)L; { const int q = nwg / NXCD, r = nwg % NXCD, xcd = wgid % NXCD, off = wgid / NXCD; wgid = (xcd < r ? xcd * (q + 1) : r * (q + 1) + (xcd - r) * q) + off; }
        const int nig = WGM * nN, gid = wgid / nig, fm = gid * WGM, gsz = (nM - fm) < WGM ? (nM - fm) : WGM;
        u.pm = fm + ((wgid % nig) % gsz); u.pn = (wgid % nig) / gsz; if (rev) u.pm = nM - 1 - u.pm; return true;
    }
    __device__ __forceinline__ void a_ready(const Unit&) const {}
    __device__ __forceinline__ void done(const Unit&) const {}
};
__device__ __forceinline__ unsigned cvt_pk_bf16(float lo, float hi) { unsigned r; asm volatile("v_cvt_pk_bf16_f32 %0, %1, %2" : "=v"(r) : "v"(lo), "v"(hi)); return r; }
typedef unsigned u32x2 __attribute__((ext_vector_type(2)));
__device__ __forceinline__ float silu_mul(float g, float u) {
    const float e = __builtin_amdgcn_exp2f(g * -1.4426950408889634f);
    return g * __builtin_amdgcn_rcpf(1.0f + e) * u;
}
struct EpiSwiglu {
    static constexpr bool PERM = true, AFTER_DRAIN = false; static constexpr int NST = 8;
    bf16_t* O; int ldc; const float* rs;
    __device__ __forceinline__ void pre(const Unit& u, int wr, int fr, float (&rv)[8]) const {
#pragma unroll
        for (int i = 0; i < 8; ++i) rv[i] = rs[u.pm * BM + wr * 64 + fr + (i >> 2) * HALF + (i & 3) * 16];
    }
    __device__ __forceinline__ void operator()(const f32x4 (&acc)[2][2][4][2], const Unit& u, int wr, int wc, int fr, int fq, const float (&rv)[8]) const {
        const int row0 = u.pm * BM + wr * 64 + fr, col0 = u.pn * HALF + wc * 32 + 8 * fq;
#pragma unroll
        for (int ai = 0; ai < 2; ++ai)
#pragma unroll
            for (int m = 0; m < 4; ++m) {
                bf16_t* rowp = O + (size_t)(row0 + ai * HALF + m * 16) * ldc + col0;
                const float r = rv[ai * 4 + m];
                const f32x4 g0 = acc[ai][0][m][0] * r, g1 = acc[ai][0][m][1] * r, u0 = acc[ai][1][m][0] * r, u1 = acc[ai][1][m][1] * r;
                u32x4 w;
                w.x = cvt_pk_bf16(silu_mul(g0[0], u0[0]), silu_mul(g0[1], u0[1]));
                w.y = cvt_pk_bf16(silu_mul(g0[2], u0[2]), silu_mul(g0[3], u0[3]));
                w.z = cvt_pk_bf16(silu_mul(g1[0], u1[0]), silu_mul(g1[1], u1[1]));
                w.w = cvt_pk_bf16(silu_mul(g1[2], u1[2]), silu_mul(g1[3], u1[3]));
                *(u32x4*)rowp = w;
            }
    }
};
struct EpiT {
    static constexpr bool PERM = true, AFTER_DRAIN = false; static constexpr int NST = 16;
    bf16_t* O; int ldc; float* part;
    __device__ __forceinline__ void pre(const Unit&, int, int, float (&)[8]) const {}
    __device__ __forceinline__ void operator()(const f32x4 (&acc)[2][2][4][2], const Unit& u, int wr, int wc, int fr, int fq, const float (&)[8]) const {
        const int row0 = u.pm * BM + wr * 64 + fr, col0 = u.pn * BM + wc * 32 + 8 * fq;
#pragma unroll
        for (int ai = 0; ai < 2; ++ai)
#pragma unroll
            for (int m = 0; m < 4; ++m) {
                const int row = row0 + ai * HALF + m * 16;
                bf16_t* rowp = O + (size_t)row * ldc + col0;
                float ss = 0.f;
#pragma unroll
                for (int bj = 0; bj < 2; ++bj) {
                    const f32x4 v0 = acc[ai][bj][m][0], v1 = acc[ai][bj][m][1];
                    ss += (v0[0] * v0[0] + v0[1] * v0[1]) + (v0[2] * v0[2] + v0[3] * v0[3]) + (v1[0] * v1[0] + v1[1] * v1[1]) + (v1[2] * v1[2] + v1[3] * v1[3]);
                    u32x4 w; w.x = cvt_pk_bf16(v0[0], v0[1]); w.y = cvt_pk_bf16(v0[2], v0[3]); w.z = cvt_pk_bf16(v1[0], v1[1]); w.w = cvt_pk_bf16(v1[2], v1[3]);
                    *(u32x4*)(rowp + bj * HALF) = w;
                }
                ss += __shfl_xor(ss, 16); ss += __shfl_xor(ss, 32);
                if (fq == 0) part[(size_t)row * 32 + u.pn * 4 + wc] = ss;
            }
    }
};
struct EpiProj {
    static constexpr bool PERM = true, AFTER_DRAIN = false; static constexpr int NST = 16;
    bf16_t *Qda, *Kda, *VTda, *Qsw, *Ksw, *VTsw; float qscale; PG8_LAS unsigned char* epi_lds; const float* rs;
    __device__ __forceinline__ void pre(const Unit& u, int wr, int fr, float (&rv)[8]) const {
#pragma unroll
        for (int i = 0; i < 8; ++i) rv[i] = rs[u.pm * BM + wr * 64 + fr + (i >> 2) * HALF + (i & 3) * 16];
    }
    __device__ __forceinline__ void operator()(const f32x4 (&acc)[2][2][4][2], const Unit& u, int wr, int wc, int fr, int fq, const float (&rv)[8]) const {
        const int pn = u.pn;
        const int row0 = u.pm * BM + wr * 64 + fr;
        const int trow = u.pm * BM;
        int S, seqbase;
        if (trow < 32768) { S = 2048; seqbase = trow & ~2047; } else { S = 4096; seqbase = 32768 + ((trow - 32768) & ~4095); }
        const int s0 = row0 - seqbase;
        if (pn < 8 || (pn >= 12 && pn < 17)) {
            bf16_t* base; int colt; float sc = 1.f;
            if (pn < 4) { base = Qda + (size_t)seqbase * 1024; colt = pn * BM; sc = qscale; }
            else if (pn < 8) { base = Kda + (size_t)seqbase * 1024; colt = (pn - 4) * BM; }
            else if (pn < 16) { base = Qsw + (size_t)seqbase * 1024; colt = (pn - 12) * BM; sc = qscale; }
            else { base = Ksw + (size_t)seqbase * 256; colt = 0; }
            const int d0 = (wc & 1) * 32 + 8 * fq;
#pragma unroll
            for (int bj = 0; bj < 2; ++bj) {
                bf16_t* hb = base + (size_t)((colt >> 6) + bj * 2 + (wc >> 1)) * 64 * S + d0;
#pragma unroll
                for (int ai = 0; ai < 2; ++ai)
#pragma unroll
                    for (int m = 0; m < 4; ++m) {
                        const float r = rv[ai * 4 + m] * sc;
                        const f32x4 v0 = acc[ai][bj][m][0] * r, v1 = acc[ai][bj][m][1] * r;
                        u32x4 w; w.x = cvt_pk_bf16(v0[0], v0[1]); w.y = cvt_pk_bf16(v0[2], v0[3]); w.z = cvt_pk_bf16(v1[0], v1[1]); w.w = cvt_pk_bf16(v1[2], v1[3]);
                        *(u32x4*)(hb + (size_t)(s0 + ai * HALF + m * 16) * 64) = w;
                    }
            }
        } else {
            bf16_t* base; int colt, dvh;
            if (pn < 12) { base = VTda + (size_t)seqbase * 1024; colt = (pn - 8) * BM; dvh = 128; } else { base = VTsw + (size_t)seqbase * 256; colt = 0; dvh = 64; }
            const int lane = fq * 16 + fr;
            PG8_LAS unsigned char* wl = epi_lds + (wr * 4 + wc) * 4096;
            const int stw = (u.pm * BM + wr * 64 - seqbase) >> 6;
#pragma unroll
            for (int ai = 0; ai < 2; ++ai)
#pragma unroll
                for (int bj = 0; bj < 2; ++bj) {
#pragma unroll
                    for (int m = 0; m < 4; ++m)
#pragma unroll
                        for (int n = 0; n < 2; ++n) {
                            const f32x4 v = acc[ai][bj][m][n] * rv[ai * 4 + m];
                            const unsigned p01 = cvt_pk_bf16(v[0], v[1]), p23 = cvt_pk_bf16(v[2], v[3]);
                            const int token = m * 16 + fr, d = 8 * fq + 4 * n;
                            PG8_LAS unsigned char* wp = wl + d * 128 + (((token >> 3) ^ fq) << 4) + (token & 7) * 2;
                            *(PG8_LAS bf16_t*)(wp) = (bf16_t)(p01 & 0xffffu); *(PG8_LAS bf16_t*)(wp + 128) = (bf16_t)(p01 >> 16);
                            *(PG8_LAS bf16_t*)(wp + 256) = (bf16_t)(p23 & 0xffffu); *(PG8_LAS bf16_t*)(wp + 384) = (bf16_t)(p23 >> 16);
                        }
                    const int c0 = colt + bj * HALF + wc * 32, h = (dvh == 128) ? (c0 >> 7) : (c0 >> 6), dd0 = c0 & (dvh - 1);
                    bf16_t* blk = base + (size_t)h * dvh * S + (size_t)(stw + 2 * ai) * (dvh * 64) + dd0 * 64;
#pragma unroll
                    for (int i = 0; i < 4; ++i) {
                        const int q = lane + 64 * i, d = q >> 3, c = q & 7;
                        const u32x4 w = *(const PG8_LAS u32x4*)(wl + d * 128 + ((c ^ ((d >> 3) & 7)) << 4));
                        *(u32x4*)(blk + q * 8) = w;
                    }
                }
        }
    }
};
template <class Epi, class Sched, bool ALIGN_EPI = false, bool SP2 = false>
__device__ __forceinline__ void gemm_phase(PG8_LAS unsigned char* lds, const Gemm g, const Sched& S, const Epi& E) {
    const int tid = threadIdx.x, wid = __builtin_amdgcn_readfirstlane(tid >> 6), lane = tid & 63, wr = wid >> 2, wc = wid & 3, fr = lane & 15, fq = lane >> 4;
    const int K = g.K, nt = K / BK;
    unsigned voffA[2], voffB[2];
#pragma unroll
    for (int i = 0; i < 2; ++i) { int R, C; stage_rc(tid * 16 + i * 8192, R, C); const int Rb = Epi::PERM ? ((R & ~31) + perm32(R & 31)) : R;
        voffA[i] = (unsigned)(R * K + C) * 2u; voffB[i] = (unsigned)(Rb * K + C) * 2u; }
    const size_t kstep = (size_t)(BK * 2);
    const size_t hstep = (size_t)HALF * K * 2;
    const size_t tstep = 2 * hstep;
    const unsigned ldsw = (unsigned)wid * 1024u;
    const int aoff = lds_byte(wr * 64 + fr, fq * 8), boff = lds_byte(wc * 32 + fr, fq * 8);
#define PG8_SA(b, h) (((b) * 2 + (h)) * HTB)
#define PG8_SB(b, h) ((4 + (b) * 2 + (h)) * HTB)
#define PG8_STAGE(bufoff, gbase, voff) do { _Pragma("unroll") for (int _i = 0; _i < 2; ++_i) \
        __builtin_amdgcn_global_load_lds((const unsigned*)((const char*)(gbase) + (voff)[_i]), (PG8_LAS unsigned*)(lds + (bufoff) + ldsw + _i * 8192), 16, 0, 0); } while (0)
#define PG8_LDA(dst, b, h) do { _Pragma("unroll") for (int m = 0; m < 4; ++m) _Pragma("unroll") for (int k = 0; k < 2; ++k) dst[m][k] = *(const PG8_LAS bf16x8*)(lds + PG8_SA(b, h) + aoff + m * 2048 + k * 1024); } while (0)
#define PG8_LDB(dst, b, h) do { _Pragma("unroll") for (int n = 0; n < 2; ++n) _Pragma("unroll") for (int k = 0; k < 2; ++k) dst[n][k] = *(const PG8_LAS bf16x8*)(lds + PG8_SB(b, h) + boff + n * 2048 + k * 1024); } while (0)
#define PG8_MMA(ai, bj, At, Bt) do { __builtin_amdgcn_s_setprio(1); _Pragma("unroll") for (int m = 0; m < 4; ++m) _Pragma("unroll") for (int n = 0; n < 2; ++n) _Pragma("unroll") for (int k = 0; k < 2; ++k) \
        acc[ai][bj][m][n] = __builtin_amdgcn_mfma_f32_16x16x32_bf16(Bt[n][k], At[m][k], acc[ai][bj][m][n], 0, 0, 0); __builtin_amdgcn_s_setprio(0); } while (0)
#define PG8_WAIT_V(n) asm volatile("s_waitcnt vmcnt(" #n ")" ::: "memory")
#define PG8_WAIT_L(n) asm volatile("s_waitcnt lgkmcnt(" #n ")" ::: "memory")
#define PG8_BAR __builtin_amdgcn_s_barrier()
#define PG8_SCHED __builtin_amdgcn_sched_barrier(0)
    Unit cur, nxt; int ui = 0;
    if (!S.next(0, cur)) return;
    float epre[8]; E.pre(cur, wr, fr, epre);
    f32x4 acc[2][2][4][2];
#pragma unroll
    for (int a = 0; a < 2; ++a)
#pragma unroll
        for (int b = 0; b < 2; ++b)
#pragma unroll
            for (int m = 0; m < 4; ++m)
#pragma unroll
                for (int n = 0; n < 2; ++n) acc[a][b][m][n] = (f32x4){0.f, 0.f, 0.f, 0.f};
    bf16x8 At[4][2], B0[2][2], B1[2][2];
    const char* cA = (const char*)g.A + (size_t)cur.pm * tstep; const char* cB = (const char*)g.Bt + (size_t)cur.pn * tstep;
    S.a_ready(cur);
    if constexpr (SP2) {
        PG8_STAGE(PG8_SB(0, 0), cB, voffB); PG8_STAGE(PG8_SB(0, 1), cB + hstep, voffB); PG8_STAGE(PG8_SA(0, 0), cA, voffA); PG8_STAGE(PG8_SA(0, 1), cA + hstep, voffA);
        if (wr == 1) PG8_BAR;
        PG8_WAIT_V(2); PG8_BAR;
        PG8_STAGE(PG8_SB(1, 0), cB + kstep, voffB); PG8_STAGE(PG8_SA(1, 0), cA + kstep, voffA); PG8_STAGE(PG8_SB(1, 1), cB + hstep + kstep, voffB);
        PG8_WAIT_V(6); PG8_BAR;
    } else {
        PG8_STAGE(PG8_SB(0, 0), cB, voffB); PG8_STAGE(PG8_SA(0, 0), cA, voffA); PG8_STAGE(PG8_SB(0, 1), cB + hstep, voffB); PG8_STAGE(PG8_SA(0, 1), cA + hstep, voffA);
        if (wr == 1) PG8_BAR;
        PG8_WAIT_V(4); PG8_BAR;
        PG8_STAGE(PG8_SB(1, 0), cB + kstep, voffB); PG8_STAGE(PG8_SA(1, 0), cA + kstep, voffA); PG8_STAGE(PG8_SB(1, 1), cB + hstep + kstep, voffB);
        PG8_WAIT_V(6); PG8_BAR;
    }
    for (;;) {
        const bool has_next = S.next(ui + 1, nxt);
        const char* nA = has_next ? (const char*)g.A + (size_t)nxt.pm * tstep : cA; const char* nB = has_next ? (const char*)g.Bt + (size_t)nxt.pn * tstep : cB;
        for (int t = 0; t < nt; t += 2) {
            const bool last = (t == nt - 2);
            const char* a1 = cA + (size_t)(t + 1) * kstep;
            const char* a2 = last ? nA : cA + (size_t)(t + 2) * kstep; const char* b2 = last ? nB : cB + (size_t)(t + 2) * kstep;
            const char* a3 = a2 + kstep; const char* b3 = b2 + kstep;
            if (last && has_next) S.a_ready(nxt);
            if constexpr (SP2) {
            PG8_LDB(B0, 0, 0); PG8_LDB(B1, 0, 1); PG8_SCHED; PG8_LDA(At, 0, 0); PG8_STAGE(PG8_SA(1, 1), a1 + hstep, voffA);
            PG8_WAIT_V(8); PG8_WAIT_L(0); PG8_BAR; PG8_MMA(0, 0, At, B0); PG8_MMA(0, 1, At, B1); PG8_BAR; PG8_SCHED;
            PG8_LDA(At, 0, 1); PG8_STAGE(PG8_SB(0, 0), b2, voffB); PG8_STAGE(PG8_SB(0, 1), b2 + hstep, voffB); PG8_STAGE(PG8_SA(0, 0), a2, voffA);
            PG8_WAIT_V(8); PG8_WAIT_L(0); PG8_BAR; PG8_MMA(1, 0, At, B0); PG8_MMA(1, 1, At, B1); PG8_BAR; PG8_SCHED;
            PG8_LDB(B0, 1, 0); PG8_LDB(B1, 1, 1); PG8_SCHED; PG8_LDA(At, 1, 0); PG8_STAGE(PG8_SA(0, 1), a2 + hstep, voffA);
            PG8_WAIT_V(8); PG8_WAIT_L(0); PG8_BAR; PG8_MMA(0, 0, At, B0); PG8_MMA(0, 1, At, B1); PG8_BAR; PG8_SCHED;
            PG8_LDA(At, 1, 1); PG8_STAGE(PG8_SB(1, 0), b3, voffB); PG8_STAGE(PG8_SB(1, 1), b3 + hstep, voffB); PG8_STAGE(PG8_SA(1, 0), a3, voffA);
            PG8_WAIT_V(8); PG8_WAIT_L(0); PG8_BAR; PG8_MMA(1, 0, At, B0); PG8_MMA(1, 1, At, B1); PG8_BAR; PG8_SCHED;
            } else {
            PG8_LDB(B0, 0, 0); PG8_SCHED; PG8_LDA(At, 0, 0); PG8_STAGE(PG8_SA(1, 1), a1 + hstep, voffA);
            PG8_WAIT_L(8); PG8_BAR; PG8_WAIT_L(0); PG8_MMA(0, 0, At, B0); PG8_BAR; PG8_SCHED;
            PG8_LDB(B1, 0, 1); PG8_STAGE(PG8_SB(0, 0), b2, voffB);
            PG8_BAR; PG8_WAIT_L(0); PG8_MMA(0, 1, At, B1); PG8_BAR;
            PG8_LDA(At, 0, 1); PG8_STAGE(PG8_SA(0, 0), a2, voffA);
            PG8_BAR; PG8_WAIT_L(0); PG8_MMA(1, 0, At, B0); PG8_BAR; PG8_SCHED;
            PG8_STAGE(PG8_SB(0, 1), b2 + hstep, voffB);
            PG8_WAIT_V(6); PG8_BAR; PG8_MMA(1, 1, At, B1); PG8_BAR;
            PG8_LDB(B0, 1, 0); PG8_SCHED; PG8_LDA(At, 1, 0); PG8_STAGE(PG8_SA(0, 1), a2 + hstep, voffA);
            PG8_WAIT_L(8); PG8_BAR; PG8_WAIT_L(0); PG8_MMA(0, 0, At, B0); PG8_BAR; PG8_SCHED;
            PG8_LDB(B1, 1, 1); PG8_STAGE(PG8_SB(1, 0), b3, voffB);
            PG8_BAR; PG8_WAIT_L(0); PG8_MMA(0, 1, At, B1); PG8_BAR;
            PG8_LDA(At, 1, 1); PG8_STAGE(PG8_SA(1, 0), a3, voffA);
            PG8_BAR; PG8_WAIT_L(0); PG8_MMA(1, 0, At, B0); PG8_BAR; PG8_SCHED;
            PG8_STAGE(PG8_SB(1, 1), b3 + hstep, voffB);
            PG8_WAIT_V(6); PG8_BAR; PG8_MMA(1, 1, At, B1); PG8_BAR;
            }
        }
        if constexpr (ALIGN_EPI) { if (wr == 0) PG8_BAR; }
        if constexpr (!Epi::AFTER_DRAIN) { E(acc, cur, wr, wc, fr, fq, epre); S.done(cur); }
        if (!has_next) break;
#pragma unroll
        for (int a = 0; a < 2; ++a)
#pragma unroll
            for (int b = 0; b < 2; ++b)
#pragma unroll
                for (int m = 0; m < 4; ++m)
#pragma unroll
                    for (int n = 0; n < 2; ++n) acc[a][b][m][n] = (f32x4){0.f, 0.f, 0.f, 0.f};
        cur = nxt; cA = nA; cB = nB; ++ui;
        E.pre(cur, wr, fr, epre);
        if constexpr (ALIGN_EPI) { if (wr == 1) PG8_BAR; }
    }
    PG8_WAIT_V(0);
    if constexpr (!ALIGN_EPI) { if (wr == 0) PG8_BAR; }
    PG8_BAR;
    if constexpr (Epi::AFTER_DRAIN) { E.fused(acc, cur, wr, wc, fr, fq, lds, wid, lane); S.done(cur); }
#undef PG8_SA
#undef PG8_SB
#undef PG8_STAGE
#undef PG8_LDA
#undef PG8_LDB
#undef PG8_MMA
#undef PG8_WAIT_V
#undef PG8_WAIT_L
#undef PG8_BAR
#undef PG8_SCHED
}
}

#ifndef PG8_SP2
#define PG8_SP2 true
#endif
#ifndef PG8_ALIGN
#define PG8_ALIGN true
#endif
constexpr int D_MODEL = 2048, D_FF = 5632, D_IN = 4608;
constexpr int M_P = 16 * 2048, M_TOT = 65536;
constexpr float EPS = 1e-6f;
constexpr float LOG2E = 1.4426950408889634f;
constexpr float QSCALE = 0.125f * LOG2E;
constexpr float LAMBDA_INIT = 0.2f;
constexpr int NWAVES = 8, NTHREADS = 512;
constexpr int LDS_BYTES = 163840;

#define LAS __attribute__((address_space(3)))
typedef unsigned short bf16;
typedef short bf16x8 __attribute__((ext_vector_type(8)));
typedef float f32x16 __attribute__((ext_vector_type(16)));
typedef float f32x4 __attribute__((ext_vector_type(4)));
typedef unsigned u32x4 __attribute__((ext_vector_type(4)));
typedef unsigned u32x2 __attribute__((ext_vector_type(2)));
typedef float f32x2_t __attribute__((ext_vector_type(2)));
typedef __bf16 bf16x2_t __attribute__((ext_vector_type(2)));

constexpr size_t MiB = 1u << 20;
constexpr size_t WS_WGU1 = 0, WS_WD1 = 44 * MiB, WS_WIN = 66 * MiB, WS_WOUT = 84 * MiB, WS_WGU2 = 92 * MiB, WS_WD2 = 136 * MiB;
constexpr size_t WS_RS = 158 * MiB;
constexpr size_t WS_BAR = 159 * MiB;
constexpr size_t WS_PART = 160 * MiB;
constexpr size_t WS_XN = 168 * MiB;
constexpr size_t WS_T = 424 * MiB;
constexpr size_t WS_ACT = 680 * MiB;
constexpr size_t WS_QDA = WS_ACT, WS_KDA = WS_ACT + 128 * MiB, WS_VTDA = WS_ACT + 256 * MiB, WS_QSW = WS_ACT + 384 * MiB, WS_KSW = WS_ACT + 512 * MiB, WS_VTSW = WS_ACT + 544 * MiB;
constexpr size_t WS_H = WS_ACT + 704 * MiB;
constexpr size_t WS_END = WS_H + 256 * MiB;

__device__ __forceinline__ unsigned cvtpk(float lo, float hi) { f32x2_t v = {lo, hi}; bf16x2_t b = __builtin_convertvector(v, bf16x2_t); return __builtin_bit_cast(unsigned, b); }
__device__ __forceinline__ float hmax(float v) { auto rr = __builtin_amdgcn_permlane32_swap(__float_as_uint(v), __float_as_uint(v), false, false); return fmaxf(__uint_as_float(rr[0]), __uint_as_float(rr[1])); }
__device__ __forceinline__ float hsum(float v) { auto rr = __builtin_amdgcn_permlane32_swap(__float_as_uint(v), __float_as_uint(v), false, false); return __uint_as_float(rr[0]) + __uint_as_float(rr[1]); }
__device__ __forceinline__ float wave_sum(float v) {
#pragma unroll
    for (int o = 1; o < 64; o <<= 1) v += __shfl_xor(v, o);
    return v;
}
__device__ __forceinline__ float bf_lo(unsigned w) { return __uint_as_float(w << 16); }
__device__ __forceinline__ float bf_hi(unsigned w) { return __uint_as_float(w & 0xffff0000u); }

constexpr int A_K = 0, A_V = 32768, A_BT = 114688, A_G = 115968;

__device__ __forceinline__ int t5_bucket(int rp) {
    const int n = rp < 0 ? -rp : rp;
    int b;
    if (n < 8) b = n; else if (n < 12) b = 8; else if (n < 16) b = 9; else if (n < 23) b = 10; else if (n < 32) b = 11; else if (n < 46) b = 12; else if (n < 64) b = 13; else if (n < 91) b = 14; else b = 15;
    return b + (rp > 0 ? 16 : 0);
}

__device__ __forceinline__ float max3f(float a, float b, float c) { float r; asm("v_max3_f32 %0, %1, %2, %3" : "=v"(r) : "v"(a), "v"(b), "v"(c)); return r; }
#define SBAR() __builtin_amdgcn_sched_barrier(0)
__device__ __forceinline__ void v_reads(bf16x8 (&vf)[4], LAS unsigned char* lds, const unsigned (&vaddr)[4], unsigned off) {
#pragma unroll
    for (int c4 = 0; c4 < 4; ++c4) vf[c4] = *(const LAS bf16x8*)(lds + vaddr[c4] + off);
}
__device__ __forceinline__ void pv_mma(f32x16& o, const bf16x8 (&vf)[4], const bf16x8 (&p)[4]) {
#pragma unroll
    for (int c4 = 0; c4 < 4; ++c4) o = __builtin_amdgcn_mfma_f32_32x32x16_bf16(vf[c4], p[c4], o, 0, 0, 0);
}
template <int DV>
__device__ __forceinline__ void pv_rest(f32x16 (&o)[DV / 32], const bf16x8 (&p)[4], bf16x8 (&va)[4], bf16x8 (&vb)[4], LAS unsigned char* lds, const unsigned (&vaddr)[4], unsigned vb_) {
    if (DV == 128) {
        pv_mma(o[0], va, p); v_reads(va, lds, vaddr, vb_ + 2 * 4096); SBAR();
        pv_mma(o[1], vb, p); v_reads(vb, lds, vaddr, vb_ + 3 * 4096); SBAR();
        pv_mma(o[2], va, p); SBAR();
        pv_mma(o[DV / 32 - 1], vb, p);
    } else {
        pv_mma(o[0], va, p); SBAR();
        pv_mma(o[1], vb, p);
    }
}
__device__ __forceinline__ void glds16(const void* gsrc, unsigned lds_dst) {
    unsigned keep;
    asm volatile("s_mov_b32 %0, m0\n\ts_mov_b32 m0, %2\n\ts_nop 0\n\tglobal_load_lds_dwordx4 %1, off\n\ts_mov_b32 m0, %0" : "=&s"(keep) : "v"(gsrc), "s"(lds_dst) : "memory");
}
constexpr int NKS = 4, NVS = 5, PFD = 3;
template <int DV, bool SW>
__device__ __forceinline__ void flash(LAS unsigned char* lds, const bf16* __restrict__ Qw, int qpitch, const bf16* __restrict__ Kb, int kpitch,
                                      const bf16* __restrict__ VTb, int S, int t_lo, int t_hi, int qpos_w, bool grpB, f32x16 (&o)[DV / 32], float& mref, float& lsum) {
    const int tid = threadIdx.x, lane = tid & 63, r32 = lane & 31, hi = lane >> 5;
    const int wid = __builtin_amdgcn_readfirstlane(tid >> 6);
    const LAS float* bt = (const LAS float*)(lds + A_BT);
    const unsigned lds0 = (unsigned)(uintptr_t)lds;
    bf16x8 qf[4];
#pragma unroll
    for (int d0 = 0; d0 < 4; ++d0) qf[d0] = *(const bf16x8*)(Qw + (size_t)r32 * qpitch + d0 * 16 + hi * 8);
    const int lrow = wid * 8 + (lane >> 3), pch = lane & 7, lch = pch ^ ((lrow >> 1) & 7);
    const int rho = lrow & 31, key = (lrow & 32) + 16 * ((rho >> 2) & 1) + 4 * (rho >> 3) + (rho & 3);
    const bf16* ksrc = Kb + key * 64 + lch * 8;
    const bf16* vsrc = VTb + lrow * 64 + lch * 8;
    const unsigned kdst = lds0 + A_K + wid * 1024, vdst = lds0 + A_V + wid * 1024;
    const int sw = (r32 >> 1) & 7;
    unsigned kaddr[4], vaddr[4];
#pragma unroll
    for (int d0 = 0; d0 < 4; ++d0) kaddr[d0] = A_K + r32 * 128 + (((2 * d0 + hi) ^ sw) << 4);
#pragma unroll
    for (int c4 = 0; c4 < 4; ++c4) vaddr[c4] = A_V + r32 * 128 + (((4 * (c4 >> 1) + 2 * hi + (c4 & 1)) ^ sw) << 4);
#define FL_ISSUE(tt, ks, vs) do { const int tc_ = min((tt), t_hi - 1); \
        glds16(ksrc + (size_t)tc_ * 4096, (unsigned)__builtin_amdgcn_readfirstlane(kdst + (ks) * 8192)); \
        _Pragma("unroll") for (int i_ = 0; i_ < DV / 64; ++i_) glds16(vsrc + (size_t)tc_ * (DV * 64) + i_ * 4096, (unsigned)__builtin_amdgcn_readfirstlane(vdst + (vs) * 16384 + i_ * 8192)); } while (0)
    FL_ISSUE(t_lo, 0, 0); FL_ISSUE(t_lo + 1, 1, 1); FL_ISSUE(t_lo + 2, 2, 2);
    asm volatile("" :: "v"(qf[0]), "v"(qf[1]), "v"(qf[2]), "v"(qf[3]));
    if (DV == 128) asm volatile("s_waitcnt vmcnt(6) lgkmcnt(0)\n\ts_barrier" ::: "memory"); else asm volatile("s_waitcnt vmcnt(4) lgkmcnt(0)\n\ts_barrier" ::: "memory");
    int ks_cur = 0, ks_iss = 3;
    int vs_prev = 4, vs_cur = 0, vs_iss = 3;
    int cls_cur = 0; float cb = 0.f;
    bf16x8 p[4];
    bool have_prev = false;
    for (int t = t_lo; t <= t_hi; ++t) {
        bool issued = false;
        if (grpB && have_prev) {
            bf16x8 va[4], vb[4];
            v_reads(va, lds, vaddr, (unsigned)vs_prev * 16384); v_reads(vb, lds, vaddr, (unsigned)vs_prev * 16384 + 4096); SBAR();
            pv_rest<DV>(o, p, va, vb, lds, vaddr, (unsigned)vs_prev * 16384);
        }
        const int kt = t * 64;
        bool active = (t < t_hi);
        if (SW) active = active && (kt + 63 >= qpos_w - 128) && (kt <= qpos_w + 31 + 128);
        if (active) {
            const unsigned kb_ = (unsigned)ks_cur * 8192;
            bf16x8 kf[8];
#pragma unroll
            for (int d0 = 0; d0 < 4; ++d0) { kf[2 * d0] = *(const LAS bf16x8*)(lds + kaddr[d0] + kb_); kf[2 * d0 + 1] = *(const LAS bf16x8*)(lds + kaddr[d0] + kb_ + 4096); }
            SBAR();
            const int rpmin = kt - (qpos_w + 31), rpmax = kt + 63 - qpos_w;
            const int cls = SW ? 0 : (rpmax <= -91 ? 1 : (rpmin >= 91 ? 2 : 0));
            if (cls != cls_cur) { cls_cur = cls; cb = (cls == 0) ? 0.f : (cls == 1 ? bt[0] : bt[258]); }
            f32x16 s0, s1;
            s0 = __builtin_amdgcn_mfma_f32_32x32x16_bf16(kf[0], qf[0], f32x16{}, 0, 0, 0);
            s1 = __builtin_amdgcn_mfma_f32_32x32x16_bf16(kf[1], qf[0], f32x16{}, 0, 0, 0);
#pragma unroll
            for (int d0 = 1; d0 < 4; ++d0) {
                s0 = __builtin_amdgcn_mfma_f32_32x32x16_bf16(kf[2 * d0], qf[d0], s0, 0, 0, 0);
                s1 = __builtin_amdgcn_mfma_f32_32x32x16_bf16(kf[2 * d0 + 1], qf[d0], s1, 0, 0, 0);
            }
#ifdef PROBE_EXTRA_MFMA
            { f32x16 dm_;
#pragma unroll
              for (int d0 = 0; d0 < 4; ++d0) { asm volatile("v_mfma_f32_32x32x16_bf16 %0, %1, %2, 0" : "=v"(dm_) : "v"(kf[2 * d0]), "v"(qf[d0])); asm volatile("v_mfma_f32_32x32x16_bf16 %0, %1, %2, 0" : "=v"(dm_) : "v"(kf[2 * d0 + 1]), "v"(qf[d0])); } }
#endif
            bf16x8 va[4], vb[4];
            if (!grpB) { v_reads(va, lds, vaddr, (unsigned)vs_cur * 16384); v_reads(vb, lds, vaddr, (unsigned)vs_cur * 16384 + 4096); }
            SBAR();
            if (cls == 0) {
                const int a0 = (kt + 16 * hi - (qpos_w + r32) + 129) * 4 + A_BT;
#pragma unroll
                for (int rg = 0; rg < 4; ++rg) {
#pragma unroll
                    for (int r = 4 * rg; r < 4 * rg + 4; ++r) {
                        const int aa = min(max(a0 + 4 * r, A_BT), A_BT + 258 * 4), ab = min(max(a0 + 4 * r + 128, A_BT), A_BT + 258 * 4);
                        s0[r] += *(const LAS float*)(lds + aa);
                        s1[r] += *(const LAS float*)(lds + ab);
                    }
                    SBAR();
                }
            }
            float mx = max3f(s0[0], s1[0], s0[1]);
            mx = max3f(mx, s1[1], s0[2]);
#pragma unroll
            for (int r = 2; r < 15; ++r) mx = max3f(mx, s1[r], s0[r + 1]);
            mx = fmaxf(mx, s1[15]);
            mx = hmax(mx) + (cb - mref);
            if (__any(mx > 8.0f)) {
                const float dl = fmaxf(mx, 0.f);
                mref += dl;
                const float f = __builtin_amdgcn_exp2f(-dl);
                lsum *= f;
#pragma unroll
                for (int db = 0; db < DV / 32; ++db) o[db] *= f;
            }
            FL_ISSUE(t + PFD, ks_iss, vs_iss); issued = true;
            const float off = mref - cb;
            s0 = s0 - off; s1 = s1 - off;
#pragma unroll
            for (int r = 0; r < 16; ++r) { s0[r] = __builtin_amdgcn_exp2f(s0[r]); s1[r] = __builtin_amdgcn_exp2f(s1[r]); }
#ifdef PROBE_EXTRA_EXP
#pragma unroll
            for (int r = 0; r < 16; ++r) { float t0_, t1_; asm volatile("v_exp_f32 %0, %1" : "=v"(t0_) : "v"(s0[r])); asm volatile("v_exp_f32 %0, %1" : "=v"(t1_) : "v"(s1[r])); }
#endif
#ifdef PROBE_EXTRA_VALU
#pragma unroll
            for (int r = 0; r < 16; ++r) { float t0_, t1_, t2_, t3_; asm volatile("v_add_f32 %0, %1, %1" : "=v"(t0_) : "v"(s0[r])); asm volatile("v_add_f32 %0, %1, %1" : "=v"(t1_) : "v"(s1[r])); asm volatile("v_add_f32 %0, %1, %1" : "=v"(t2_) : "v"(s0[r])); asm volatile("v_add_f32 %0, %1, %1" : "=v"(t3_) : "v"(s1[r])); }
#endif
            {
                const f32x16 sm = s0 + s1;
                lsum += ((sm[0] + sm[1]) + (sm[2] + sm[3])) + ((sm[4] + sm[5]) + (sm[6] + sm[7])) + (((sm[8] + sm[9]) + (sm[10] + sm[11])) + ((sm[12] + sm[13]) + (sm[14] + sm[15])));
            }
            {
                u32x4 w;
                w.x = cvtpk(s0[0], s0[1]); w.y = cvtpk(s0[2], s0[3]); w.z = cvtpk(s0[4], s0[5]); w.w = cvtpk(s0[6], s0[7]); p[0] = __builtin_bit_cast(bf16x8, w);
                w.x = cvtpk(s0[8], s0[9]); w.y = cvtpk(s0[10], s0[11]); w.z = cvtpk(s0[12], s0[13]); w.w = cvtpk(s0[14], s0[15]); p[1] = __builtin_bit_cast(bf16x8, w);
                w.x = cvtpk(s1[0], s1[1]); w.y = cvtpk(s1[2], s1[3]); w.z = cvtpk(s1[4], s1[5]); w.w = cvtpk(s1[6], s1[7]); p[2] = __builtin_bit_cast(bf16x8, w);
                w.x = cvtpk(s1[8], s1[9]); w.y = cvtpk(s1[10], s1[11]); w.z = cvtpk(s1[12], s1[13]); w.w = cvtpk(s1[14], s1[15]); p[3] = __builtin_bit_cast(bf16x8, w);
            }
            if (!grpB) { SBAR(); pv_rest<DV>(o, p, va, vb, lds, vaddr, (unsigned)vs_cur * 16384); }
        }
        if (!issued) FL_ISSUE(t + PFD, ks_iss, vs_iss);
        have_prev = active;
        if (DV == 128) asm volatile("s_waitcnt vmcnt(6) lgkmcnt(0)\n\ts_barrier" ::: "memory"); else asm volatile("s_waitcnt vmcnt(4) lgkmcnt(0)\n\ts_barrier" ::: "memory");
        ks_cur = (ks_cur + 1) & 3; ks_iss = (ks_iss + 1) & 3;
        vs_prev = vs_cur; vs_cur = (vs_cur == NVS - 1) ? 0 : vs_cur + 1; vs_iss = (vs_iss == NVS - 1) ? 0 : vs_iss + 1;
    }
    asm volatile("s_waitcnt vmcnt(0)" ::: "memory");
    __syncthreads();
#undef FL_ISSUE
}

template <bool ISSUE>
__device__ __forceinline__ void da_tile(LAS unsigned char* lds, int t, int NT, int qpos_w, int r32, int hi, const bf16x8 (&qf)[4], const unsigned (&kaddr)[4], const unsigned (&vaddr)[4],
                                        const bf16* ksrc, const bf16* vsrc, unsigned kdst, unsigned vdst, int& cls_cur, float& cb, f32x16 (&o)[4], float& mref, float& lsum) {
    const LAS float* bt = (const LAS float*)(lds + A_BT);
    const unsigned kb_ = (unsigned)(t & 3) * 8192, vb_ = (unsigned)(t & 3) * 16384;
    bf16x8 kf[8];
#pragma unroll
    for (int d0 = 0; d0 < 4; ++d0) { kf[2 * d0] = *(const LAS bf16x8*)(lds + kaddr[d0] + kb_); kf[2 * d0 + 1] = *(const LAS bf16x8*)(lds + kaddr[d0] + kb_ + 4096); }
    SBAR();
    const int kt = t * 64;
    const int rpmin = kt - (qpos_w + 31), rpmax = kt + 63 - qpos_w;
    const int cls = (rpmax <= -91 ? 1 : (rpmin >= 91 ? 2 : 0));
    if (cls != cls_cur) { cls_cur = cls; cb = (cls == 0) ? 0.f : (cls == 1 ? bt[0] : bt[258]); }
    f32x16 s0, s1;
    s0 = __builtin_amdgcn_mfma_f32_32x32x16_bf16(kf[0], qf[0], f32x16{}, 0, 0, 0);
    s1 = __builtin_amdgcn_mfma_f32_32x32x16_bf16(kf[1], qf[0], f32x16{}, 0, 0, 0);
#pragma unroll
    for (int d0 = 1; d0 < 4; ++d0) {
        s0 = __builtin_amdgcn_mfma_f32_32x32x16_bf16(kf[2 * d0], qf[d0], s0, 0, 0, 0);
        s1 = __builtin_amdgcn_mfma_f32_32x32x16_bf16(kf[2 * d0 + 1], qf[d0], s1, 0, 0, 0);
    }
    bf16x8 va[4], vb[4];
    v_reads(va, lds, vaddr, vb_);
    SBAR();
    if (cls == 0) {
        int a0 = (kt + 16 * hi - (qpos_w + r32) + 129) * 4 + A_BT; asm volatile("" : "+v"(a0));
#pragma unroll
        for (int rg = 0; rg < 4; ++rg) {
#pragma unroll
            for (int r = 4 * rg; r < 4 * rg + 4; ++r) {
                const int aa = min(max(a0 + 4 * r, A_BT), A_BT + 258 * 4), ab = min(max(a0 + 4 * r + 128, A_BT), A_BT + 258 * 4);
                s0[r] += *(const LAS float*)(lds + aa);
                s1[r] += *(const LAS float*)(lds + ab);
            }
            SBAR();
        }
    }
    float mx;
    {
        float m0 = max3f(s0[0], s0[1], s0[2]), m1 = max3f(s0[8], s0[9], s0[10]), m2 = max3f(s1[0], s1[1], s1[2]), m3 = max3f(s1[8], s1[9], s1[10]);
        m0 = max3f(m0, s0[3], s0[4]); m1 = max3f(m1, s0[11], s0[12]); m2 = max3f(m2, s1[3], s1[4]); m3 = max3f(m3, s1[11], s1[12]);
        m0 = max3f(m0, s0[5], s0[6]); m1 = max3f(m1, s0[13], s0[14]); m2 = max3f(m2, s1[5], s1[6]); m3 = max3f(m3, s1[13], s1[14]);
        m0 = max3f(m0, s0[7], s0[15]); m2 = max3f(m2, s1[7], s1[15]);
        mx = max3f(max3f(m0, m1, m2), m3, m3);
    }
    mx = hmax(mx) + (cb - mref);
    if (__any(mx > 8.0f)) {
        const float dl = fmaxf(mx, 0.f);
        mref += dl;
        const float f = __builtin_amdgcn_exp2f(-dl);
        lsum *= f;
#pragma unroll
        for (int db = 0; db < 4; ++db) o[db] *= f;
    }
    if (ISSUE) {
        if (t + 2 < NT) {
            glds16(ksrc + (size_t)(t + 2) * 4096, (unsigned)__builtin_amdgcn_readfirstlane(kdst + ((t + 2) & 3) * 8192));
            glds16(vsrc + (size_t)(t + 2) * 8192, (unsigned)__builtin_amdgcn_readfirstlane(vdst + ((t + 2) & 3) * 16384));
            glds16(vsrc + (size_t)(t + 2) * 8192 + 4096, (unsigned)__builtin_amdgcn_readfirstlane(vdst + ((t + 2) & 3) * 16384 + 8192));
            glds16(ksrc + (size_t)(t + 3) * 4096, (unsigned)__builtin_amdgcn_readfirstlane(kdst + ((t + 3) & 3) * 8192));
            glds16(vsrc + (size_t)(t + 3) * 8192, (unsigned)__builtin_amdgcn_readfirstlane(vdst + ((t + 3) & 3) * 16384));
            glds16(vsrc + (size_t)(t + 3) * 8192 + 4096, (unsigned)__builtin_amdgcn_readfirstlane(vdst + ((t + 3) & 3) * 16384 + 8192));
        }
    }
    const float off = mref - cb;
    s0 = s0 - off; s1 = s1 - off;
#pragma unroll
    for (int r = 0; r < 16; ++r) { s0[r] = __builtin_amdgcn_exp2f(s0[r]); s1[r] = __builtin_amdgcn_exp2f(s1[r]); }
    {
        const f32x16 sm = s0 + s1;
        lsum += ((sm[0] + sm[1]) + (sm[2] + sm[3])) + ((sm[4] + sm[5]) + (sm[6] + sm[7])) + (((sm[8] + sm[9]) + (sm[10] + sm[11])) + ((sm[12] + sm[13]) + (sm[14] + sm[15])));
    }
    bf16x8 p[4];
    {
        u32x4 w;
        w.x = cvtpk(s0[0], s0[1]); w.y = cvtpk(s0[2], s0[3]); w.z = cvtpk(s0[4], s0[5]); w.w = cvtpk(s0[6], s0[7]); p[0] = __builtin_bit_cast(bf16x8, w);
        w.x = cvtpk(s0[8], s0[9]); w.y = cvtpk(s0[10], s0[11]); w.z = cvtpk(s0[12], s0[13]); w.w = cvtpk(s0[14], s0[15]); p[1] = __builtin_bit_cast(bf16x8, w);
        w.x = cvtpk(s1[0], s1[1]); w.y = cvtpk(s1[2], s1[3]); w.z = cvtpk(s1[4], s1[5]); w.w = cvtpk(s1[6], s1[7]); p[2] = __builtin_bit_cast(bf16x8, w);
        w.x = cvtpk(s1[8], s1[9]); w.y = cvtpk(s1[10], s1[11]); w.z = cvtpk(s1[12], s1[13]); w.w = cvtpk(s1[14], s1[15]); p[3] = __builtin_bit_cast(bf16x8, w);
    }
    v_reads(vb, lds, vaddr, vb_ + 4096);
    SBAR();
    pv_rest<128>(o, p, va, vb, lds, vaddr, vb_);
}
__device__ __forceinline__ void flash_da2(LAS unsigned char* lds, const bf16* __restrict__ Qw, const bf16* __restrict__ Kb, const bf16* __restrict__ VTb,
                                          int NT, int qpos_w, f32x16 (&o)[4], float& mref, float& lsum) {
    const int tid = threadIdx.x, lane = tid & 63, r32 = lane & 31, hi = lane >> 5;
    const int wid = __builtin_amdgcn_readfirstlane(tid >> 6);
    const unsigned lds0 = (unsigned)(uintptr_t)lds;
    bf16x8 qf[4];
#pragma unroll
    for (int d0 = 0; d0 < 4; ++d0) qf[d0] = *(const bf16x8*)(Qw + (size_t)r32 * 64 + d0 * 16 + hi * 8);
    const int lrow = wid * 8 + (lane >> 3), pch = lane & 7, lch = pch ^ ((lrow >> 1) & 7);
    const int rho = lrow & 31, key = (lrow & 32) + 16 * ((rho >> 2) & 1) + 4 * (rho >> 3) + (rho & 3);
    const bf16* ksrc = Kb + key * 64 + lch * 8;
    const bf16* vsrc = VTb + lrow * 64 + lch * 8;
    const unsigned kdst = lds0 + A_K + wid * 1024, vdst = lds0 + A_V + wid * 1024;
    const int sw = (r32 >> 1) & 7;
    unsigned kaddr[4], vaddr[4];
#pragma unroll
    for (int d0 = 0; d0 < 4; ++d0) kaddr[d0] = A_K + r32 * 128 + (((2 * d0 + hi) ^ sw) << 4);
#pragma unroll
    for (int c4 = 0; c4 < 4; ++c4) vaddr[c4] = A_V + r32 * 128 + (((4 * (c4 >> 1) + 2 * hi + (c4 & 1)) ^ sw) << 4);
#pragma unroll
    for (int j = 0; j < 2; ++j) {
        glds16(ksrc + (size_t)j * 4096, (unsigned)__builtin_amdgcn_readfirstlane(kdst + j * 8192));
        glds16(vsrc + (size_t)j * 8192, (unsigned)__builtin_amdgcn_readfirstlane(vdst + j * 16384));
        glds16(vsrc + (size_t)j * 8192 + 4096, (unsigned)__builtin_amdgcn_readfirstlane(vdst + j * 16384 + 8192));
    }
    asm volatile("" :: "v"(qf[0]), "v"(qf[1]), "v"(qf[2]), "v"(qf[3]));
    asm volatile("s_waitcnt vmcnt(0) lgkmcnt(0)\n\ts_barrier" ::: "memory");
    int cls_cur = 0; float cb = 0.f;
#pragma unroll 1
    for (int t = 0; t < NT; t += 2) {
        da_tile<true>(lds, t, NT, qpos_w, r32, hi, qf, kaddr, vaddr, ksrc, vsrc, kdst, vdst, cls_cur, cb, o, mref, lsum);
        da_tile<false>(lds, t + 1, NT, qpos_w, r32, hi, qf, kaddr, vaddr, ksrc, vsrc, kdst, vdst, cls_cur, cb, o, mref, lsum);
        asm volatile("s_waitcnt vmcnt(0) lgkmcnt(0)\n\ts_barrier" ::: "memory");
    }
}

struct AttnP {
    const bf16 *Qda, *Kda, *VTda, *Qsw, *Ksw, *VTsw; bf16* O;
    const float *rel_bias, *subln_g, *sink; float* stash;
};

__device__ __forceinline__ void bias_table(LAS unsigned char* lds, const float* rel_bias, int head, bool mask) {
    LAS float* bt = (LAS float*)(lds + A_BT);
    for (int i = threadIdx.x; i < 259; i += NTHREADS) {
        const int rp = i - 129;
        bt[i] = (mask && (rp < -128 || rp > 128)) ? -INFINITY : rel_bias[t5_bucket(rp) * 24 + head] * LOG2E;
    }
}

__device__ __forceinline__ void da_unit(LAS unsigned char* lds, const AttnP& P, int seqbase, int S, int h, int qb, float lam) {
    const int tid = threadIdx.x, lane = tid & 63, r32 = lane & 31, hi = lane >> 5, wid = __builtin_amdgcn_readfirstlane(tid >> 6);
    bias_table(lds, P.rel_bias, h, false);
    const int qpos_w = qb * 256 + wid * 32;
    const size_t row_w = (size_t)seqbase + qpos_w;
    const bf16* Kb = P.Kda + (size_t)seqbase * 1024 + (size_t)(h * 2) * 64 * S;
    const bf16* Qb = P.Qda + (size_t)seqbase * 1024 + (size_t)(h * 2) * 64 * S + (size_t)qpos_w * 64;
    const bf16* VTb = P.VTda + (size_t)seqbase * 1024 + (size_t)(h * 128) * S;
    f32x16 o[4];
    float ss = 0.f;
#pragma unroll 1
    for (int map = 0; map < 2; ++map) {
#pragma unroll
        for (int db = 0; db < 4; ++db) o[db] = f32x16{};
        float mref = 0.f, l = 0.f;
        flash_da2(lds, Qb + (size_t)map * 64 * S, Kb + (size_t)map * 64 * S, VTb, S / 64, qpos_w, o, mref, l);
        int tid3 = threadIdx.x; asm volatile("" : "+v"(tid3));
        f32x4* stash = (f32x4*)(P.stash + (size_t)blockIdx.x * 32768 + tid3 * 64);
        if (map == 0) {
            const float inv = 1.0f / hsum(l);
#pragma unroll
            for (int db = 0; db < 4; ++db)
#pragma unroll
                for (int g = 0; g < 4; ++g) stash[db * 4 + g] = (f32x4){o[db][4 * g], o[db][4 * g + 1], o[db][4 * g + 2], o[db][4 * g + 3]} * inv;
        } else {
            const float inv = lam / hsum(l);
#pragma unroll
            for (int db = 0; db < 4; ++db)
#pragma unroll
                for (int g = 0; g < 4; ++g) {
                    const f32x4 st = stash[db * 4 + g];
#pragma unroll
                    for (int e = 0; e < 4; ++e) { const float a = st[e] - o[db][4 * g + e] * inv; o[db][4 * g + e] = a; ss += a * a; }
                }
        }
    }
    ss = hsum(ss);
    const float rstd = __builtin_amdgcn_rsqf(ss * (1.0f / 128.0f) + EPS) * (1.0f - LAMBDA_INIT);
    int tid2 = threadIdx.x; asm volatile("" : "+v"(tid2));
    const int r32e = tid2 & 31, hie = (tid2 >> 5) & 1;
    bf16* orow = P.O + (row_w + r32e) * 2048 + h * 128 + 4 * hie;
    const LAS unsigned char* gb = lds + A_G + hie * 16;
#pragma unroll
    for (int db = 0; db < 4; ++db)
#pragma unroll
        for (int g4 = 0; g4 < 4; ++g4) {
            const int d0 = 32 * db + 8 * g4;
            const f32x4 gv = *(const LAS f32x4*)(gb + d0 * 4);
            u32x2 w;
            w.x = cvtpk(o[db][4 * g4] * rstd * gv[0], o[db][4 * g4 + 1] * rstd * gv[1]);
            w.y = cvtpk(o[db][4 * g4 + 2] * rstd * gv[2], o[db][4 * g4 + 3] * rstd * gv[3]);
            *(u32x2*)(orow + d0) = w;
        }
}

__device__ __forceinline__ void sw_unit(LAS unsigned char* lds, const AttnP& P, int blk, int qh) {
    const int tid = threadIdx.x, lane = tid & 63, r32 = lane & 31, hi = lane >> 5, wid = __builtin_amdgcn_readfirstlane(tid >> 6);
    const int row0 = blk * 256;
    int S, seqbase;
    if (row0 < M_P) { S = 2048; seqbase = row0 & ~2047; } else { S = 4096; seqbase = M_P + ((row0 - M_P) & ~4095); }
    const int q0 = row0 - seqbase;
    bias_table(lds, P.rel_bias, 8 + qh, true);
    const int kvh = qh >> 2;
    const int t_lo = max(0, q0 - 128) >> 6, t_hi = min(S, q0 + 384) >> 6;
    const int qpos_w = q0 + wid * 32;
    const size_t row_w = (size_t)row0 + wid * 32;
    f32x16 o[2];
    o[0] = f32x16{}; o[1] = f32x16{};
    float mref = 0.f, l = 0.f;
    flash<64, true>(lds, P.Qsw + (size_t)seqbase * 1024 + (size_t)qh * 64 * S + (size_t)qpos_w * 64, 64, P.Ksw + (size_t)seqbase * 256 + (size_t)kvh * 64 * S, 64, P.VTsw + (size_t)seqbase * 256 + (size_t)(kvh * 64) * S, S, t_lo, t_hi, qpos_w, wid >= 4, o, mref, l);
    const float lt = hsum(l) + __builtin_amdgcn_exp2f(P.sink[qh] * LOG2E - mref);
    const float inv = 1.0f / lt;
    bf16* orow = P.O + (row_w + r32) * 2048 + 1024 + qh * 64;
#pragma unroll
    for (int db = 0; db < 2; ++db)
#pragma unroll
        for (int g4 = 0; g4 < 4; ++g4) {
            const int d0 = 32 * db + 8 * g4 + 4 * hi;
            u32x2 w;
            w.x = cvtpk(o[db][4 * g4] * inv, o[db][4 * g4 + 1] * inv);
            w.y = cvtpk(o[db][4 * g4 + 2] * inv, o[db][4 * g4 + 3] * inv);
            *(u32x2*)(orow + d0) = w;
        }
}

constexpr int A_K8 = 0, A_V8 = 65536, A_BT4 = 131072;
__device__ __forceinline__ void sw_unit4(LAS unsigned char* lds, const AttnP& P, int blk, int kvh) {
    const int tid = threadIdx.x, lane = tid & 63, r32 = lane & 31, hi = lane >> 5, wid = __builtin_amdgcn_readfirstlane(tid >> 6);
    const unsigned lds0 = (unsigned)(uintptr_t)lds;
    const int row0 = blk * 256;
    int S, seqbase;
    if (row0 < M_P) { S = 2048; seqbase = row0 & ~2047; } else { S = 4096; seqbase = M_P + ((row0 - M_P) & ~4095); }
    const int q0 = row0 - seqbase;
    const int t_lo = max(0, q0 - 128) >> 6, t_hi = min(S, q0 + 384) >> 6;
    for (int i = tid; i < 4 * 452; i += NTHREADS) {
        const int g = i / 452, e = i - g * 452, rp = e - 224;
        ((LAS float*)(lds + A_BT4))[i] = (rp < -128 || rp > 128) ? -INFINITY : P.rel_bias[t5_bucket(rp) * 24 + 8 + kvh * 4 + g] * LOG2E;
    }
    {
        const int lrow = wid * 8 + (lane >> 3), pch = lane & 7, lch = pch ^ ((lrow >> 1) & 7);
        const int rho = lrow & 31, key = (lrow & 32) + 16 * ((rho >> 2) & 1) + 4 * (rho >> 3) + (rho & 3);
        const bf16* ksrc = P.Ksw + (size_t)seqbase * 256 + (size_t)kvh * 64 * S + key * 64 + lch * 8;
        const bf16* vsrc = P.VTsw + (size_t)seqbase * 256 + (size_t)(kvh * 64) * S + lrow * 64 + lch * 8;
        for (int t = t_lo; t < t_hi; ++t) {
            glds16(ksrc + (size_t)t * 4096, (unsigned)__builtin_amdgcn_readfirstlane(lds0 + A_K8 + (t - t_lo) * 8192 + wid * 1024));
            glds16(vsrc + (size_t)t * 4096, (unsigned)__builtin_amdgcn_readfirstlane(lds0 + A_V8 + (t - t_lo) * 8192 + wid * 1024));
        }
    }
    const int sw = (r32 >> 1) & 7;
    unsigned kaddr[4], vaddr[4];
#pragma unroll
    for (int d0 = 0; d0 < 4; ++d0) kaddr[d0] = A_K8 + r32 * 128 + (((2 * d0 + hi) ^ sw) << 4);
#pragma unroll
    for (int c4 = 0; c4 < 4; ++c4) vaddr[c4] = A_V8 + r32 * 128 + (((4 * (c4 >> 1) + 2 * hi + (c4 & 1)) ^ sw) << 4);
    const int qpos_w = q0 + wid * 32;
    const size_t row_w = (size_t)row0 + wid * 32;
    asm volatile("s_waitcnt vmcnt(0) lgkmcnt(0)\n\ts_barrier" ::: "memory");
    const bf16* Qg = P.Qsw + (size_t)seqbase * 1024 + (size_t)(kvh * 4) * 64 * S + (size_t)qpos_w * 64 + (size_t)r32 * 64 + hi * 8;
    bf16x8 qn[4];
#pragma unroll
    for (int d0 = 0; d0 < 4; ++d0) qn[d0] = *(const bf16x8*)(Qg + d0 * 16);
#pragma unroll 1
    for (int g = 0; g < 4; ++g) {
        const int qh = kvh * 4 + g;
        bf16x8 qf[4];
#pragma unroll
        for (int d0 = 0; d0 < 4; ++d0) qf[d0] = qn[d0];
        if (g < 3) {
#pragma unroll
            for (int d0 = 0; d0 < 4; ++d0) qn[d0] = *(const bf16x8*)(Qg + (size_t)(g + 1) * 64 * S + d0 * 16);
        }
        const int btg = A_BT4 + g * 1808;
        f32x16 o[2]; o[0] = f32x16{}; o[1] = f32x16{};
        float mref = 0.f, lsum = 0.f;
#pragma unroll 1
        for (int t = t_lo; t < t_hi; ++t) {
            const int kt = t * 64;
            if (!((kt + 63 >= qpos_w - 128) && (kt <= qpos_w + 31 + 128))) continue;
            const unsigned sl = (unsigned)(t - t_lo) * 8192;
            bf16x8 kf[8];
#pragma unroll
            for (int d0 = 0; d0 < 4; ++d0) { kf[2 * d0] = *(const LAS bf16x8*)(lds + kaddr[d0] + sl); kf[2 * d0 + 1] = *(const LAS bf16x8*)(lds + kaddr[d0] + sl + 4096); }
            f32x16 s0, s1;
            s0 = __builtin_amdgcn_mfma_f32_32x32x16_bf16(kf[0], qf[0], f32x16{}, 0, 0, 0);
            s1 = __builtin_amdgcn_mfma_f32_32x32x16_bf16(kf[1], qf[0], f32x16{}, 0, 0, 0);
#pragma unroll
            for (int d0 = 1; d0 < 4; ++d0) {
                s0 = __builtin_amdgcn_mfma_f32_32x32x16_bf16(kf[2 * d0], qf[d0], s0, 0, 0, 0);
                s1 = __builtin_amdgcn_mfma_f32_32x32x16_bf16(kf[2 * d0 + 1], qf[d0], s1, 0, 0, 0);
            }
            bf16x8 va[4], vb[4];
            v_reads(va, lds, vaddr, sl); v_reads(vb, lds, vaddr, sl + 4096);
            SBAR();
            {
                const LAS float* tb = (const LAS float*)(lds + btg) + (kt + 16 * hi - (qpos_w + r32) + 224);
#pragma unroll
                for (int rg = 0; rg < 4; ++rg) {
#pragma unroll
                    for (int r = 4 * rg; r < 4 * rg + 4; ++r) { s0[r] += tb[r]; s1[r] += tb[r + 32]; }
                    SBAR();
                }
            }
            float mx;
            {
                float m0 = max3f(s0[0], s0[1], s0[2]), m1 = max3f(s0[8], s0[9], s0[10]), m2 = max3f(s1[0], s1[1], s1[2]), m3 = max3f(s1[8], s1[9], s1[10]);
                m0 = max3f(m0, s0[3], s0[4]); m1 = max3f(m1, s0[11], s0[12]); m2 = max3f(m2, s1[3], s1[4]); m3 = max3f(m3, s1[11], s1[12]);
                m0 = max3f(m0, s0[5], s0[6]); m1 = max3f(m1, s0[13], s0[14]); m2 = max3f(m2, s1[5], s1[6]); m3 = max3f(m3, s1[13], s1[14]);
                m0 = max3f(m0, s0[7], s0[15]); m2 = max3f(m2, s1[7], s1[15]);
                mx = max3f(max3f(m0, m1, m2), m3, m3);
            }
            mx = hmax(mx) - mref;
            if (__any(mx > 8.0f)) {
                const float dl = fmaxf(mx, 0.f);
                mref += dl;
                const float f = __builtin_amdgcn_exp2f(-dl);
                lsum *= f; o[0] *= f; o[1] *= f;
            }
            s0 = s0 - mref; s1 = s1 - mref;
#pragma unroll
            for (int r = 0; r < 16; ++r) { s0[r] = __builtin_amdgcn_exp2f(s0[r]); s1[r] = __builtin_amdgcn_exp2f(s1[r]); }
            {
                const f32x16 sm = s0 + s1;
                lsum += ((sm[0] + sm[1]) + (sm[2] + sm[3])) + ((sm[4] + sm[5]) + (sm[6] + sm[7])) + (((sm[8] + sm[9]) + (sm[10] + sm[11])) + ((sm[12] + sm[13]) + (sm[14] + sm[15])));
            }
            bf16x8 p[4];
            {
                u32x4 w;
                w.x = cvtpk(s0[0], s0[1]); w.y = cvtpk(s0[2], s0[3]); w.z = cvtpk(s0[4], s0[5]); w.w = cvtpk(s0[6], s0[7]); p[0] = __builtin_bit_cast(bf16x8, w);
                w.x = cvtpk(s0[8], s0[9]); w.y = cvtpk(s0[10], s0[11]); w.z = cvtpk(s0[12], s0[13]); w.w = cvtpk(s0[14], s0[15]); p[1] = __builtin_bit_cast(bf16x8, w);
                w.x = cvtpk(s1[0], s1[1]); w.y = cvtpk(s1[2], s1[3]); w.z = cvtpk(s1[4], s1[5]); w.w = cvtpk(s1[6], s1[7]); p[2] = __builtin_bit_cast(bf16x8, w);
                w.x = cvtpk(s1[8], s1[9]); w.y = cvtpk(s1[10], s1[11]); w.z = cvtpk(s1[12], s1[13]); w.w = cvtpk(s1[14], s1[15]); p[3] = __builtin_bit_cast(bf16x8, w);
            }
            SBAR();
            pv_mma(o[0], va, p); pv_mma(o[1], vb, p);
        }
        const float lt = hsum(lsum) + __builtin_amdgcn_exp2f(P.sink[qh] * LOG2E - mref);
        const float inv = 1.0f / lt;
        bf16* orow = P.O + (row_w + r32) * 2048 + 1024 + qh * 64 + 4 * hi;
#pragma unroll
        for (int db = 0; db < 2; ++db)
#pragma unroll
            for (int g4 = 0; g4 < 4; ++g4) {
                u32x2 w;
                w.x = cvtpk(o[db][4 * g4] * inv, o[db][4 * g4 + 1] * inv);
                w.y = cvtpk(o[db][4 * g4 + 2] * inv, o[db][4 * g4 + 3] * inv);
                *(u32x2*)(orow + 32 * db + 8 * g4) = w;
            }
    }
    asm volatile("s_waitcnt vmcnt(0) lgkmcnt(0)\n\ts_barrier" ::: "memory");
}

__device__ __forceinline__ void attn_phase(LAS unsigned char* lds, const AttnP& P, int vcu, int G, const float* lq1, const float* lk1, const float* lq2, const float* lk2) {
    const int lane = threadIdx.x & 63;
    const float s1 = wave_sum(lq1[lane] * lk1[lane]), s2 = wave_sum(lq2[lane] * lk2[lane]);
    const float lam = __expf(s1) - __expf(s2) + LAMBDA_INIT;
    if (threadIdx.x < 128) ((LAS float*)(lds + A_G))[threadIdx.x] = P.subln_g[threadIdx.x];
#ifndef REP_DA
#define REP_DA 1
#endif
#ifndef REP_SW
#define REP_SW 1
#endif
#ifndef NO_DA
    const int nda = (G == 256) ? 8 : (2048 - vcu + G - 1) / G;
#pragma unroll 1
    for (int j0 = 0; j0 < nda * REP_DA; ++j0) {
        const int j = j0 % nda;
        int grp, qb, seqbase, S;
        if (G == 256) {
            const int x = vcu >> 5, i = vcu & 31;
            if (j < 4) { grp = x * 16 + j * 4 + (i >> 3); qb = i & 7; seqbase = (grp >> 3) * 2048; S = 2048; }
            else { grp = x * 8 + (j - 4) * 2 + (i >> 4); qb = i & 15; seqbase = M_P + (grp >> 3) * 4096; S = 4096; }
        } else {
            const int u = vcu + j * G;
            if (u < 1024) { grp = u >> 3; qb = u & 7; seqbase = (grp >> 3) * 2048; S = 2048; }
            else { const int u2 = u - 1024; grp = u2 >> 4; qb = u2 & 15; seqbase = M_P + (grp >> 3) * 4096; S = 4096; }
        }
        da_unit(lds, P, seqbase, S, grp & 7, qb, lam);
    }
#endif
#ifndef NO_SW
    __syncthreads();
#pragma unroll 1
    for (int u = vcu; u < 256; u += G)
#pragma unroll 1
        for (int kv0 = 0; kv0 < 4 * REP_SW; ++kv0) sw_unit4(lds, P, u, kv0 & 3);
#endif
}

__device__ __forceinline__ unsigned f2bf(float f) { unsigned u = __builtin_bit_cast(unsigned, f); return (u + 0x7fffu + ((u >> 16) & 1u)) >> 16; }
__device__ __forceinline__ unsigned pk2(float lo, float hi) { return f2bf(lo) | (f2bf(hi) << 16); }
template <bool GU>
__device__ __forceinline__ void transpose_item(const float* __restrict__ W, int K, int N, bf16* __restrict__ WT, LAS float* scr, int item, int lane, const float* __restrict__ gk) {
    const int nblk = N / 32, kb = item / nblk, nb = item % nblk, k0 = 64 * kb, n0 = 32 * nb;
    int r0 = n0;
    if (GU) { r0 = (n0 < D_FF) ? (n0 >> 7) * 256 + (n0 & 127) : ((n0 - D_FF) >> 7) * 256 + 128 + ((n0 - D_FF) & 127); }
    float wv[32];
#pragma unroll
    for (int i = 0; i < 32; ++i) wv[i] = W[(size_t)(k0 + 2 * i + (lane >> 5)) * N + n0 + (lane & 31)];
#pragma unroll
    for (int i = 0; i < 32; ++i) scr[(2 * i + (lane >> 5)) * 33 + (lane & 31)] = gk ? wv[i] * gk[k0 + 2 * i + (lane >> 5)] : wv[i];
    asm volatile("s_waitcnt lgkmcnt(0)" ::: "memory");
    const int c = lane & 7;
#pragma unroll
    for (int j = 0; j < 4; ++j) { const int n = (lane >> 3) + 8 * j; const LAS float* s = scr + (8 * c) * 33 + n;
        u32x4 o; o.x = pk2(s[0 * 33], s[1 * 33]); o.y = pk2(s[2 * 33], s[3 * 33]); o.z = pk2(s[4 * 33], s[5 * 33]); o.w = pk2(s[6 * 33], s[7 * 33]);
        *(u32x4*)(WT + (size_t)(r0 + n) * K + k0 + 8 * c) = o; }
    asm volatile("s_waitcnt lgkmcnt(0)" ::: "memory");
}

template <bool HAS_T, bool NEXT, bool BASE_BF, bool OUT_BF>
__device__ __forceinline__ void rowpass(int gw, int ngw, int lane, const float* base0, const float* base1, const bf16* hin, const bf16* T, const float* part, const float* gpost, float alpha,
                                        float* out, bf16* hout, float* rs, bf16* xn, bool rev) {
    f32x4 gp[4][2];
#pragma unroll
    for (int j = 0; j < 4; ++j)
#pragma unroll
        for (int e = 0; e < 2; ++e) {
            if (HAS_T) gp[j][e] = *(const f32x4*)(gpost + j * 512 + lane * 8 + e * 4) * alpha;
        }
    for (int row_ = gw; row_ < M_TOT; row_ += ngw) {
        const int row = rev ? (M_TOT - 1 - row_) : row_;
        f32x4 v[4][2];
        if (BASE_BF) {
            u32x4 hw[4];
#pragma unroll
            for (int j = 0; j < 4; ++j) hw[j] = *(const u32x4*)(hin + (size_t)row * D_MODEL + j * 512 + lane * 8);
#pragma unroll
            for (int j = 0; j < 4; ++j) { v[j][0] = (f32x4){bf_lo(hw[j].x), bf_hi(hw[j].x), bf_lo(hw[j].y), bf_hi(hw[j].y)}; v[j][1] = (f32x4){bf_lo(hw[j].z), bf_hi(hw[j].z), bf_lo(hw[j].w), bf_hi(hw[j].w)}; }
        } else {
            const float* brow = (row < M_P ? base0 : base1) + (size_t)row * D_MODEL;
#pragma unroll
            for (int j = 0; j < 4; ++j) { v[j][0] = *(const f32x4*)(brow + j * 512 + lane * 8); v[j][1] = *(const f32x4*)(brow + j * 512 + lane * 8 + 4); }
        }
        if (HAS_T) {
            u32x4 tw[4];
#pragma unroll
            for (int j = 0; j < 4; ++j) tw[j] = *(const u32x4*)(T + (size_t)row * D_MODEL + j * 512 + lane * 8);
            float ps = (lane < 32) ? part[(size_t)row * 32 + lane] : 0.f;
            ps = wave_sum(ps);
            const float rstd = __builtin_amdgcn_rsqf(ps * (1.0f / D_MODEL) + EPS);
#pragma unroll
            for (int j = 0; j < 4; ++j) {
                const f32x4 t0 = {bf_lo(tw[j].x), bf_hi(tw[j].x), bf_lo(tw[j].y), bf_hi(tw[j].y)}, t1 = {bf_lo(tw[j].z), bf_hi(tw[j].z), bf_lo(tw[j].w), bf_hi(tw[j].w)};
                v[j][0] += t0 * rstd * gp[j][0]; v[j][1] += t1 * rstd * gp[j][1];
            }
            if (OUT_BF) {
                bf16* hr = hout + (size_t)row * D_MODEL;
#pragma unroll
                for (int j = 0; j < 4; ++j) {
                    u32x4 w; w.x = cvtpk(v[j][0][0], v[j][0][1]); w.y = cvtpk(v[j][0][2], v[j][0][3]); w.z = cvtpk(v[j][1][0], v[j][1][1]); w.w = cvtpk(v[j][1][2], v[j][1][3]);
                    *(u32x4*)(hr + j * 512 + lane * 8) = w;
                }
            } else {
                float* orow = out + (size_t)row * D_MODEL;
#pragma unroll
                for (int j = 0; j < 4; ++j) { *(f32x4*)(orow + j * 512 + lane * 8) = v[j][0]; *(f32x4*)(orow + j * 512 + lane * 8 + 4) = v[j][1]; }
            }
        }
        if (NEXT) {
            float ss = 0.f;
#pragma unroll
            for (int j = 0; j < 4; ++j)
#pragma unroll
                for (int e = 0; e < 2; ++e) ss += (v[j][e][0] * v[j][e][0] + v[j][e][1] * v[j][e][1]) + (v[j][e][2] * v[j][e][2] + v[j][e][3] * v[j][e][3]);
            ss = wave_sum(ss);
            if (lane == 0) rs[row] = __builtin_amdgcn_rsqf(ss * (1.0f / D_MODEL) + EPS);
            if (!HAS_T) {
                bf16* xr = xn + (size_t)row * D_MODEL;
#pragma unroll
                for (int j = 0; j < 4; ++j) {
                    u32x4 w; w.x = cvtpk(v[j][0][0], v[j][0][1]); w.y = cvtpk(v[j][0][2], v[j][0][3]); w.z = cvtpk(v[j][1][0], v[j][1][1]); w.w = cvtpk(v[j][1][2], v[j][1][3]);
                    *(u32x4*)(xr + j * 512 + lane * 8) = w;
                }
            }
        }
    }
}

#ifndef REP_P0
#define REP_P0 1
#endif
#ifndef REP_P1
#define REP_P1 1
#endif
#ifndef REP_P2
#define REP_P2 1
#endif
#ifndef REP_P3
#define REP_P3 1
#endif
#ifndef REP_P4
#define REP_P4 1
#endif
#ifndef REP_P5
#define REP_P5 1
#endif
#ifndef REP_P6
#define REP_P6 1
#endif
#ifndef REP_P7
#define REP_P7 1
#endif
#ifndef REP_P8
#define REP_P8 1
#endif
#ifndef REP_P9
#define REP_P9 1
#endif
#ifndef REP_P10
#define REP_P10 1
#endif
#define XB_TMO      128
#define XB_XCNT(j)  (256  + 64 * (j))
#define XB_XSUB(j)  (1280 + 64 * (j))
#define XB_XGEN(j)  (2304 + 64 * (j))
#define XB_TOP      3328
#define XB_TOPGEN   3392
#define XCD_BAR_WORDS 3456
#define XB_SPIN_CAP (1u << 18)

__device__ __forceinline__ unsigned xb_ld(unsigned* p)              { return __hip_atomic_load(p, __ATOMIC_RELAXED, __HIP_MEMORY_SCOPE_AGENT); }
__device__ __forceinline__ unsigned xb_add(unsigned* p, unsigned v) { return __hip_atomic_fetch_add(p, v, __ATOMIC_RELAXED, __HIP_MEMORY_SCOPE_AGENT); }
__device__ __forceinline__ unsigned xb_xcc_id() { return (unsigned)__builtin_amdgcn_s_getreg((3 << 11) | 20) & 0xFu; }
#define XB_SPIN(cond, bar) do { unsigned _sp = 0; while (cond) { __builtin_amdgcn_s_sleep(1); \
    if ((++_sp & 255u) == 0u) { if (xb_ld(&(bar)[XB_TMO])) break; if (_sp > XB_SPIN_CAP) { atomicAdd(&(bar)[XB_TMO], 1u); break; } } } } while (0)

struct XcdBarrier {
    unsigned* bar; unsigned x;
    unsigned nloc, nx;
};

__device__ __forceinline__ XcdBarrier xcd_barrier_post(unsigned* bar) {
    XcdBarrier b; b.bar = bar; b.x = xb_xcc_id(); b.nloc = 0u; b.nx = 0u;
    if (threadIdx.x == 0) (void)xb_add(&bar[XB_XCNT(b.x)], 1u);
    return b;
}
__device__ __forceinline__ void xcd_barrier_complete(unsigned* bar, unsigned x, unsigned& nloc, unsigned& nx) {
    const unsigned G = gridDim.x * gridDim.y * gridDim.z;
    unsigned sum, cnt, mine, sp = 0u;
    for (;;) {
        sum = 0u; cnt = 0u; mine = 0u;
#pragma unroll
        for (unsigned j = 0; j < 16; ++j) { const unsigned c = xb_ld(&bar[XB_XCNT(j)]); sum += c; cnt += (c > 0u) ? 1u : 0u; mine = (j == x) ? c : mine; }
        if (sum == G) break;
        __builtin_amdgcn_s_sleep(1);
        if ((++sp & 255u) == 0u) { if (xb_ld(&bar[XB_TMO])) break; if (sp > XB_SPIN_CAP) { atomicAdd(&bar[XB_TMO], 1u); break; } }
    }
    nloc = mine > 0u ? mine : 1u; nx = cnt > 0u ? cnt : 1u;
}

__device__ __forceinline__ void xcd_barrier(XcdBarrier& b) {
    asm volatile("s_waitcnt vmcnt(0)" ::: "memory");
    __syncthreads();
    if (threadIdx.x == 0) {
        unsigned* bar = b.bar;
        __builtin_amdgcn_s_waitcnt(0);
        unsigned nloc = b.nloc, nx = b.nx;
        if (nloc == 0u) { xcd_barrier_complete(bar, b.x, nloc, nx); b.nloc = nloc; b.nx = nx; }
        const unsigned old = xb_add(&bar[XB_XSUB(b.x)], 1u);
        const unsigned gen = old / nloc;
        if (old + 1u == (gen + 1u) * nloc) {
            __builtin_amdgcn_fence(__ATOMIC_RELEASE, "agent");
            asm volatile("s_waitcnt vmcnt(0)" ::: "memory");
            const unsigned og = xb_add(&bar[XB_TOP], 1u);
            const unsigned tg = og / nx;
            if (og + 1u == (tg + 1u) * nx) xb_add(&bar[XB_TOPGEN], 1u);
            else XB_SPIN(xb_ld(&bar[XB_TOPGEN]) == tg, bar);
            __builtin_amdgcn_fence(__ATOMIC_ACQUIRE, "agent");
            xb_add(&bar[XB_XGEN(b.x)], 1u);
            asm volatile("s_waitcnt vmcnt(0)" ::: "memory");
        } else {
            XB_SPIN(xb_ld(&bar[XB_XGEN(b.x)]) == gen, bar);
            __builtin_amdgcn_fence(__ATOMIC_ACQUIRE, "agent");
            asm volatile("s_waitcnt vmcnt(0)" ::: "memory");
        }
    }
    __syncthreads();
}

constexpr int N_PHASES = 11;
struct Args { const float* in[21]; float* out; unsigned char* ws; int ph_lo, ph_hi; };
static_assert(sizeof(Args) == 21 * 8 + 8 + 8 + 8, "Args has no padding");

__global__ void __launch_bounds__(NTHREADS, 2) mega_fwd(Args args) {
    extern __shared__ __attribute__((aligned(16))) unsigned char lds_raw[];
    LAS unsigned char* lds = (LAS unsigned char*)lds_raw;
    cg::grid_group grid = cg::this_grid();
    const int tid = threadIdx.x, lane = tid & 63, wave = __builtin_amdgcn_readfirstlane(tid >> 6);
    const int G = gridDim.x, bx = blockIdx.x;
    const int vcu = (G % 8 == 0) ? (bx % 8) * (G / 8) + bx / 8 : bx;
    const int gw = vcu * NWAVES + wave, ngw = G * NWAVES;
    unsigned char* ws = args.ws;
    const float* x_prompt = args.in[0]; const float* x_sample = args.in[1]; const float* rel_bias = args.in[2];
    const float* g_ffn1_pre = args.in[3]; const float* w_ffn1_gu = args.in[4]; const float* w_ffn1_down = args.in[5]; const float* g_ffn1_post = args.in[6];
    const float* g_mix_pre = args.in[7]; const float* w_in = args.in[8];
    const float* lq1 = args.in[9]; const float* lk1 = args.in[10]; const float* lq2 = args.in[11]; const float* lk2 = args.in[12];
    const float* g_subln = args.in[13]; const float* sink = args.in[14]; const float* w_out = args.in[15]; const float* g_mix_post = args.in[16];
    const float* g_ffn2_pre = args.in[17]; const float* w_ffn2_gu = args.in[18]; const float* w_ffn2_down = args.in[19]; const float* g_ffn2_post = args.in[20];
    float* out = args.out;
    bf16* Wgu1 = (bf16*)(ws + WS_WGU1); bf16* Wd1 = (bf16*)(ws + WS_WD1); bf16* Win = (bf16*)(ws + WS_WIN); bf16* Wout = (bf16*)(ws + WS_WOUT);
    bf16* Wgu2 = (bf16*)(ws + WS_WGU2); bf16* Wd2 = (bf16*)(ws + WS_WD2);
    float* PART = (float*)(ws + WS_PART); float* RS = (float*)(ws + WS_RS); bf16* XN = (bf16*)(ws + WS_XN); bf16* T = (bf16*)(ws + WS_T); bf16* ACT = (bf16*)(ws + WS_ACT); bf16* H = (bf16*)(ws + WS_H);
    const float* xs_off = x_sample - (size_t)M_P * D_MODEL;
    const int lo = args.ph_lo, hi = args.ph_hi;
    XcdBarrier xbar; xbar.bar = (unsigned*)(ws + WS_BAR); xbar.x = 0u; xbar.nloc = 0u; xbar.nx = 0u;
#ifndef PH_MASK
#define PH_MASK 0x7ff
#endif
#define IN(k) (((PH_MASK >> (k)) & 1) && lo <= (k) && (k) < hi)
#define SEAM(k) do { if ((k) + 1 < hi) { if ((k) == 0) grid.sync(); else xcd_barrier(xbar); } } while (0)

    if (IN(0)) for (int rep_ = 0; rep_ < REP_P0; ++rep_) {
        LAS float* scr = (LAS float*)(lds + wave * 16384);
        constexpr int I_GU = (D_MODEL / 64) * (2 * D_FF / 32), I_D = (D_FF / 64) * (D_MODEL / 32), I_IN = (D_MODEL / 64) * (D_IN / 32), I_OUT = (D_MODEL / 64) * (D_MODEL / 32);
        constexpr int NITEMS = 2 * I_GU + 2 * I_D + I_IN + I_OUT;
        for (int it = gw; it < NITEMS; it += ngw) {
            int r = it;
            if (r < I_GU) { transpose_item<true>(w_ffn1_gu, D_MODEL, 2 * D_FF, Wgu1, scr, r, lane, g_ffn1_pre); continue; } r -= I_GU;
            if (r < I_GU) { transpose_item<true>(w_ffn2_gu, D_MODEL, 2 * D_FF, Wgu2, scr, r, lane, g_ffn2_pre); continue; } r -= I_GU;
            if (r < I_D) { transpose_item<false>(w_ffn1_down, D_FF, D_MODEL, Wd1, scr, r, lane, nullptr); continue; } r -= I_D;
            if (r < I_D) { transpose_item<false>(w_ffn2_down, D_FF, D_MODEL, Wd2, scr, r, lane, nullptr); continue; } r -= I_D;
            if (r < I_IN) { transpose_item<false>(w_in, D_MODEL, D_IN, Win, scr, r, lane, g_mix_pre); continue; } r -= I_IN;
            transpose_item<false>(w_out, D_MODEL, D_MODEL, Wout, scr, r, lane, nullptr);
        }
        rowpass<false, true, false, false>(gw, ngw, lane, x_prompt, xs_off, nullptr, nullptr, nullptr, nullptr, 0.f, nullptr, nullptr, RS, XN, false);
        if (rep_ == 0 && bx == 0) { for (int i = tid; i < 4096; i += NTHREADS) ((unsigned*)(ws + WS_BAR))[i] = 0u; }
        SEAM(0);
        if (rep_ == 0) xbar = xcd_barrier_post((unsigned*)(ws + WS_BAR));
    }
    if (IN(1)) for (int rep_ = 0; rep_ < REP_P1; ++rep_) {
        pg8::Gemm g{XN, Wgu1, M_TOT, 2 * D_FF, D_MODEL}; pg8::StaticOrder S; S.init(M_TOT, 2 * D_FF, G, bx, 1);
        pg8::EpiSwiglu E{ACT, D_FF, RS};
        pg8::gemm_phase<pg8::EpiSwiglu, pg8::StaticOrder, PG8_ALIGN, PG8_SP2>(lds, g, S, E);
        SEAM(1);
    }
    if (IN(2)) for (int rep_ = 0; rep_ < REP_P2; ++rep_) {
        pg8::Gemm g{ACT, Wd1, M_TOT, D_MODEL, D_FF}; pg8::StaticOrder S; S.init(M_TOT, D_MODEL, G, bx);
        pg8::EpiT E{T, D_MODEL, PART};
        pg8::gemm_phase<pg8::EpiT, pg8::StaticOrder, PG8_ALIGN, PG8_SP2>(lds, g, S, E);
        SEAM(2);
    }
#ifdef PROBE_SYNCS
    for (int i_ = 0; i_ < PROBE_SYNCS; ++i_) grid.sync();
#endif
    if (IN(3)) for (int rep_ = 0; rep_ < REP_P3; ++rep_) {
        rowpass<true, true, false, true>(gw, ngw, lane, x_prompt, xs_off, nullptr, T, PART, g_ffn1_post, 0.5f, nullptr, H, RS, nullptr, true);
        SEAM(3);
    }
    if (IN(4)) for (int rep_ = 0; rep_ < REP_P4; ++rep_) {
        pg8::Gemm g{H, Win, M_TOT, D_IN, D_MODEL}; pg8::StaticOrder S; S.init(M_TOT, D_IN, G, bx);
        pg8::EpiProj E{(bf16*)(ws + WS_QDA), (bf16*)(ws + WS_KDA), (bf16*)(ws + WS_VTDA), (bf16*)(ws + WS_QSW), (bf16*)(ws + WS_KSW), (bf16*)(ws + WS_VTSW), QSCALE, lds + 131072, RS};
        pg8::gemm_phase<pg8::EpiProj, pg8::StaticOrder, PG8_ALIGN, PG8_SP2>(lds, g, S, E);
#ifdef PROBE_DUP_P4
        grid.sync();
        pg8::gemm_phase<pg8::EpiProj, pg8::StaticOrder, PG8_ALIGN, PG8_SP2>(lds, g, S, E);
#endif
        SEAM(4);
    }
    if (IN(5)) for (int rep_ = 0; rep_ < REP_P5; ++rep_) {
        AttnP P{(const bf16*)(ws + WS_QDA), (const bf16*)(ws + WS_KDA), (const bf16*)(ws + WS_VTDA), (const bf16*)(ws + WS_QSW), (const bf16*)(ws + WS_KSW), (const bf16*)(ws + WS_VTSW), XN, rel_bias, g_subln, sink, (float*)(ws + WS_T)};
        attn_phase(lds, P, vcu, G, lq1, lk1, lq2, lk2);
        SEAM(5);
    }
    if (IN(6)) for (int rep_ = 0; rep_ < REP_P6; ++rep_) {
        pg8::Gemm g{XN, Wout, M_TOT, D_MODEL, D_MODEL}; pg8::StaticOrder S; S.init(M_TOT, D_MODEL, G, bx);
        pg8::EpiT E{T, D_MODEL, PART};
        pg8::gemm_phase<pg8::EpiT, pg8::StaticOrder, PG8_ALIGN, PG8_SP2>(lds, g, S, E);
        SEAM(6);
    }
    if (IN(7)) for (int rep_ = 0; rep_ < REP_P7; ++rep_) {
        rowpass<true, true, true, true>(gw, ngw, lane, nullptr, nullptr, H, T, PART, g_mix_post, 1.0f, nullptr, H, RS, nullptr, true);
        SEAM(7);
    }
    if (IN(8)) for (int rep_ = 0; rep_ < REP_P8; ++rep_) {
        pg8::Gemm g{H, Wgu2, M_TOT, 2 * D_FF, D_MODEL}; pg8::StaticOrder S; S.init(M_TOT, 2 * D_FF, G, bx);
        pg8::EpiSwiglu E{ACT, D_FF, RS};
        pg8::gemm_phase<pg8::EpiSwiglu, pg8::StaticOrder, PG8_ALIGN, PG8_SP2>(lds, g, S, E);
        SEAM(8);
    }
    if (IN(9)) for (int rep_ = 0; rep_ < REP_P9; ++rep_) {
        pg8::Gemm g{ACT, Wd2, M_TOT, D_MODEL, D_FF}; pg8::StaticOrder S; S.init(M_TOT, D_MODEL, G, bx, 1);
        pg8::EpiT E{T, D_MODEL, PART};
        pg8::gemm_phase<pg8::EpiT, pg8::StaticOrder, PG8_ALIGN, PG8_SP2>(lds, g, S, E);
        SEAM(9);
    }
    if (IN(10)) for (int rep_ = 0; rep_ < REP_P10; ++rep_) {
        rowpass<true, false, true, false>(gw, ngw, lane, nullptr, nullptr, H, T, PART, g_ffn2_post, 0.5f, out, nullptr, nullptr, nullptr, false);
    }
#undef IN
#undef SEAM
}

#ifndef MK_MULTI_LAUNCH
#define MK_MULTI_LAUNCH 0
#endif
extern "C" void kernel_launch(void* const* d_in, const int* in_sizes, int n_in, void* d_out, int out_size, void* d_ws, size_t ws_size, hipStream_t stream) {
    static int grid = 0;
    if (grid == 0) {
        if (n_in != 21 || out_size != M_TOT * D_MODEL || ws_size < WS_END) { fprintf(stderr, "kernel_launch: unexpected shapes (n_in %d, out %d, ws %zu)\n", n_in, out_size, ws_size); grid = -1; return; }
        int dev = 0, cus = 0, per_cu = 0;
        hipGetDevice(&dev);
        hipDeviceGetAttribute(&cus, hipDeviceAttributeMultiprocessorCount, dev);
        if (hipFuncSetAttribute((const void*)mega_fwd, hipFuncAttributeMaxDynamicSharedMemorySize, LDS_BYTES) != hipSuccess) { fprintf(stderr, "kernel_launch: hipFuncSetAttribute failed\n"); grid = -1; return; }
        if (hipOccupancyMaxActiveBlocksPerMultiprocessor(&per_cu, (const void*)mega_fwd, NTHREADS, LDS_BYTES) != hipSuccess || per_cu < 1) { fprintf(stderr, "kernel_launch: occupancy query gave %d\n", per_cu); per_cu = 1; }
        (void)hipGetLastError();
        grid = cus * per_cu;
    }
    if (grid < 0) return;
    Args a{};
    for (int i = 0; i < 21; ++i) a.in[i] = (const float*)d_in[i];
    a.out = (float*)d_out; a.ws = (unsigned char*)d_ws;
#if MK_MULTI_LAUNCH
    for (int p = 0; p < N_PHASES; ++p) {
        a.ph_lo = p; a.ph_hi = p + 1;
        hipLaunchKernelGGL(mega_fwd, dim3(grid), dim3(NTHREADS), LDS_BYTES, stream, a);
    }
#else
    a.ph_lo = 0; a.ph_hi = N_PHASES;
    void* kargs[] = {&a};
    hipError_t e = hipLaunchCooperativeKernel((const void*)mega_fwd, dim3(grid), dim3(NTHREADS), kargs, LDS_BYTES, stream);
    if (e != hipSuccess) fprintf(stderr, "cooperative launch failed: %s (grid %d)\n", hipGetErrorString(e), grid);
#endif
}
```

```cpp
#include <hip/hip_runtime.h>
#include <hip/hip_cooperative_groups.h>
#include <cstdio>
#include <cstdint>
#include <cmath>
namespace cg = cooperative_groups;
#define MK_MULTI_LAUNCH 0
namespace pg8 {
#define PG8_LAS __attribute__((address_space(3)))
typedef unsigned short bf16_t;
typedef short bf16x8 __attribute__((ext_vector_type(8)));
typedef float f32x4 __attribute__((ext_vector_type(4)));
typedef unsigned u32x4 __attribute__((ext_vector_type(4)));
constexpr int BM = 256, BK = 64, HALF = 128, HTB = HALF * BK * 2  , STAGE_BYTES = 8 * HTB, NXCD = 8, WGM = 8;

__host__ __device__ __forceinline__ int lds_byte(int r, int c) { const int st = (r >> 4) * 2 + (c >> 5), rr = r & 15, cc = c & 31, ob = rr * 64 + cc * 2; return st * 1024 + (ob ^ (((ob >> 9) & 1) << 5)); }
__host__ __device__ __forceinline__ void stage_rc(int b, int& R, int& C) { const int st = b / 1024, sb = b % 1024, swz = sb ^ (((sb >> 9) & 1) << 5); R = (st >> 1) * 16 + swz / 64; C = (st & 1) * 32 + (swz % 64) / 2; }
__host__ __device__ __forceinline__ int perm32(int rho) { const int n = rho >> 4, i = rho & 15; return 8 * (i >> 2) + 4 * n + (i & 3); }

struct Unit { int pm, pn; };
struct Gemm { const bf16_t* A; const bf16_t* Bt; int M, N, K; };

struct StaticOrder {
    int nM, nN, nwg, G, c, rev;
    __host__ __device__ void init(int M, int N, int G_, int c_, int rev_ = 0) { nM = M / BM; nN = N / BM; nwg = nM * nN; G = G_; c = c_; rev = rev_; }
    __host__ __device__ bool next(int i, Unit& u) const {
        const long L = (long)i * G + c; if (L >= nwg) return false;
        int wgid = (int)L; { const int q = nwg / NXCD, r = nwg % NXCD, xcd = wgid % NXCD, off = wgid / NXCD; wgid = (xcd < r ? xcd * (q + 1) : r * (q + 1) + (xcd - r) * q) + off; }
        const int nig = WGM * nN, gid = wgid / nig, fm = gid * WGM, gsz = (nM - fm) < WGM ? (nM - fm) : WGM;
        u.pm = fm + ((wgid % nig) % gsz); u.pn = (wgid % nig) / gsz; if (rev) u.pm = nM - 1 - u.pm; return true;
    }
    __device__ __forceinline__ void a_ready(const Unit&) const {}
    __device__ __forceinline__ void done(const Unit&) const {}
};
__device__ __forceinline__ unsigned cvt_pk_bf16(float lo, float hi) { unsigned r; asm volatile("v_cvt_pk_bf16_f32 %0, %1, %2" : "=v"(r) : "v"(lo), "v"(hi)); return r; }
typedef unsigned u32x2 __attribute__((ext_vector_type(2)));
__device__ __forceinline__ float silu_mul(float g, float u) {
    const float e = __builtin_amdgcn_exp2f(g * -1.4426950408889634f);
    return g * __builtin_amdgcn_rcpf(1.0f + e) * u;
}
struct EpiSwiglu {
    static constexpr bool PERM = true, AFTER_DRAIN = false; static constexpr int NST = 8;
    bf16_t* O; int ldc; const float* rs;
    __device__ __forceinline__ void pre(const Unit& u, int wr, int fr, float (&rv)[8]) const {
#pragma unroll
        for (int i = 0; i < 8; ++i) rv[i] = rs[u.pm * BM + wr * 64 + fr + (i >> 2) * HALF + (i & 3) * 16];
    }
    __device__ __forceinline__ void operator()(const f32x4 (&acc)[2][2][4][2], const Unit& u, int wr, int wc, int fr, int fq, const float (&rv)[8]) const {
        const int row0 = u.pm * BM + wr * 64 + fr, col0 = u.pn * HALF + wc * 32 + 8 * fq;
#pragma unroll
        for (int ai = 0; ai < 2; ++ai)
#pragma unroll
            for (int m = 0; m < 4; ++m) {
                bf16_t* rowp = O + (size_t)(row0 + ai * HALF + m * 16) * ldc + col0;
                const float r = rv[ai * 4 + m];
                const f32x4 g0 = acc[ai][0][m][0] * r, g1 = acc[ai][0][m][1] * r, u0 = acc[ai][1][m][0] * r, u1 = acc[ai][1][m][1] * r;
                u32x4 w;
                w.x = cvt_pk_bf16(silu_mul(g0[0], u0[0]), silu_mul(g0[1], u0[1]));
                w.y = cvt_pk_bf16(silu_mul(g0[2], u0[2]), silu_mul(g0[3], u0[3]));
                w.z = cvt_pk_bf16(silu_mul(g1[0], u1[0]), silu_mul(g1[1], u1[1]));
                w.w = cvt_pk_bf16(silu_mul(g1[2], u1[2]), silu_mul(g1[3], u1[3]));
                *(u32x4*)rowp = w;
            }
    }
};
struct EpiT {
    static constexpr bool PERM = true, AFTER_DRAIN = false; static constexpr int NST = 16;
    bf16_t* O; int ldc; float* part;
    __device__ __forceinline__ void pre(const Unit&, int, int, float (&)[8]) const {}
    __device__ __forceinline__ void operator()(const f32x4 (&acc)[2][2][4][2], const Unit& u, int wr, int wc, int fr, int fq, const float (&)[8]) const {
        const int row0 = u.pm * BM + wr * 64 + fr, col0 = u.pn * BM + wc * 32 + 8 * fq;
#pragma unroll
        for (int ai = 0; ai < 2; ++ai)
#pragma unroll
            for (int m = 0; m < 4; ++m) {
                const int row = row0 + ai * HALF + m * 16;
                bf16_t* rowp = O + (size_t)row * ldc + col0;
                float ss = 0.f;
#pragma unroll
                for (int bj = 0; bj < 2; ++bj) {
                    const f32x4 v0 = acc[ai][bj][m][0], v1 = acc[ai][bj][m][1];
                    ss += (v0[0] * v0[0] + v0[1] * v0[1]) + (v0[2] * v0[2] + v0[3] * v0[3]) + (v1[0] * v1[0] + v1[1] * v1[1]) + (v1[2] * v1[2] + v1[3] * v1[3]);
                    u32x4 w; w.x = cvt_pk_bf16(v0[0], v0[1]); w.y = cvt_pk_bf16(v0[2], v0[3]); w.z = cvt_pk_bf16(v1[0], v1[1]); w.w = cvt_pk_bf16(v1[2], v1[3]);
                    *(u32x4*)(rowp + bj * HALF) = w;
                }
                ss += __shfl_xor(ss, 16); ss += __shfl_xor(ss, 32);
                if (fq == 0) part[(size_t)row * 32 + u.pn * 4 + wc] = ss;
            }
    }
};
struct EpiProj {
    static constexpr bool PERM = true, AFTER_DRAIN = false; static constexpr int NST = 16;
    bf16_t *Qda, *Kda, *VTda, *Qsw, *Ksw, *VTsw; float qscale; PG8_LAS unsigned char* epi_lds; const float* rs;
    __device__ __forceinline__ void pre(const Unit& u, int wr, int fr, float (&rv)[8]) const {
#pragma unroll
        for (int i = 0; i < 8; ++i) rv[i] = rs[u.pm * BM + wr * 64 + fr + (i >> 2) * HALF + (i & 3) * 16];
    }
    __device__ __forceinline__ void operator()(const f32x4 (&acc)[2][2][4][2], const Unit& u, int wr, int wc, int fr, int fq, const float (&rv)[8]) const {
        const int pn = u.pn;
        const int row0 = u.pm * BM + wr * 64 + fr;
        const int trow = u.pm * BM;
        int S, seqbase;
        if (trow < 32768) { S = 2048; seqbase = trow & ~2047; } else { S = 4096; seqbase = 32768 + ((trow - 32768) & ~4095); }
        const int s0 = row0 - seqbase;
        if (pn < 8 || (pn >= 12 && pn < 17)) {
            bf16_t* base; int colt; float sc = 1.f;
            if (pn < 4) { base = Qda + (size_t)seqbase * 1024; colt = pn * BM; sc = qscale; }
            else if (pn < 8) { base = Kda + (size_t)seqbase * 1024; colt = (pn - 4) * BM; }
            else if (pn < 16) { base = Qsw + (size_t)seqbase * 1024; colt = (pn - 12) * BM; sc = qscale; }
            else { base = Ksw + (size_t)seqbase * 256; colt = 0; }
            const int d0 = (wc & 1) * 32 + 8 * fq;
#pragma unroll
            for (int bj = 0; bj < 2; ++bj) {
                bf16_t* hb = base + (size_t)((colt >> 6) + bj * 2 + (wc >> 1)) * 64 * S + d0;
#pragma unroll
                for (int ai = 0; ai < 2; ++ai)
#pragma unroll
                    for (int m = 0; m < 4; ++m) {
                        const float r = rv[ai * 4 + m] * sc;
                        const f32x4 v0 = acc[ai][bj][m][0] * r, v1 = acc[ai][bj][m][1] * r;
                        u32x4 w; w.x = cvt_pk_bf16(v0[0], v0[1]); w.y = cvt_pk_bf16(v0[2], v0[3]); w.z = cvt_pk_bf16(v1[0], v1[1]); w.w = cvt_pk_bf16(v1[2], v1[3]);
                        *(u32x4*)(hb + (size_t)(s0 + ai * HALF + m * 16) * 64) = w;
                    }
            }
        } else {
            bf16_t* base; int colt, dvh;
            if (pn < 12) { base = VTda + (size_t)seqbase * 1024; colt = (pn - 8) * BM; dvh = 128; } else { base = VTsw + (size_t)seqbase * 256; colt = 0; dvh = 64; }
            const int lane = fq * 16 + fr;
            PG8_LAS unsigned char* wl = epi_lds + (wr * 4 + wc) * 4096;
            const int stw = (u.pm * BM + wr * 64 - seqbase) >> 6;
#pragma unroll
            for (int ai = 0; ai < 2; ++ai)
#pragma unroll
                for (int bj = 0; bj < 2; ++bj) {
#pragma unroll
                    for (int m = 0; m < 4; ++m)
#pragma unroll
                        for (int n = 0; n < 2; ++n) {
                            const f32x4 v = acc[ai][bj][m][n] * rv[ai * 4 + m];
                            const unsigned p01 = cvt_pk_bf16(v[0], v[1]), p23 = cvt_pk_bf16(v[2], v[3]);
                            const int token = m * 16 + fr, d = 8 * fq + 4 * n;
                            PG8_LAS unsigned char* wp = wl + d * 128 + (((token >> 3) ^ fq) << 4) + (token & 7) * 2;
                            *(PG8_LAS bf16_t*)(wp) = (bf16_t)(p01 & 0xffffu); *(PG8_LAS bf16_t*)(wp + 128) = (bf16_t)(p01 >> 16);
                            *(PG8_LAS bf16_t*)(wp + 256) = (bf16_t)(p23 & 0xffffu); *(PG8_LAS bf16_t*)(wp + 384) = (bf16_t)(p23 >> 16);
                        }
                    const int c0 = colt + bj * HALF + wc * 32, h = (dvh == 128) ? (c0 >> 7) : (c0 >> 6), dd0 = c0 & (dvh - 1);
                    bf16_t* blk = base + (size_t)h * dvh * S + (size_t)(stw + 2 * ai) * (dvh * 64) + dd0 * 64;
#pragma unroll
                    for (int i = 0; i < 4; ++i) {
                        const int q = lane + 64 * i, d = q >> 3, c = q & 7;
                        const u32x4 w = *(const PG8_LAS u32x4*)(wl + d * 128 + ((c ^ ((d >> 3) & 7)) << 4));
                        *(u32x4*)(blk + q * 8) = w;
                    }
                }
        }
    }
};
template <class Epi, class Sched, bool ALIGN_EPI = false, bool SP2 = false>
__device__ __forceinline__ void gemm_phase(PG8_LAS unsigned char* lds, const Gemm g, const Sched& S, const Epi& E) {
    const int tid = threadIdx.x, wid = __builtin_amdgcn_readfirstlane(tid >> 6), lane = tid & 63, wr = wid >> 2, wc = wid & 3, fr = lane & 15, fq = lane >> 4;
    const int K = g.K, nt = K / BK;
    unsigned voffA[2], voffB[2];
#pragma unroll
    for (int i = 0; i < 2; ++i) { int R, C; stage_rc(tid * 16 + i * 8192, R, C); const int Rb = Epi::PERM ? ((R & ~31) + perm32(R & 31)) : R;
        voffA[i] = (unsigned)(R * K + C) * 2u; voffB[i] = (unsigned)(Rb * K + C) * 2u; }
    const size_t kstep = (size_t)(BK * 2);
    const size_t hstep = (size_t)HALF * K * 2;
    const size_t tstep = 2 * hstep;
    const unsigned ldsw = (unsigned)wid * 1024u;
    const int aoff = lds_byte(wr * 64 + fr, fq * 8), boff = lds_byte(wc * 32 + fr, fq * 8);
#define PG8_SA(b, h) (((b) * 2 + (h)) * HTB)
#define PG8_SB(b, h) ((4 + (b) * 2 + (h)) * HTB)
#define PG8_STAGE(bufoff, gbase, voff) do { _Pragma("unroll") for (int _i = 0; _i < 2; ++_i) \
        __builtin_amdgcn_global_load_lds((const unsigned*)((const char*)(gbase) + (voff)[_i]), (PG8_LAS unsigned*)(lds + (bufoff) + ldsw + _i * 8192), 16, 0, 0); } while (0)
#define PG8_LDA(dst, b, h) do { _Pragma("unroll") for (int m = 0; m < 4; ++m) _Pragma("unroll") for (int k = 0; k < 2; ++k) dst[m][k] = *(const PG8_LAS bf16x8*)(lds + PG8_SA(b, h) + aoff + m * 2048 + k * 1024); } while (0)
#define PG8_LDB(dst, b, h) do { _Pragma("unroll") for (int n = 0; n < 2; ++n) _Pragma("unroll") for (int k = 0; k < 2; ++k) dst[n][k] = *(const PG8_LAS bf16x8*)(lds + PG8_SB(b, h) + boff + n * 2048 + k * 1024); } while (0)
#define PG8_MMA(ai, bj, At, Bt) do { __builtin_amdgcn_s_setprio(1); _Pragma("unroll") for (int m = 0; m < 4; ++m) _Pragma("unroll") for (int n = 0; n < 2; ++n) _Pragma("unroll") for (int k = 0; k < 2; ++k) \
        acc[ai][bj][m][n] = __builtin_amdgcn_mfma_f32_16x16x32_bf16(Bt[n][k], At[m][k], acc[ai][bj][m][n], 0, 0, 0); __builtin_amdgcn_s_setprio(0); } while (0)
#define PG8_WAIT_V(n) asm volatile("s_waitcnt vmcnt(" #n ")" ::: "memory")
#define PG8_WAIT_L(n) asm volatile("s_waitcnt lgkmcnt(" #n ")" ::: "memory")
#define PG8_BAR __builtin_amdgcn_s_barrier()
#define PG8_SCHED __builtin_amdgcn_sched_barrier(0)
    Unit cur, nxt; int ui = 0;
    if (!S.next(0, cur)) return;
    float epre[8]; E.pre(cur, wr, fr, epre);
    f32x4 acc[2][2][4][2];
#pragma unroll
    for (int a = 0; a < 2; ++a)
#pragma unroll
        for (int b = 0; b < 2; ++b)
#pragma unroll
            for (int m = 0; m < 4; ++m)
#pragma unroll
                for (int n = 0; n < 2; ++n) acc[a][b][m][n] = (f32x4){0.f, 0.f, 0.f, 0.f};
    bf16x8 At[4][2], B0[2][2], B1[2][2];
    const char* cA = (const char*)g.A + (size_t)cur.pm * tstep; const char* cB = (const char*)g.Bt + (size_t)cur.pn * tstep;
    S.a_ready(cur);
    if constexpr (SP2) {
        PG8_STAGE(PG8_SB(0, 0), cB, voffB); PG8_STAGE(PG8_SB(0, 1), cB + hstep, voffB); PG8_STAGE(PG8_SA(0, 0), cA, voffA); PG8_STAGE(PG8_SA(0, 1), cA + hstep, voffA);
        if (wr == 1) PG8_BAR;
        PG8_WAIT_V(2); PG8_BAR;
        PG8_STAGE(PG8_SB(1, 0), cB + kstep, voffB); PG8_STAGE(PG8_SA(1, 0), cA + kstep, voffA); PG8_STAGE(PG8_SB(1, 1), cB + hstep + kstep, voffB);
        PG8_WAIT_V(6); PG8_BAR;
    } else {
        PG8_STAGE(PG8_SB(0, 0), cB, voffB); PG8_STAGE(PG8_SA(0, 0), cA, voffA); PG8_STAGE(PG8_SB(0, 1), cB + hstep, voffB); PG8_STAGE(PG8_SA(0, 1), cA + hstep, voffA);
        if (wr == 1) PG8_BAR;
        PG8_WAIT_V(4); PG8_BAR;
        PG8_STAGE(PG8_SB(1, 0), cB + kstep, voffB); PG8_STAGE(PG8_SA(1, 0), cA + kstep, voffA); PG8_STAGE(PG8_SB(1, 1), cB + hstep + kstep, voffB);
        PG8_WAIT_V(6); PG8_BAR;
    }
    for (;;) {
        const bool has_next = S.next(ui + 1, nxt);
        const char* nA = has_next ? (const char*)g.A + (size_t)nxt.pm * tstep : cA; const char* nB = has_next ? (const char*)g.Bt + (size_t)nxt.pn * tstep : cB;
        for (int t = 0; t < nt; t += 2) {
            const bool last = (t == nt - 2);
            const char* a1 = cA + (size_t)(t + 1) * kstep;
            const char* a2 = last ? nA : cA + (size_t)(t + 2) * kstep; const char* b2 = last ? nB : cB + (size_t)(t + 2) * kstep;
            const char* a3 = a2 + kstep; const char* b3 = b2 + kstep;
            if (last && has_next) S.a_ready(nxt);
            if constexpr (SP2) {
            PG8_LDB(B0, 0, 0); PG8_LDB(B1, 0, 1); PG8_SCHED; PG8_LDA(At, 0, 0); PG8_STAGE(PG8_SA(1, 1), a1 + hstep, voffA);
            PG8_WAIT_V(8); PG8_WAIT_L(0); PG8_BAR; PG8_MMA(0, 0, At, B0); PG8_MMA(0, 1, At, B1); PG8_BAR; PG8_SCHED;
            PG8_LDA(At, 0, 1); PG8_STAGE(PG8_SB(0, 0), b2, voffB); PG8_STAGE(PG8_SB(0, 1), b2 + hstep, voffB); PG8_STAGE(PG8_SA(0, 0), a2, voffA);
            PG8_WAIT_V(8); PG8_WAIT_L(0); PG8_BAR; PG8_MMA(1, 0, At, B0); PG8_MMA(1, 1, At, B1); PG8_BAR; PG8_SCHED;
            PG8_LDB(B0, 1, 0); PG8_LDB(B1, 1, 1); PG8_SCHED; PG8_LDA(At, 1, 0); PG8_STAGE(PG8_SA(0, 1), a2 + hstep, voffA);
            PG8_WAIT_V(8); PG8_WAIT_L(0); PG8_BAR; PG8_MMA(0, 0, At, B0); PG8_MMA(0, 1, At, B1); PG8_BAR; PG8_SCHED;
            PG8_LDA(At, 1, 1); PG8_STAGE(PG8_SB(1, 0), b3, voffB); PG8_STAGE(PG8_SB(1, 1), b3 + hstep, voffB); PG8_STAGE(PG8_SA(1, 0), a3, voffA);
            PG8_WAIT_V(8); PG8_WAIT_L(0); PG8_BAR; PG8_MMA(1, 0, At, B0); PG8_MMA(1, 1, At, B1); PG8_BAR; PG8_SCHED;
            } else {
            PG8_LDB(B0, 0, 0); PG8_SCHED; PG8_LDA(At, 0, 0); PG8_STAGE(PG8_SA(1, 1), a1 + hstep, voffA);
            PG8_WAIT_L(8); PG8_BAR; PG8_WAIT_L(0); PG8_MMA(0, 0, At, B0); PG8_BAR; PG8_SCHED;
            PG8_LDB(B1, 0, 1); PG8_STAGE(PG8_SB(0, 0), b2, voffB);
            PG8_BAR; PG8_WAIT_L(0); PG8_MMA(0, 1, At, B1); PG8_BAR;
            PG8_LDA(At, 0, 1); PG8_STAGE(PG8_SA(0, 0), a2, voffA);
            PG8_BAR; PG8_WAIT_L(0); PG8_MMA(1, 0, At, B0); PG8_BAR; PG8_SCHED;
            PG8_STAGE(PG8_SB(0, 1), b2 + hstep, voffB);
            PG8_WAIT_V(6); PG8_BAR; PG8_MMA(1, 1, At, B1); PG8_BAR;
            PG8_LDB(B0, 1, 0); PG8_SCHED; PG8_LDA(At, 1, 0); PG8_STAGE(PG8_SA(0, 1), a2 + hstep, voffA);
            PG8_WAIT_L(8); PG8_BAR; PG8_WAIT_L(0); PG8_MMA(0, 0, At, B0); PG8_BAR; PG8_SCHED;
            PG8_LDB(B1, 1, 1); PG8_STAGE(PG8_SB(1, 0), b3, voffB);
            PG8_BAR; PG8_WAIT_L(0); PG8_MMA(0, 1, At, B1); PG8_BAR;
            PG8_LDA(At, 1, 1); PG8_STAGE(PG8_SA(1, 0), a3, voffA);
            PG8_BAR; PG8_WAIT_L(0); PG8_MMA(1, 0, At, B0); PG8_BAR; PG8_SCHED;
            PG8_STAGE(PG8_SB(1, 1), b3 + hstep, voffB);
            PG8_WAIT_V(6); PG8_BAR; PG8_MMA(1, 1, At, B1); PG8_BAR;
            }
        }
        if constexpr (ALIGN_EPI) { if (wr == 0) PG8_BAR; }
        if constexpr (!Epi::AFTER_DRAIN) { E(acc, cur, wr, wc, fr, fq, epre); S.done(cur); }
        if (!has_next) break;
#pragma unroll
        for (int a = 0; a < 2; ++a)
#pragma unroll
            for (int b = 0; b < 2; ++b)
#pragma unroll
                for (int m = 0; m < 4; ++m)
#pragma unroll
                    for (int n = 0; n < 2; ++n) acc[a][b][m][n] = (f32x4){0.f, 0.f, 0.f, 0.f};
        cur = nxt; cA = nA; cB = nB; ++ui;
        E.pre(cur, wr, fr, epre);
        if constexpr (ALIGN_EPI) { if (wr == 1) PG8_BAR; }
    }
    PG8_WAIT_V(0);
    if constexpr (!ALIGN_EPI) { if (wr == 0) PG8_BAR; }
    PG8_BAR;
    if constexpr (Epi::AFTER_DRAIN) { E.fused(acc, cur, wr, wc, fr, fq, lds, wid, lane); S.done(cur); }
#undef PG8_SA
#undef PG8_SB
#undef PG8_STAGE
#undef PG8_LDA
#undef PG8_LDB
#undef PG8_MMA
#undef PG8_WAIT_V
#undef PG8_WAIT_L
#undef PG8_BAR
#undef PG8_SCHED
}
}

#ifndef PG8_SP2
#define PG8_SP2 true
#endif
#ifndef PG8_ALIGN
#define PG8_ALIGN true
#endif
constexpr int D_MODEL = 2048, D_FF = 5632, D_IN = 4608;
constexpr int M_P = 16 * 2048, M_TOT = 65536;
constexpr float EPS = 1e-6f;
constexpr float LOG2E = 1.4426950408889634f;
constexpr float QSCALE = 0.125f * LOG2E;
constexpr float LAMBDA_INIT = 0.2f;
constexpr int NWAVES = 8, NTHREADS = 512;
constexpr int LDS_BYTES = 163840;

#define LAS __attribute__((address_space(3)))
typedef unsigned short bf16;
typedef short bf16x8 __attribute__((ext_vector_type(8)));
typedef float f32x16 __attribute__((ext_vector_type(16)));
typedef float f32x4 __attribute__((ext_vector_type(4)));
typedef unsigned u32x4 __attribute__((ext_vector_type(4)));
typedef unsigned u32x2 __attribute__((ext_vector_type(2)));
typedef float f32x2_t __attribute__((ext_vector_type(2)));
typedef __bf16 bf16x2_t __attribute__((ext_vector_type(2)));

constexpr size_t MiB = 1u << 20;
constexpr size_t WS_WGU1 = 0, WS_WD1 = 44 * MiB, WS_WIN = 66 * MiB, WS_WOUT = 84 * MiB, WS_WGU2 = 92 * MiB, WS_WD2 = 136 * MiB;
constexpr size_t WS_RS = 158 * MiB;
constexpr size_t WS_BAR = 159 * MiB;
constexpr size_t WS_PART = 160 * MiB;
constexpr size_t WS_XN = 168 * MiB;
constexpr size_t WS_T = 424 * MiB;
constexpr size_t WS_ACT = 680 * MiB;
constexpr size_t WS_QDA = WS_ACT, WS_KDA = WS_ACT + 128 * MiB, WS_VTDA = WS_ACT + 256 * MiB, WS_QSW = WS_ACT + 384 * MiB, WS_KSW = WS_ACT + 512 * MiB, WS_VTSW = WS_ACT + 544 * MiB;
constexpr size_t WS_H = WS_ACT + 704 * MiB;
constexpr size_t WS_END = WS_H + 256 * MiB;

__device__ __forceinline__ unsigned cvtpk(float lo, float hi) { f32x2_t v = {lo, hi}; bf16x2_t b = __builtin_convertvector(v, bf16x2_t); return __builtin_bit_cast(unsigned, b); }
__device__ __forceinline__ float hmax(float v) { auto rr = __builtin_amdgcn_permlane32_swap(__float_as_uint(v), __float_as_uint(v), false, false); return fmaxf(__uint_as_float(rr[0]), __uint_as_float(rr[1])); }
__device__ __forceinline__ float hsum(float v) { auto rr = __builtin_amdgcn_permlane32_swap(__float_as_uint(v), __float_as_uint(v), false, false); return __uint_as_float(rr[0]) + __uint_as_float(rr[1]); }
__device__ __forceinline__ float wave_sum(float v) {
#pragma unroll
    for (int o = 1; o < 64; o <<= 1) v += __shfl_xor(v, o);
    return v;
}
__device__ __forceinline__ float bf_lo(unsigned w) { return __uint_as_float(w << 16); }
__device__ __forceinline__ float bf_hi(unsigned w) { return __uint_as_float(w & 0xffff0000u); }

constexpr int A_K = 0, A_V = 32768, A_BT = 114688, A_G = 115968;

__device__ __forceinline__ int t5_bucket(int rp) {
    const int n = rp < 0 ? -rp : rp;
    int b;
    if (n < 8) b = n; else if (n < 12) b = 8; else if (n < 16) b = 9; else if (n < 23) b = 10; else if (n < 32) b = 11; else if (n < 46) b = 12; else if (n < 64) b = 13; else if (n < 91) b = 14; else b = 15;
    return b + (rp > 0 ? 16 : 0);
}

__device__ __forceinline__ float max3f(float a, float b, float c) { float r; asm("v_max3_f32 %0, %1, %2, %3" : "=v"(r) : "v"(a), "v"(b), "v"(c)); return r; }
#define SBAR() __builtin_amdgcn_sched_barrier(0)
__device__ __forceinline__ void v_reads(bf16x8 (&vf)[4], LAS unsigned char* lds, const unsigned (&vaddr)[4], unsigned off) {
#pragma unroll
    for (int c4 = 0; c4 < 4; ++c4) vf[c4] = *(const LAS bf16x8*)(lds + vaddr[c4] + off);
}
__device__ __forceinline__ void pv_mma(f32x16& o, const bf16x8 (&vf)[4], const bf16x8 (&p)[4]) {
#pragma unroll
    for (int c4 = 0; c4 < 4; ++c4) o = __builtin_amdgcn_mfma_f32_32x32x16_bf16(vf[c4], p[c4], o, 0, 0, 0);
}
template <int DV>
__device__ __forceinline__ void pv_rest(f32x16 (&o)[DV / 32], const bf16x8 (&p)[4], bf16x8 (&va)[4], bf16x8 (&vb)[4], LAS unsigned char* lds, const unsigned (&vaddr)[4], unsigned vb_) {
    if (DV == 128) {
        pv_mma(o[0], va, p); v_reads(va, lds, vaddr, vb_ + 2 * 4096); SBAR();
        pv_mma(o[1], vb, p); v_reads(vb, lds, vaddr, vb_ + 3 * 4096); SBAR();
        pv_mma(o[2], va, p); SBAR();
        pv_mma(o[DV / 32 - 1], vb, p);
    } else {
        pv_mma(o[0], va, p); SBAR();
        pv_mma(o[1], vb, p);
    }
}
__device__ __forceinline__ void glds16(const void* gsrc, unsigned lds_dst) {
    unsigned keep;
    asm volatile("s_mov_b32 %0, m0\n\ts_mov_b32 m0, %2\n\ts_nop 0\n\tglobal_load_lds_dwordx4 %1, off\n\ts_mov_b32 m0, %0" : "=&s"(keep) : "v"(gsrc), "s"(lds_dst) : "memory");
}
constexpr int NKS = 4, NVS = 5, PFD = 3;
template <int DV, bool SW>
__device__ __forceinline__ void flash(LAS unsigned char* lds, const bf16* __restrict__ Qw, int qpitch, const bf16* __restrict__ Kb, int kpitch,
                                      const bf16* __restrict__ VTb, int S, int t_lo, int t_hi, int qpos_w, bool grpB, f32x16 (&o)[DV / 32], float& mref, float& lsum) {
    const int tid = threadIdx.x, lane = tid & 63, r32 = lane & 31, hi = lane >> 5;
    const int wid = __builtin_amdgcn_readfirstlane(tid >> 6);
    const LAS float* bt = (const LAS float*)(lds + A_BT);
    const unsigned lds0 = (unsigned)(uintptr_t)lds;
    bf16x8 qf[4];
#pragma unroll
    for (int d0 = 0; d0 < 4; ++d0) qf[d0] = *(const bf16x8*)(Qw + (size_t)r32 * qpitch + d0 * 16 + hi * 8);
    const int lrow = wid * 8 + (lane >> 3), pch = lane & 7, lch = pch ^ ((lrow >> 1) & 7);
    const int rho = lrow & 31, key = (lrow & 32) + 16 * ((rho >> 2) & 1) + 4 * (rho >> 3) + (rho & 3);
    const bf16* ksrc = Kb + key * 64 + lch * 8;
    const bf16* vsrc = VTb + lrow * 64 + lch * 8;
    const unsigned kdst = lds0 + A_K + wid * 1024, vdst = lds0 + A_V + wid * 1024;
    const int sw = (r32 >> 1) & 7;
    unsigned kaddr[4], vaddr[4];
#pragma unroll
    for (int d0 = 0; d0 < 4; ++d0) kaddr[d0] = A_K + r32 * 128 + (((2 * d0 + hi) ^ sw) << 4);
#pragma unroll
    for (int c4 = 0; c4 < 4; ++c4) vaddr[c4] = A_V + r32 * 128 + (((4 * (c4 >> 1) + 2 * hi + (c4 & 1)) ^ sw) << 4);
#define FL_ISSUE(tt, ks, vs) do { const int tc_ = min((tt), t_hi - 1); \
        glds16(ksrc + (size_t)tc_ * 4096, (unsigned)__builtin_amdgcn_readfirstlane(kdst + (ks) * 8192)); \
        _Pragma("unroll") for (int i_ = 0; i_ < DV / 64; ++i_) glds16(vsrc + (size_t)tc_ * (DV * 64) + i_ * 4096, (unsigned)__builtin_amdgcn_readfirstlane(vdst + (vs) * 16384 + i_ * 8192)); } while (0)
    FL_ISSUE(t_lo, 0, 0); FL_ISSUE(t_lo + 1, 1, 1); FL_ISSUE(t_lo + 2, 2, 2);
    asm volatile("" :: "v"(qf[0]), "v"(qf[1]), "v"(qf[2]), "v"(qf[3]));
    if (DV == 128) asm volatile("s_waitcnt vmcnt(6) lgkmcnt(0)\n\ts_barrier" ::: "memory"); else asm volatile("s_waitcnt vmcnt(4) lgkmcnt(0)\n\ts_barrier" ::: "memory");
    int ks_cur = 0, ks_iss = 3;
    int vs_prev = 4, vs_cur = 0, vs_iss = 3;
    int cls_cur = 0; float cb = 0.f;
    bf16x8 p[4];
    bool have_prev = false;
    for (int t = t_lo; t <= t_hi; ++t) {
        bool issued = false;
        if (grpB && have_prev) {
            bf16x8 va[4], vb[4];
            v_reads(va, lds, vaddr, (unsigned)vs_prev * 16384); v_reads(vb, lds, vaddr, (unsigned)vs_prev * 16384 + 4096); SBAR();
            pv_rest<DV>(o, p, va, vb, lds, vaddr, (unsigned)vs_prev * 16384);
        }
        const int kt = t * 64;
        bool active = (t < t_hi);
        if (SW) active = active && (kt + 63 >= qpos_w - 128) && (kt <= qpos_w + 31 + 128);
        if (active) {
            const unsigned kb_ = (unsigned)ks_cur * 8192;
            bf16x8 kf[8];
#pragma unroll
            for (int d0 = 0; d0 < 4; ++d0) { kf[2 * d0] = *(const LAS bf16x8*)(lds + kaddr[d0] + kb_); kf[2 * d0 + 1] = *(const LAS bf16x8*)(lds + kaddr[d0] + kb_ + 4096); }
            SBAR();
            const int rpmin = kt - (qpos_w + 31), rpmax = kt + 63 - qpos_w;
            const int cls = SW ? 0 : (rpmax <= -91 ? 1 : (rpmin >= 91 ? 2 : 0));
            if (cls != cls_cur) { cls_cur = cls; cb = (cls == 0) ? 0.f : (cls == 1 ? bt[0] : bt[258]); }
            f32x16 s0, s1;
            s0 = __builtin_amdgcn_mfma_f32_32x32x16_bf16(kf[0], qf[0], f32x16{}, 0, 0, 0);
            s1 = __builtin_amdgcn_mfma_f32_32x32x16_bf16(kf[1], qf[0], f32x16{}, 0, 0, 0);
#pragma unroll
            for (int d0 = 1; d0 < 4; ++d0) {
                s0 = __builtin_amdgcn_mfma_f32_32x32x16_bf16(kf[2 * d0], qf[d0], s0, 0, 0, 0);
                s1 = __builtin_amdgcn_mfma_f32_32x32x16_bf16(kf[2 * d0 + 1], qf[d0], s1, 0, 0, 0);
            }
#ifdef PROBE_EXTRA_MFMA
            { f32x16 dm_;
#pragma unroll
              for (int d0 = 0; d0 < 4; ++d0) { asm volatile("v_mfma_f32_32x32x16_bf16 %0, %1, %2, 0" : "=v"(dm_) : "v"(kf[2 * d0]), "v"(qf[d0])); asm volatile("v_mfma_f32_32x32x16_bf16 %0, %1, %2, 0" : "=v"(dm_) : "v"(kf[2 * d0 + 1]), "v"(qf[d0])); } }
#endif
            bf16x8 va[4], vb[4];
            if (!grpB) { v_reads(va, lds, vaddr, (unsigned)vs_cur * 16384); v_reads(vb, lds, vaddr, (unsigned)vs_cur * 16384 + 4096); }
            SBAR();
            if (cls == 0) {
                const int a0 = (kt + 16 * hi - (qpos_w + r32) + 129) * 4 + A_BT;
#pragma unroll
                for (int rg = 0; rg < 4; ++rg) {
#pragma unroll
                    for (int r = 4 * rg; r < 4 * rg + 4; ++r) {
                        const int aa = min(max(a0 + 4 * r, A_BT), A_BT + 258 * 4), ab = min(max(a0 + 4 * r + 128, A_BT), A_BT + 258 * 4);
                        s0[r] += *(const LAS float*)(lds + aa);
                        s1[r] += *(const LAS float*)(lds + ab);
                    }
                    SBAR();
                }
            }
            float mx = max3f(s0[0], s1[0], s0[1]);
            mx = max3f(mx, s1[1], s0[2]);
#pragma unroll
            for (int r = 2; r < 15; ++r) mx = max3f(mx, s1[r], s0[r + 1]);
            mx = fmaxf(mx, s1[15]);
            mx = hmax(mx) + (cb - mref);
            if (__any(mx > 8.0f)) {
                const float dl = fmaxf(mx, 0.f);
                mref += dl;
                const float f = __builtin_amdgcn_exp2f(-dl);
                lsum *= f;
#pragma unroll
                for (int db = 0; db < DV / 32; ++db) o[db] *= f;
            }
            FL_ISSUE(t + PFD, ks_iss, vs_iss); issued = true;
            const float off = mref - cb;
            s0 = s0 - off; s1 = s1 - off;
#pragma unroll
            for (int r = 0; r < 16; ++r) { s0[r] = __builtin_amdgcn_exp2f(s0[r]); s1[r] = __builtin_amdgcn_exp2f(s1[r]); }
#ifdef PROBE_EXTRA_EXP
#pragma unroll
            for (int r = 0; r < 16; ++r) { float t0_, t1_; asm volatile("v_exp_f32 %0, %1" : "=v"(t0_) : "v"(s0[r])); asm volatile("v_exp_f32 %0, %1" : "=v"(t1_) : "v"(s1[r])); }
#endif
#ifdef PROBE_EXTRA_VALU
#pragma unroll
            for (int r = 0; r < 16; ++r) { float t0_, t1_, t2_, t3_; asm volatile("v_add_f32 %0, %1, %1" : "=v"(t0_) : "v"(s0[r])); asm volatile("v_add_f32 %0, %1, %1" : "=v"(t1_) : "v"(s1[r])); asm volatile("v_add_f32 %0, %1, %1" : "=v"(t2_) : "v"(s0[r])); asm volatile("v_add_f32 %0, %1, %1" : "=v"(t3_) : "v"(s1[r])); }
#endif
            {
                const f32x16 sm = s0 + s1;
                lsum += ((sm[0] + sm[1]) + (sm[2] + sm[3])) + ((sm[4] + sm[5]) + (sm[6] + sm[7])) + (((sm[8] + sm[9]) + (sm[10] + sm[11])) + ((sm[12] + sm[13]) + (sm[14] + sm[15])));
            }
            {
                u32x4 w;
                w.x = cvtpk(s0[0], s0[1]); w.y = cvtpk(s0[2], s0[3]); w.z = cvtpk(s0[4], s0[5]); w.w = cvtpk(s0[6], s0[7]); p[0] = __builtin_bit_cast(bf16x8, w);
                w.x = cvtpk(s0[8], s0[9]); w.y = cvtpk(s0[10], s0[11]); w.z = cvtpk(s0[12], s0[13]); w.w = cvtpk(s0[14], s0[15]); p[1] = __builtin_bit_cast(bf16x8, w);
                w.x = cvtpk(s1[0], s1[1]); w.y = cvtpk(s1[2], s1[3]); w.z = cvtpk(s1[4], s1[5]); w.w = cvtpk(s1[6], s1[7]); p[2] = __builtin_bit_cast(bf16x8, w);
                w.x = cvtpk(s1[8], s1[9]); w.y = cvtpk(s1[10], s1[11]); w.z = cvtpk(s1[12], s1[13]); w.w = cvtpk(s1[14], s1[15]); p[3] = __builtin_bit_cast(bf16x8, w);
            }
            if (!grpB) { SBAR(); pv_rest<DV>(o, p, va, vb, lds, vaddr, (unsigned)vs_cur * 16384); }
        }
        if (!issued) FL_ISSUE(t + PFD, ks_iss, vs_iss);
        have_prev = active;
        if (DV == 128) asm volatile("s_waitcnt vmcnt(6) lgkmcnt(0)\n\ts_barrier" ::: "memory"); else asm volatile("s_waitcnt vmcnt(4) lgkmcnt(0)\n\ts_barrier" ::: "memory");
        ks_cur = (ks_cur + 1) & 3; ks_iss = (ks_iss + 1) & 3;
        vs_prev = vs_cur; vs_cur = (vs_cur == NVS - 1) ? 0 : vs_cur + 1; vs_iss = (vs_iss == NVS - 1) ? 0 : vs_iss + 1;
    }
    asm volatile("s_waitcnt vmcnt(0)" ::: "memory");
    __syncthreads();
#undef FL_ISSUE
}

template <bool ISSUE>
__device__ __forceinline__ void da_tile(LAS unsigned char* lds, int t, int NT, int qpos_w, int r32, int hi, const bf16x8 (&qf)[4], const unsigned (&kaddr)[4], const unsigned (&vaddr)[4],
                                        const bf16* ksrc, const bf16* vsrc, unsigned kdst, unsigned vdst, int& cls_cur, float& cb, f32x16 (&o)[4], float& mref, float& lsum) {
    const LAS float* bt = (const LAS float*)(lds + A_BT);
    const unsigned kb_ = (unsigned)(t & 3) * 8192, vb_ = (unsigned)(t & 3) * 16384;
    bf16x8 kf[8];
#pragma unroll
    for (int d0 = 0; d0 < 4; ++d0) { kf[2 * d0] = *(const LAS bf16x8*)(lds + kaddr[d0] + kb_); kf[2 * d0 + 1] = *(const LAS bf16x8*)(lds + kaddr[d0] + kb_ + 4096); }
    SBAR();
    const int kt = t * 64;
    const int rpmin = kt - (qpos_w + 31), rpmax = kt + 63 - qpos_w;
    const int cls = (rpmax <= -91 ? 1 : (rpmin >= 91 ? 2 : 0));
    if (cls != cls_cur) { cls_cur = cls; cb = (cls == 0) ? 0.f : (cls == 1 ? bt[0] : bt[258]); }
    f32x16 s0, s1;
    s0 = __builtin_amdgcn_mfma_f32_32x32x16_bf16(kf[0], qf[0], f32x16{}, 0, 0, 0);
    s1 = __builtin_amdgcn_mfma_f32_32x32x16_bf16(kf[1], qf[0], f32x16{}, 0, 0, 0);
#pragma unroll
    for (int d0 = 1; d0 < 4; ++d0) {
        s0 = __builtin_amdgcn_mfma_f32_32x32x16_bf16(kf[2 * d0], qf[d0], s0, 0, 0, 0);
        s1 = __builtin_amdgcn_mfma_f32_32x32x16_bf16(kf[2 * d0 + 1], qf[d0], s1, 0, 0, 0);
    }
    bf16x8 va[4], vb[4];
    v_reads(va, lds, vaddr, vb_);
    SBAR();
    if (cls == 0) {
        int a0 = (kt + 16 * hi - (qpos_w + r32) + 129) * 4 + A_BT; asm volatile("" : "+v"(a0));
#pragma unroll
        for (int rg = 0; rg < 4; ++rg) {
#pragma unroll
            for (int r = 4 * rg; r < 4 * rg + 4; ++r) {
                const int aa = min(max(a0 + 4 * r, A_BT), A_BT + 258 * 4), ab = min(max(a0 + 4 * r + 128, A_BT), A_BT + 258 * 4);
                s0[r] += *(const LAS float*)(lds + aa);
                s1[r] += *(const LAS float*)(lds + ab);
            }
            SBAR();
        }
    }
    float mx;
    {
        float m0 = max3f(s0[0], s0[1], s0[2]), m1 = max3f(s0[8], s0[9], s0[10]), m2 = max3f(s1[0], s1[1], s1[2]), m3 = max3f(s1[8], s1[9], s1[10]);
        m0 = max3f(m0, s0[3], s0[4]); m1 = max3f(m1, s0[11], s0[12]); m2 = max3f(m2, s1[3], s1[4]); m3 = max3f(m3, s1[11], s1[12]);
        m0 = max3f(m0, s0[5], s0[6]); m1 = max3f(m1, s0[13], s0[14]); m2 = max3f(m2, s1[5], s1[6]); m3 = max3f(m3, s1[13], s1[14]);
        m0 = max3f(m0, s0[7], s0[15]); m2 = max3f(m2, s1[7], s1[15]);
        mx = max3f(max3f(m0, m1, m2), m3, m3);
    }
    mx = hmax(mx) + (cb - mref);
    if (__any(mx > 8.0f)) {
        const float dl = fmaxf(mx, 0.f);
        mref += dl;
        const float f = __builtin_amdgcn_exp2f(-dl);
        lsum *= f;
#pragma unroll
        for (int db = 0; db < 4; ++db) o[db] *= f;
    }
    if (ISSUE) {
        if (t + 2 < NT) {
            glds16(ksrc + (size_t)(t + 2) * 4096, (unsigned)__builtin_amdgcn_readfirstlane(kdst + ((t + 2) & 3) * 8192));
            glds16(vsrc + (size_t)(t + 2) * 8192, (unsigned)__builtin_amdgcn_readfirstlane(vdst + ((t + 2) & 3) * 16384));
            glds16(vsrc + (size_t)(t + 2) * 8192 + 4096, (unsigned)__builtin_amdgcn_readfirstlane(vdst + ((t + 2) & 3) * 16384 + 8192));
            glds16(ksrc + (size_t)(t + 3) * 4096, (unsigned)__builtin_amdgcn_readfirstlane(kdst + ((t + 3) & 3) * 8192));
            glds16(vsrc + (size_t)(t + 3) * 8192, (unsigned)__builtin_amdgcn_readfirstlane(vdst + ((t + 3) & 3) * 16384));
            glds16(vsrc + (size_t)(t + 3) * 8192 + 4096, (unsigned)__builtin_amdgcn_readfirstlane(vdst + ((t + 3) & 3) * 16384 + 8192));
        }
    }
    const float off = mref - cb;
    s0 = s0 - off; s1 = s1 - off;
#pragma unroll
    for (int r = 0; r < 16; ++r) { s0[r] = __builtin_amdgcn_exp2f(s0[r]); s1[r] = __builtin_amdgcn_exp2f(s1[r]); }
    {
        const f32x16 sm = s0 + s1;
        lsum += ((sm[0] + sm[1]) + (sm[2] + sm[3])) + ((sm[4] + sm[5]) + (sm[6] + sm[7])) + (((sm[8] + sm[9]) + (sm[10] + sm[11])) + ((sm[12] + sm[13]) + (sm[14] + sm[15])));
    }
    bf16x8 p[4];
    {
        u32x4 w;
        w.x = cvtpk(s0[0], s0[1]); w.y = cvtpk(s0[2], s0[3]); w.z = cvtpk(s0[4], s0[5]); w.w = cvtpk(s0[6], s0[7]); p[0] = __builtin_bit_cast(bf16x8, w);
        w.x = cvtpk(s0[8], s0[9]); w.y = cvtpk(s0[10], s0[11]); w.z = cvtpk(s0[12], s0[13]); w.w = cvtpk(s0[14], s0[15]); p[1] = __builtin_bit_cast(bf16x8, w);
        w.x = cvtpk(s1[0], s1[1]); w.y = cvtpk(s1[2], s1[3]); w.z = cvtpk(s1[4], s1[5]); w.w = cvtpk(s1[6], s1[7]); p[2] = __builtin_bit_cast(bf16x8, w);
        w.x = cvtpk(s1[8], s1[9]); w.y = cvtpk(s1[10], s1[11]); w.z = cvtpk(s1[12], s1[13]); w.w = cvtpk(s1[14], s1[15]); p[3] = __builtin_bit_cast(bf16x8, w);
    }
    v_reads(vb, lds, vaddr, vb_ + 4096);
    SBAR();
    pv_rest<128>(o, p, va, vb, lds, vaddr, vb_);
}
__device__ __forceinline__ void flash_da2(LAS unsigned char* lds, const bf16* __restrict__ Qw, const bf16* __restrict__ Kb, const bf16* __restrict__ VTb,
                                          int NT, int qpos_w, f32x16 (&o)[4], float& mref, float& lsum) {
    const int tid = threadIdx.x, lane = tid & 63, r32 = lane & 31, hi = lane >> 5;
    const int wid = __builtin_amdgcn_readfirstlane(tid >> 6);
    const unsigned lds0 = (unsigned)(uintptr_t)lds;
    bf16x8 qf[4];
#pragma unroll
    for (int d0 = 0; d0 < 4; ++d0) qf[d0] = *(const bf16x8*)(Qw + (size_t)r32 * 64 + d0 * 16 + hi * 8);
    const int lrow = wid * 8 + (lane >> 3), pch = lane & 7, lch = pch ^ ((lrow >> 1) & 7);
    const int rho = lrow & 31, key = (lrow & 32) + 16 * ((rho >> 2) & 1) + 4 * (rho >> 3) + (rho & 3);
    const bf16* ksrc = Kb + key * 64 + lch * 8;
    const bf16* vsrc = VTb + lrow * 64 + lch * 8;
    const unsigned kdst = lds0 + A_K + wid * 1024, vdst = lds0 + A_V + wid * 1024;
    const int sw = (r32 >> 1) & 7;
    unsigned kaddr[4], vaddr[4];
#pragma unroll
    for (int d0 = 0; d0 < 4; ++d0) kaddr[d0] = A_K + r32 * 128 + (((2 * d0 + hi) ^ sw) << 4);
#pragma unroll
    for (int c4 = 0; c4 < 4; ++c4) vaddr[c4] = A_V + r32 * 128 + (((4 * (c4 >> 1) + 2 * hi + (c4 & 1)) ^ sw) << 4);
#pragma unroll
    for (int j = 0; j < 2; ++j) {
        glds16(ksrc + (size_t)j * 4096, (unsigned)__builtin_amdgcn_readfirstlane(kdst + j * 8192));
        glds16(vsrc + (size_t)j * 8192, (unsigned)__builtin_amdgcn_readfirstlane(vdst + j * 16384));
        glds16(vsrc + (size_t)j * 8192 + 4096, (unsigned)__builtin_amdgcn_readfirstlane(vdst + j * 16384 + 8192));
    }
    asm volatile("" :: "v"(qf[0]), "v"(qf[1]), "v"(qf[2]), "v"(qf[3]));
    asm volatile("s_waitcnt vmcnt(0) lgkmcnt(0)\n\ts_barrier" ::: "memory");
    int cls_cur = 0; float cb = 0.f;
#pragma unroll 1
    for (int t = 0; t < NT; t += 2) {
        da_tile<true>(lds, t, NT, qpos_w, r32, hi, qf, kaddr, vaddr, ksrc, vsrc, kdst, vdst, cls_cur, cb, o, mref, lsum);
        da_tile<false>(lds, t + 1, NT, qpos_w, r32, hi, qf, kaddr, vaddr, ksrc, vsrc, kdst, vdst, cls_cur, cb, o, mref, lsum);
        asm volatile("s_waitcnt vmcnt(0) lgkmcnt(0)\n\ts_barrier" ::: "memory");
    }
}

struct AttnP {
    const bf16 *Qda, *Kda, *VTda, *Qsw, *Ksw, *VTsw; bf16* O;
    const float *rel_bias, *subln_g, *sink; float* stash;
};

__device__ __forceinline__ void bias_table(LAS unsigned char* lds, const float* rel_bias, int head, bool mask) {
    LAS float* bt = (LAS float*)(lds + A_BT);
    for (int i = threadIdx.x; i < 259; i += NTHREADS) {
        const int rp = i - 129;
        bt[i] = (mask && (rp < -128 || rp > 128)) ? -INFINITY : rel_bias[t5_bucket(rp) * 24 + head] * LOG2E;
    }
}

__device__ __forceinline__ void da_unit(LAS unsigned char* lds, const AttnP& P, int seqbase, int S, int h, int qb, float lam) {
    const int tid = threadIdx.x, lane = tid & 63, r32 = lane & 31, hi = lane >> 5, wid = __builtin_amdgcn_readfirstlane(tid >> 6);
    bias_table(lds, P.rel_bias, h, false);
    const int qpos_w = qb * 256 + wid * 32;
    const size_t row_w = (size_t)seqbase + qpos_w;
    const bf16* Kb = P.Kda + (size_t)seqbase * 1024 + (size_t)(h * 2) * 64 * S;
    const bf16* Qb = P.Qda + (size_t)seqbase * 1024 + (size_t)(h * 2) * 64 * S + (size_t)qpos_w * 64;
    const bf16* VTb = P.VTda + (size_t)seqbase * 1024 + (size_t)(h * 128) * S;
    f32x16 o[4];
    float ss = 0.f;
#pragma unroll 1
    for (int map = 0; map < 2; ++map) {
#pragma unroll
        for (int db = 0; db < 4; ++db) o[db] = f32x16{};
        float mref = 0.f, l = 0.f;
        flash_da2(lds, Qb + (size_t)map * 64 * S, Kb + (size_t)map * 64 * S, VTb, S / 64, qpos_w, o, mref, l);
        int tid3 = threadIdx.x; asm volatile("" : "+v"(tid3));
        f32x4* stash = (f32x4*)(P.stash + (size_t)blockIdx.x * 32768 + tid3 * 64);
        if (map == 0) {
            const float inv = 1.0f / hsum(l);
#pragma unroll
            for (int db = 0; db < 4; ++db)
#pragma unroll
                for (int g = 0; g < 4; ++g) stash[db * 4 + g] = (f32x4){o[db][4 * g], o[db][4 * g + 1], o[db][4 * g + 2], o[db][4 * g + 3]} * inv;
        } else {
            const float inv = lam / hsum(l);
#pragma unroll
            for (int db = 0; db < 4; ++db)
#pragma unroll
                for (int g = 0; g < 4; ++g) {
                    const f32x4 st = stash[db * 4 + g];
#pragma unroll
                    for (int e = 0; e < 4; ++e) { const float a = st[e] - o[db][4 * g + e] * inv; o[db][4 * g + e] = a; ss += a * a; }
                }
        }
    }
    ss = hsum(ss);
    const float rstd = __builtin_amdgcn_rsqf(ss * (1.0f / 128.0f) + EPS) * (1.0f - LAMBDA_INIT);
    int tid2 = threadIdx.x; asm volatile("" : "+v"(tid2));
    const int r32e = tid2 & 31, hie = (tid2 >> 5) & 1;
    bf16* orow = P.O + (row_w + r32e) * 2048 + h * 128 + 4 * hie;
    const LAS unsigned char* gb = lds + A_G + hie * 16;
#pragma unroll
    for (int db = 0; db < 4; ++db)
#pragma unroll
        for (int g4 = 0; g4 < 4; ++g4) {
            const int d0 = 32 * db + 8 * g4;
            const f32x4 gv = *(const LAS f32x4*)(gb + d0 * 4);
            u32x2 w;
            w.x = cvtpk(o[db][4 * g4] * rstd * gv[0], o[db][4 * g4 + 1] * rstd * gv[1]);
            w.y = cvtpk(o[db][4 * g4 + 2] * rstd * gv[2], o[db][4 * g4 + 3] * rstd * gv[3]);
            *(u32x2*)(orow + d0) = w;
        }
}

__device__ __forceinline__ void sw_unit(LAS unsigned char* lds, const AttnP& P, int blk, int qh) {
    const int tid = threadIdx.x, lane = tid & 63, r32 = lane & 31, hi = lane >> 5, wid = __builtin_amdgcn_readfirstlane(tid >> 6);
    const int row0 = blk * 256;
    int S, seqbase;
    if (row0 < M_P) { S = 2048; seqbase = row0 & ~2047; } else { S = 4096; seqbase = M_P + ((row0 - M_P) & ~4095); }
    const int q0 = row0 - seqbase;
    bias_table(lds, P.rel_bias, 8 + qh, true);
    const int kvh = qh >> 2;
    const int t_lo = max(0, q0 - 128) >> 6, t_hi = min(S, q0 + 384) >> 6;
    const int qpos_w = q0 + wid * 32;
    const size_t row_w = (size_t)row0 + wid * 32;
    f32x16 o[2];
    o[0] = f32x16{}; o[1] = f32x16{};
    float mref = 0.f, l = 0.f;
    flash<64, true>(lds, P.Qsw + (size_t)seqbase * 1024 + (size_t)qh * 64 * S + (size_t)qpos_w * 64, 64, P.Ksw + (size_t)seqbase * 256 + (size_t)kvh * 64 * S, 64, P.VTsw + (size_t)seqbase * 256 + (size_t)(kvh * 64) * S, S, t_lo, t_hi, qpos_w, wid >= 4, o, mref, l);
    const float lt = hsum(l) + __builtin_amdgcn_exp2f(P.sink[qh] * LOG2E - mref);
    const float inv = 1.0f / lt;
    bf16* orow = P.O + (row_w + r32) * 2048 + 1024 + qh * 64;
#pragma unroll
    for (int db = 0; db < 2; ++db)
#pragma unroll
        for (int g4 = 0; g4 < 4; ++g4) {
            const int d0 = 32 * db + 8 * g4 + 4 * hi;
            u32x2 w;
            w.x = cvtpk(o[db][4 * g4] * inv, o[db][4 * g4 + 1] * inv);
            w.y = cvtpk(o[db][4 * g4 + 2] * inv, o[db][4 * g4 + 3] * inv);
            *(u32x2*)(orow + d0) = w;
        }
}

constexpr int A_K8 = 0, A_V8 = 65536, A_BT4 = 131072;
__device__ __forceinline__ void sw_unit4(LAS unsigned char* lds, const AttnP& P, int blk, int kvh) {
    const int tid = threadIdx.x, lane = tid & 63, r32 = lane & 31, hi = lane >> 5, wid = __builtin_amdgcn_readfirstlane(tid >> 6);
    const unsigned lds0 = (unsigned)(uintptr_t)lds;
    const int row0 = blk * 256;
    int S, seqbase;
    if (row0 < M_P) { S = 2048; seqbase = row0 & ~2047; } else { S = 4096; seqbase = M_P + ((row0 - M_P) & ~4095); }
    const int q0 = row0 - seqbase;
    const int t_lo = max(0, q0 - 128) >> 6, t_hi = min(S, q0 + 384) >> 6;
    for (int i = tid; i < 4 * 452; i += NTHREADS) {
        const int g = i / 452, e = i - g * 452, rp = e - 224;
        ((LAS float*)(lds + A_BT4))[i] = (rp < -128 || rp > 128) ? -INFINITY : P.rel_bias[t5_bucket(rp) * 24 + 8 + kvh * 4 + g] * LOG2E;
    }
    {
        const int lrow = wid * 8 + (lane >> 3), pch = lane & 7, lch = pch ^ ((lrow >> 1) & 7);
        const int rho = lrow & 31, key = (lrow & 32) + 16 * ((rho >> 2) & 1) + 4 * (rho >> 3) + (rho & 3);
        const bf16* ksrc = P.Ksw + (size_t)seqbase * 256 + (size_t)kvh * 64 * S + key * 64 + lch * 8;
        const bf16* vsrc = P.VTsw + (size_t)seqbase * 256 + (size_t)(kvh * 64) * S + lrow * 64 + lch * 8;
        for (int t = t_lo; t < t_hi; ++t) {
            glds16(ksrc + (size_t)t * 4096, (unsigned)__builtin_amdgcn_readfirstlane(lds0 + A_K8 + (t - t_lo) * 8192 + wid * 1024));
            glds16(vsrc + (size_t)t * 4096, (unsigned)__builtin_amdgcn_readfirstlane(lds0 + A_V8 + (t - t_lo) * 8192 + wid * 1024));
        }
    }
    const int sw = (r32 >> 1) & 7;
    unsigned kaddr[4], vaddr[4];
#pragma unroll
    for (int d0 = 0; d0 < 4; ++d0) kaddr[d0] = A_K8 + r32 * 128 + (((2 * d0 + hi) ^ sw) << 4);
#pragma unroll
    for (int c4 = 0; c4 < 4; ++c4) vaddr[c4] = A_V8 + r32 * 128 + (((4 * (c4 >> 1) + 2 * hi + (c4 & 1)) ^ sw) << 4);
    const int qpos_w = q0 + wid * 32;
    const size_t row_w = (size_t)row0 + wid * 32;
    asm volatile("s_waitcnt vmcnt(0) lgkmcnt(0)\n\ts_barrier" ::: "memory");
    const bf16* Qg = P.Qsw + (size_t)seqbase * 1024 + (size_t)(kvh * 4) * 64 * S + (size_t)qpos_w * 64 + (size_t)r32 * 64 + hi * 8;
    bf16x8 qn[4];
#pragma unroll
    for (int d0 = 0; d0 < 4; ++d0) qn[d0] = *(const bf16x8*)(Qg + d0 * 16);
#pragma unroll 1
    for (int g = 0; g < 4; ++g) {
        const int qh = kvh * 4 + g;
        bf16x8 qf[4];
#pragma unroll
        for (int d0 = 0; d0 < 4; ++d0) qf[d0] = qn[d0];
        if (g < 3) {
#pragma unroll
            for (int d0 = 0; d0 < 4; ++d0) qn[d0] = *(const bf16x8*)(Qg + (size_t)(g + 1) * 64 * S + d0 * 16);
        }
        const int btg = A_BT4 + g * 1808;
        f32x16 o[2]; o[0] = f32x16{}; o[1] = f32x16{};
        float mref = 0.f, lsum = 0.f;
#pragma unroll 1
        for (int t = t_lo; t < t_hi; ++t) {
            const int kt = t * 64;
            if (!((kt + 63 >= qpos_w - 128) && (kt <= qpos_w + 31 + 128))) continue;
            const unsigned sl = (unsigned)(t - t_lo) * 8192;
            bf16x8 kf[8];
#pragma unroll
            for (int d0 = 0; d0 < 4; ++d0) { kf[2 * d0] = *(const LAS bf16x8*)(lds + kaddr[d0] + sl); kf[2 * d0 + 1] = *(const LAS bf16x8*)(lds + kaddr[d0] + sl + 4096); }
            f32x16 s0, s1;
            s0 = __builtin_amdgcn_mfma_f32_32x32x16_bf16(kf[0], qf[0], f32x16{}, 0, 0, 0);
            s1 = __builtin_amdgcn_mfma_f32_32x32x16_bf16(kf[1], qf[0], f32x16{}, 0, 0, 0);
#pragma unroll
            for (int d0 = 1; d0 < 4; ++d0) {
                s0 = __builtin_amdgcn_mfma_f32_32x32x16_bf16(kf[2 * d0], qf[d0], s0, 0, 0, 0);
                s1 = __builtin_amdgcn_mfma_f32_32x32x16_bf16(kf[2 * d0 + 1], qf[d0], s1, 0, 0, 0);
            }
            bf16x8 va[4], vb[4];
            v_reads(va, lds, vaddr, sl); v_reads(vb, lds, vaddr, sl + 4096);
            SBAR();
            {
                const LAS float* tb = (const LAS float*)(lds + btg) + (kt + 16 * hi - (qpos_w + r32) + 224);
#pragma unroll
                for (int rg = 0; rg < 4; ++rg) {
#pragma unroll
                    for (int r = 4 * rg; r < 4 * rg + 4; ++r) { s0[r] += tb[r]; s1[r] += tb[r + 32]; }
                    SBAR();
                }
            }
            float mx;
            {
                float m0 = max3f(s0[0], s0[1], s0[2]), m1 = max3f(s0[8], s0[9], s0[10]), m2 = max3f(s1[0], s1[1], s1[2]), m3 = max3f(s1[8], s1[9], s1[10]);
                m0 = max3f(m0, s0[3], s0[4]); m1 = max3f(m1, s0[11], s0[12]); m2 = max3f(m2, s1[3], s1[4]); m3 = max3f(m3, s1[11], s1[12]);
                m0 = max3f(m0, s0[5], s0[6]); m1 = max3f(m1, s0[13], s0[14]); m2 = max3f(m2, s1[5], s1[6]); m3 = max3f(m3, s1[13], s1[14]);
                m0 = max3f(m0, s0[7], s0[15]); m2 = max3f(m2, s1[7], s1[15]);
                mx = max3f(max3f(m0, m1, m2), m3, m3);
            }
            mx = hmax(mx) - mref;
            if (__any(mx > 8.0f)) {
                const float dl = fmaxf(mx, 0.f);
                mref += dl;
                const float f = __builtin_amdgcn_exp2f(-dl);
                lsum *= f; o[0] *= f; o[1] *= f;
            }
            s0 = s0 - mref; s1 = s1 - mref;
#pragma unroll
            for (int r = 0; r < 16; ++r) { s0[r] = __builtin_amdgcn_exp2f(s0[r]); s1[r] = __builtin_amdgcn_exp2f(s1[r]); }
            {
                const f32x16 sm = s0 + s1;
                lsum += ((sm[0] + sm[1]) + (sm[2] + sm[3])) + ((sm[4] + sm[5]) + (sm[6] + sm[7])) + (((sm[8] + sm[9]) + (sm[10] + sm[11])) + ((sm[12] + sm[13]) + (sm[14] + sm[15])));
            }
            bf16x8 p[4];
            {
                u32x4 w;
                w.x = cvtpk(s0[0], s0[1]); w.y = cvtpk(s0[2], s0[3]); w.z = cvtpk(s0[4], s0[5]); w.w = cvtpk(s0[6], s0[7]); p[0] = __builtin_bit_cast(bf16x8, w);
                w.x = cvtpk(s0[8], s0[9]); w.y = cvtpk(s0[10], s0[11]); w.z = cvtpk(s0[12], s0[13]); w.w = cvtpk(s0[14], s0[15]); p[1] = __builtin_bit_cast(bf16x8, w);
                w.x = cvtpk(s1[0], s1[1]); w.y = cvtpk(s1[2], s1[3]); w.z = cvtpk(s1[4], s1[5]); w.w = cvtpk(s1[6], s1[7]); p[2] = __builtin_bit_cast(bf16x8, w);
                w.x = cvtpk(s1[8], s1[9]); w.y = cvtpk(s1[10], s1[11]); w.z = cvtpk(s1[12], s1[13]); w.w = cvtpk(s1[14], s1[15]); p[3] = __builtin_bit_cast(bf16x8, w);
            }
            SBAR();
            pv_mma(o[0], va, p); pv_mma(o[1], vb, p);
        }
        const float lt = hsum(lsum) + __builtin_amdgcn_exp2f(P.sink[qh] * LOG2E - mref);
        const float inv = 1.0f / lt;
        bf16* orow = P.O + (row_w + r32) * 2048 + 1024 + qh * 64 + 4 * hi;
#pragma unroll
        for (int db = 0; db < 2; ++db)
#pragma unroll
            for (int g4 = 0; g4 < 4; ++g4) {
                u32x2 w;
                w.x = cvtpk(o[db][4 * g4] * inv, o[db][4 * g4 + 1] * inv);
                w.y = cvtpk(o[db][4 * g4 + 2] * inv, o[db][4 * g4 + 3] * inv);
                *(u32x2*)(orow + 32 * db + 8 * g4) = w;
            }
    }
    asm volatile("s_waitcnt vmcnt(0) lgkmcnt(0)\n\ts_barrier" ::: "memory");
}

__device__ __forceinline__ void attn_phase(LAS unsigned char* lds, const AttnP& P, int vcu, int G, const float* lq1, const float* lk1, const float* lq2, const float* lk2) {
    const int lane = threadIdx.x & 63;
    const float s1 = wave_sum(lq1[lane] * lk1[lane]), s2 = wave_sum(lq2[lane] * lk2[lane]);
    const float lam = __expf(s1) - __expf(s2) + LAMBDA_INIT;
    if (threadIdx.x < 128) ((LAS float*)(lds + A_G))[threadIdx.x] = P.subln_g[threadIdx.x];
#ifndef REP_DA
#define REP_DA 1
#endif
#ifndef REP_SW
#define REP_SW 1
#endif
#ifndef NO_DA
    const int nda = (G == 256) ? 8 : (2048 - vcu + G - 1) / G;
#pragma unroll 1
    for (int j0 = 0; j0 < nda * REP_DA; ++j0) {
        const int j = j0 % nda;
        int grp, qb, seqbase, S;
        if (G == 256) {
            const int x = vcu >> 5, i = vcu & 31;
            if (j < 4) { grp = x * 16 + j * 4 + (i >> 3); qb = i & 7; seqbase = (grp >> 3) * 2048; S = 2048; }
            else { grp = x * 8 + (j - 4) * 2 + (i >> 4); qb = i & 15; seqbase = M_P + (grp >> 3) * 4096; S = 4096; }
        } else {
            const int u = vcu + j * G;
            if (u < 1024) { grp = u >> 3; qb = u & 7; seqbase = (grp >> 3) * 2048; S = 2048; }
            else { const int u2 = u - 1024; grp = u2 >> 4; qb = u2 & 15; seqbase = M_P + (grp >> 3) * 4096; S = 4096; }
        }
        da_unit(lds, P, seqbase, S, grp & 7, qb, lam);
    }
#endif
#ifndef NO_SW
    __syncthreads();
#pragma unroll 1
    for (int u = vcu; u < 256; u += G)
#pragma unroll 1
        for (int kv0 = 0; kv0 < 4 * REP_SW; ++kv0) sw_unit4(lds, P, u, kv0 & 3);
#endif
}

__device__ __forceinline__ unsigned f2bf(float f) { unsigned u = __builtin_bit_cast(unsigned, f); return (u + 0x7fffu + ((u >> 16) & 1u)) >> 16; }
__device__ __forceinline__ unsigned pk2(float lo, float hi) { return f2bf(lo) | (f2bf(hi) << 16); }
template <bool GU>
__device__ __forceinline__ void transpose_item(const float* __restrict__ W, int K, int N, bf16* __restrict__ WT, LAS float* scr, int item, int lane, const float* __restrict__ gk) {
    const int nblk = N / 32, kb = item / nblk, nb = item % nblk, k0 = 64 * kb, n0 = 32 * nb;
    int r0 = n0;
    if (GU) { r0 = (n0 < D_FF) ? (n0 >> 7) * 256 + (n0 & 127) : ((n0 - D_FF) >> 7) * 256 + 128 + ((n0 - D_FF) & 127); }
    f32x4 wv[8];
#pragma unroll
    for (int i = 0; i < 8; ++i) wv[i] = *(const f32x4*)(W + (size_t)(k0 + 8 * i + (lane >> 3)) * N + n0 + 4 * (lane & 7));
#pragma unroll
    for (int i = 0; i < 8; ++i) {
        const int kk = 8 * i + (lane >> 3);
        const float gkk = gk ? gk[k0 + kk] : 1.0f;
        LAS float* d = scr + kk * 33 + 4 * (lane & 7);
        d[0] = wv[i][0] * gkk; d[1] = wv[i][1] * gkk; d[2] = wv[i][2] * gkk; d[3] = wv[i][3] * gkk;
    }
    asm volatile("s_waitcnt lgkmcnt(0)" ::: "memory");
    const int c = lane & 7;
#pragma unroll
    for (int j = 0; j < 4; ++j) { const int n = (lane >> 3) + 8 * j; const LAS float* s = scr + (8 * c) * 33 + n;
        u32x4 o; o.x = pk2(s[0 * 33], s[1 * 33]); o.y = pk2(s[2 * 33], s[3 * 33]); o.z = pk2(s[4 * 33], s[5 * 33]); o.w = pk2(s[6 * 33], s[7 * 33]);
        *(u32x4*)(WT + (size_t)(r0 + n) * K + k0 + 8 * c) = o; }
    asm volatile("s_waitcnt lgkmcnt(0)" ::: "memory");
}

template <bool HAS_T, bool NEXT, bool BASE_BF, bool OUT_BF>
__device__ __forceinline__ void rowpass(int gw, int ngw, int lane, const float* base0, const float* base1, const bf16* hin, const bf16* T, const float* part, const float* gpost, float alpha,
                                        float* out, bf16* hout, float* rs, bf16* xn, bool rev) {
    f32x4 gp[4][2];
#pragma unroll
    for (int j = 0; j < 4; ++j)
#pragma unroll
        for (int e = 0; e < 2; ++e) {
            if (HAS_T) gp[j][e] = *(const f32x4*)(gpost + j * 512 + lane * 8 + e * 4) * alpha;
        }
    for (int row_ = gw; row_ < M_TOT; row_ += ngw) {
        const int row = rev ? (M_TOT - 1 - row_) : row_;
        f32x4 v[4][2];
        if (BASE_BF) {
            u32x4 hw[4];
#pragma unroll
            for (int j = 0; j < 4; ++j) hw[j] = *(const u32x4*)(hin + (size_t)row * D_MODEL + j * 512 + lane * 8);
#pragma unroll
            for (int j = 0; j < 4; ++j) { v[j][0] = (f32x4){bf_lo(hw[j].x), bf_hi(hw[j].x), bf_lo(hw[j].y), bf_hi(hw[j].y)}; v[j][1] = (f32x4){bf_lo(hw[j].z), bf_hi(hw[j].z), bf_lo(hw[j].w), bf_hi(hw[j].w)}; }
        } else {
            const float* brow = (row < M_P ? base0 : base1) + (size_t)row * D_MODEL;
#pragma unroll
            for (int j = 0; j < 4; ++j) { v[j][0] = *(const f32x4*)(brow + j * 512 + lane * 8); v[j][1] = *(const f32x4*)(brow + j * 512 + lane * 8 + 4); }
        }
        if (HAS_T) {
            u32x4 tw[4];
#pragma unroll
            for (int j = 0; j < 4; ++j) tw[j] = *(const u32x4*)(T + (size_t)row * D_MODEL + j * 512 + lane * 8);
            float ps = (lane < 32) ? part[(size_t)row * 32 + lane] : 0.f;
            ps = wave_sum(ps);
            const float rstd = __builtin_amdgcn_rsqf(ps * (1.0f / D_MODEL) + EPS);
#pragma unroll
            for (int j = 0; j < 4; ++j) {
                const f32x4 t0 = {bf_lo(tw[j].x), bf_hi(tw[j].x), bf_lo(tw[j].y), bf_hi(tw[j].y)}, t1 = {bf_lo(tw[j].z), bf_hi(tw[j].z), bf_lo(tw[j].w), bf_hi(tw[j].w)};
                v[j][0] += t0 * rstd * gp[j][0]; v[j][1] += t1 * rstd * gp[j][1];
            }
            if (OUT_BF) {
                bf16* hr = hout + (size_t)row * D_MODEL;
#pragma unroll
                for (int j = 0; j < 4; ++j) {
                    u32x4 w; w.x = cvtpk(v[j][0][0], v[j][0][1]); w.y = cvtpk(v[j][0][2], v[j][0][3]); w.z = cvtpk(v[j][1][0], v[j][1][1]); w.w = cvtpk(v[j][1][2], v[j][1][3]);
                    *(u32x4*)(hr + j * 512 + lane * 8) = w;
                }
            } else {
                float* orow = out + (size_t)row * D_MODEL;
#pragma unroll
                for (int j = 0; j < 4; ++j) { *(f32x4*)(orow + j * 512 + lane * 8) = v[j][0]; *(f32x4*)(orow + j * 512 + lane * 8 + 4) = v[j][1]; }
            }
        }
        if (NEXT) {
            float ss = 0.f;
#pragma unroll
            for (int j = 0; j < 4; ++j)
#pragma unroll
                for (int e = 0; e < 2; ++e) ss += (v[j][e][0] * v[j][e][0] + v[j][e][1] * v[j][e][1]) + (v[j][e][2] * v[j][e][2] + v[j][e][3] * v[j][e][3]);
            ss = wave_sum(ss);
            if (lane == 0) rs[row] = __builtin_amdgcn_rsqf(ss * (1.0f / D_MODEL) + EPS);
            if (!HAS_T) {
                bf16* xr = xn + (size_t)row * D_MODEL;
#pragma unroll
                for (int j = 0; j < 4; ++j) {
                    u32x4 w; w.x = cvtpk(v[j][0][0], v[j][0][1]); w.y = cvtpk(v[j][0][2], v[j][0][3]); w.z = cvtpk(v[j][1][0], v[j][1][1]); w.w = cvtpk(v[j][1][2], v[j][1][3]);
                    *(u32x4*)(xr + j * 512 + lane * 8) = w;
                }
            }
        }
    }
}

#ifndef REP_P0
#define REP_P0 1
#endif
#ifndef REP_P1
#define REP_P1 1
#endif
#ifndef REP_P2
#define REP_P2 1
#endif
#ifndef REP_P3
#define REP_P3 1
#endif
#ifndef REP_P4
#define REP_P4 1
#endif
#ifndef REP_P5
#define REP_P5 1
#endif
#ifndef REP_P6
#define REP_P6 1
#endif
#ifndef REP_P7
#define REP_P7 1
#endif
#ifndef REP_P8
#define REP_P8 1
#endif
#ifndef REP_P9
#define REP_P9 1
#endif
#ifndef REP_P10
#define REP_P10 1
#endif
#define XB_TMO      128
#define XB_XCNT(j)  (256  + 64 * (j))
#define XB_XSUB(j)  (1280 + 64 * (j))
#define XB_XGEN(j)  (2304 + 64 * (j))
#define XB_TOP      3328
#define XB_TOPGEN   3392
#define XCD_BAR_WORDS 3456
#define XB_SPIN_CAP (1u << 18)

__device__ __forceinline__ unsigned xb_ld(unsigned* p)              { return __hip_atomic_load(p, __ATOMIC_RELAXED, __HIP_MEMORY_SCOPE_AGENT); }
__device__ __forceinline__ unsigned xb_add(unsigned* p, unsigned v) { return __hip_atomic_fetch_add(p, v, __ATOMIC_RELAXED, __HIP_MEMORY_SCOPE_AGENT); }
__device__ __forceinline__ unsigned xb_xcc_id() { return (unsigned)__builtin_amdgcn_s_getreg((3 << 11) | 20) & 0xFu; }
#define XB_SPIN(cond, bar) do { unsigned _sp = 0; while (cond) { __builtin_amdgcn_s_sleep(1); \
    if ((++_sp & 255u) == 0u) { if (xb_ld(&(bar)[XB_TMO])) break; if (_sp > XB_SPIN_CAP) { atomicAdd(&(bar)[XB_TMO], 1u); break; } } } } while (0)

struct XcdBarrier {
    unsigned* bar; unsigned x;
    unsigned nloc, nx;
};

__device__ __forceinline__ XcdBarrier xcd_barrier_post(unsigned* bar) {
    XcdBarrier b; b.bar = bar; b.x = xb_xcc_id(); b.nloc = 0u; b.nx = 0u;
    if (threadIdx.x == 0) (void)xb_add(&bar[XB_XCNT(b.x)], 1u);
    return b;
}
__device__ __forceinline__ void xcd_barrier_complete(unsigned* bar, unsigned x, unsigned& nloc, unsigned& nx) {
    const unsigned G = gridDim.x * gridDim.y * gridDim.z;
    unsigned sum, cnt, mine, sp = 0u;
    for (;;) {
        sum = 0u; cnt = 0u; mine = 0u;
#pragma unroll
        for (unsigned j = 0; j < 16; ++j) { const unsigned c = xb_ld(&bar[XB_XCNT(j)]); sum += c; cnt += (c > 0u) ? 1u : 0u; mine = (j == x) ? c : mine; }
        if (sum == G) break;
        __builtin_amdgcn_s_sleep(1);
        if ((++sp & 255u) == 0u) { if (xb_ld(&bar[XB_TMO])) break; if (sp > XB_SPIN_CAP) { atomicAdd(&bar[XB_TMO], 1u); break; } }
    }
    nloc = mine > 0u ? mine : 1u; nx = cnt > 0u ? cnt : 1u;
}

__device__ __forceinline__ void xcd_barrier(XcdBarrier& b) {
    asm volatile("s_waitcnt vmcnt(0)" ::: "memory");
    __syncthreads();
    if (threadIdx.x == 0) {
        unsigned* bar = b.bar;
        __builtin_amdgcn_s_waitcnt(0);
        unsigned nloc = b.nloc, nx = b.nx;
        if (nloc == 0u) { xcd_barrier_complete(bar, b.x, nloc, nx); b.nloc = nloc; b.nx = nx; }
        const unsigned old = xb_add(&bar[XB_XSUB(b.x)], 1u);
        const unsigned gen = old / nloc;
        if (old + 1u == (gen + 1u) * nloc) {
            __builtin_amdgcn_fence(__ATOMIC_RELEASE, "agent");
            asm volatile("s_waitcnt vmcnt(0)" ::: "memory");
            const unsigned og = xb_add(&bar[XB_TOP], 1u);
            const unsigned tg = og / nx;
            if (og + 1u == (tg + 1u) * nx) xb_add(&bar[XB_TOPGEN], 1u);
            else XB_SPIN(xb_ld(&bar[XB_TOPGEN]) == tg, bar);
            __builtin_amdgcn_fence(__ATOMIC_ACQUIRE, "agent");
            xb_add(&bar[XB_XGEN(b.x)], 1u);
            asm volatile("s_waitcnt vmcnt(0)" ::: "memory");
        } else {
            XB_SPIN(xb_ld(&bar[XB_XGEN(b.x)]) == gen, bar);
            __builtin_amdgcn_fence(__ATOMIC_ACQUIRE, "agent");
            asm volatile("s_waitcnt vmcnt(0)" ::: "memory");
        }
    }
    __syncthreads();
}

constexpr int N_PHASES = 11;
struct Args { const float* in[21]; float* out; unsigned char* ws; int ph_lo, ph_hi; };
static_assert(sizeof(Args) == 21 * 8 + 8 + 8 + 8, "Args has no padding");

__global__ void __launch_bounds__(NTHREADS, 2) mega_fwd(Args args) {
    extern __shared__ __attribute__((aligned(16))) unsigned char lds_raw[];
    LAS unsigned char* lds = (LAS unsigned char*)lds_raw;
    cg::grid_group grid = cg::this_grid();
    const int tid = threadIdx.x, lane = tid & 63, wave = __builtin_amdgcn_readfirstlane(tid >> 6);
    const int G = gridDim.x, bx = blockIdx.x;
    const int vcu = (G % 8 == 0) ? (bx % 8) * (G / 8) + bx / 8 : bx;
    const int gw = vcu * NWAVES + wave, ngw = G * NWAVES;
    unsigned char* ws = args.ws;
    const float* x_prompt = args.in[0]; const float* x_sample = args.in[1]; const float* rel_bias = args.in[2];
    const float* g_ffn1_pre = args.in[3]; const float* w_ffn1_gu = args.in[4]; const float* w_ffn1_down = args.in[5]; const float* g_ffn1_post = args.in[6];
    const float* g_mix_pre = args.in[7]; const float* w_in = args.in[8];
    const float* lq1 = args.in[9]; const float* lk1 = args.in[10]; const float* lq2 = args.in[11]; const float* lk2 = args.in[12];
    const float* g_subln = args.in[13]; const float* sink = args.in[14]; const float* w_out = args.in[15]; const float* g_mix_post = args.in[16];
    const float* g_ffn2_pre = args.in[17]; const float* w_ffn2_gu = args.in[18]; const float* w_ffn2_down = args.in[19]; const float* g_ffn2_post = args.in[20];
    float* out = args.out;
    bf16* Wgu1 = (bf16*)(ws + WS_WGU1); bf16* Wd1 = (bf16*)(ws + WS_WD1); bf16* Win = (bf16*)(ws + WS_WIN); bf16* Wout = (bf16*)(ws + WS_WOUT);
    bf16* Wgu2 = (bf16*)(ws + WS_WGU2); bf16* Wd2 = (bf16*)(ws + WS_WD2);
    float* PART = (float*)(ws + WS_PART); float* RS = (float*)(ws + WS_RS); bf16* XN = (bf16*)(ws + WS_XN); bf16* T = (bf16*)(ws + WS_T); bf16* ACT = (bf16*)(ws + WS_ACT); bf16* H = (bf16*)(ws + WS_H);
    const float* xs_off = x_sample - (size_t)M_P * D_MODEL;
    const int lo = args.ph_lo, hi = args.ph_hi;
    XcdBarrier xbar; xbar.bar = (unsigned*)(ws + WS_BAR); xbar.x = 0u; xbar.nloc = 0u; xbar.nx = 0u;
#ifndef PH_MASK
#define PH_MASK 0x7ff
#endif
#define IN(k) (((PH_MASK >> (k)) & 1) && lo <= (k) && (k) < hi)
#define SEAM(k) do { if ((k) + 1 < hi) { if ((k) == 0) grid.sync(); else xcd_barrier(xbar); } } while (0)

    if (IN(0)) for (int rep_ = 0; rep_ < REP_P0; ++rep_) {
        LAS float* scr = (LAS float*)(lds + wave * 16384);
        constexpr int I_GU = (D_MODEL / 64) * (2 * D_FF / 32), I_D = (D_FF / 64) * (D_MODEL / 32), I_IN = (D_MODEL / 64) * (D_IN / 32), I_OUT = (D_MODEL / 64) * (D_MODEL / 32);
        constexpr int NITEMS = 2 * I_GU + 2 * I_D + I_IN + I_OUT;
        for (int it = gw; it < NITEMS; it += ngw) {
            int r = it;
            if (r < I_GU) { transpose_item<true>(w_ffn1_gu, D_MODEL, 2 * D_FF, Wgu1, scr, r, lane, g_ffn1_pre); continue; } r -= I_GU;
            if (r < I_GU) { transpose_item<true>(w_ffn2_gu, D_MODEL, 2 * D_FF, Wgu2, scr, r, lane, g_ffn2_pre); continue; } r -= I_GU;
            if (r < I_D) { transpose_item<false>(w_ffn1_down, D_FF, D_MODEL, Wd1, scr, r, lane, nullptr); continue; } r -= I_D;
            if (r < I_D) { transpose_item<false>(w_ffn2_down, D_FF, D_MODEL, Wd2, scr, r, lane, nullptr); continue; } r -= I_D;
            if (r < I_IN) { transpose_item<false>(w_in, D_MODEL, D_IN, Win, scr, r, lane, g_mix_pre); continue; } r -= I_IN;
            transpose_item<false>(w_out, D_MODEL, D_MODEL, Wout, scr, r, lane, nullptr);
        }
        rowpass<false, true, false, false>(gw, ngw, lane, x_prompt, xs_off, nullptr, nullptr, nullptr, nullptr, 0.f, nullptr, nullptr, RS, XN, false);
        if (rep_ == 0 && bx == 0) { for (int i = tid; i < 4096; i += NTHREADS) ((unsigned*)(ws + WS_BAR))[i] = 0u; }
        SEAM(0);
        if (rep_ == 0) xbar = xcd_barrier_post((unsigned*)(ws + WS_BAR));
    }
    if (IN(1)) for (int rep_ = 0; rep_ < REP_P1; ++rep_) {
        pg8::Gemm g{XN, Wgu1, M_TOT, 2 * D_FF, D_MODEL}; pg8::StaticOrder S; S.init(M_TOT, 2 * D_FF, G, bx, 1);
        pg8::EpiSwiglu E{ACT, D_FF, RS};
        pg8::gemm_phase<pg8::EpiSwiglu, pg8::StaticOrder, PG8_ALIGN, PG8_SP2>(lds, g, S, E);
        SEAM(1);
    }
    if (IN(2)) for (int rep_ = 0; rep_ < REP_P2; ++rep_) {
        pg8::Gemm g{ACT, Wd1, M_TOT, D_MODEL, D_FF}; pg8::StaticOrder S; S.init(M_TOT, D_MODEL, G, bx);
        pg8::EpiT E{T, D_MODEL, PART};
        pg8::gemm_phase<pg8::EpiT, pg8::StaticOrder, PG8_ALIGN, PG8_SP2>(lds, g, S, E);
        SEAM(2);
    }
#ifdef PROBE_SYNCS
    for (int i_ = 0; i_ < PROBE_SYNCS; ++i_) grid.sync();
#endif
    if (IN(3)) for (int rep_ = 0; rep_ < REP_P3; ++rep_) {
        rowpass<true, true, false, true>(gw, ngw, lane, x_prompt, xs_off, nullptr, T, PART, g_ffn1_post, 0.5f, nullptr, H, RS, nullptr, true);
        SEAM(3);
    }
    if (IN(4)) for (int rep_ = 0; rep_ < REP_P4; ++rep_) {
        pg8::Gemm g{H, Win, M_TOT, D_IN, D_MODEL}; pg8::StaticOrder S; S.init(M_TOT, D_IN, G, bx);
        pg8::EpiProj E{(bf16*)(ws + WS_QDA), (bf16*)(ws + WS_KDA), (bf16*)(ws + WS_VTDA), (bf16*)(ws + WS_QSW), (bf16*)(ws + WS_KSW), (bf16*)(ws + WS_VTSW), QSCALE, lds + 131072, RS};
        pg8::gemm_phase<pg8::EpiProj, pg8::StaticOrder, PG8_ALIGN, PG8_SP2>(lds, g, S, E);
#ifdef PROBE_DUP_P4
        grid.sync();
        pg8::gemm_phase<pg8::EpiProj, pg8::StaticOrder, PG8_ALIGN, PG8_SP2>(lds, g, S, E);
#endif
        SEAM(4);
    }
    if (IN(5)) for (int rep_ = 0; rep_ < REP_P5; ++rep_) {
        AttnP P{(const bf16*)(ws + WS_QDA), (const bf16*)(ws + WS_KDA), (const bf16*)(ws + WS_VTDA), (const bf16*)(ws + WS_QSW), (const bf16*)(ws + WS_KSW), (const bf16*)(ws + WS_VTSW), XN, rel_bias, g_subln, sink, (float*)(ws + WS_T)};
        attn_phase(lds, P, vcu, G, lq1, lk1, lq2, lk2);
        SEAM(5);
    }
    if (IN(6)) for (int rep_ = 0; rep_ < REP_P6; ++rep_) {
        pg8::Gemm g{XN, Wout, M_TOT, D_MODEL, D_MODEL}; pg8::StaticOrder S; S.init(M_TOT, D_MODEL, G, bx);
        pg8::EpiT E{T, D_MODEL, PART};
        pg8::gemm_phase<pg8::EpiT, pg8::StaticOrder, PG8_ALIGN, PG8_SP2>(lds, g, S, E);
        SEAM(6);
    }
    if (IN(7)) for (int rep_ = 0; rep_ < REP_P7; ++rep_) {
        rowpass<true, true, true, true>(gw, ngw, lane, nullptr, nullptr, H, T, PART, g_mix_post, 1.0f, nullptr, H, RS, nullptr, true);
        SEAM(7);
    }
    if (IN(8)) for (int rep_ = 0; rep_ < REP_P8; ++rep_) {
        pg8::Gemm g{H, Wgu2, M_TOT, 2 * D_FF, D_MODEL}; pg8::StaticOrder S; S.init(M_TOT, 2 * D_FF, G, bx);
        pg8::EpiSwiglu E{ACT, D_FF, RS};
        pg8::gemm_phase<pg8::EpiSwiglu, pg8::StaticOrder, PG8_ALIGN, PG8_SP2>(lds, g, S, E);
        SEAM(8);
    }
    if (IN(9)) for (int rep_ = 0; rep_ < REP_P9; ++rep_) {
        pg8::Gemm g{ACT, Wd2, M_TOT, D_MODEL, D_FF}; pg8::StaticOrder S; S.init(M_TOT, D_MODEL, G, bx, 1);
        pg8::EpiT E{T, D_MODEL, PART};
        pg8::gemm_phase<pg8::EpiT, pg8::StaticOrder, PG8_ALIGN, PG8_SP2>(lds, g, S, E);
        SEAM(9);
    }
    if (IN(10)) for (int rep_ = 0; rep_ < REP_P10; ++rep_) {
        rowpass<true, false, true, false>(gw, ngw, lane, nullptr, nullptr, H, T, PART, g_ffn2_post, 0.5f, out, nullptr, nullptr, nullptr, false);
    }
#undef IN
#undef SEAM
}

#ifndef MK_MULTI_LAUNCH
#define MK_MULTI_LAUNCH 0
#endif
extern "C" void kernel_launch(void* const* d_in, const int* in_sizes, int n_in, void* d_out, int out_size, void* d_ws, size_t ws_size, hipStream_t stream) {
    static int grid = 0;
    if (grid == 0) {
        if (n_in != 21 || out_size != M_TOT * D_MODEL || ws_size < WS_END) { fprintf(stderr, "kernel_launch: unexpected shapes (n_in %d, out %d, ws %zu)\n", n_in, out_size, ws_size); grid = -1; return; }
        int dev = 0, cus = 0, per_cu = 0;
        hipGetDevice(&dev);
        hipDeviceGetAttribute(&cus, hipDeviceAttributeMultiprocessorCount, dev);
        if (hipFuncSetAttribute((const void*)mega_fwd, hipFuncAttributeMaxDynamicSharedMemorySize, LDS_BYTES) != hipSuccess) { fprintf(stderr, "kernel_launch: hipFuncSetAttribute failed\n"); grid = -1; return; }
        if (hipOccupancyMaxActiveBlocksPerMultiprocessor(&per_cu, (const void*)mega_fwd, NTHREADS, LDS_BYTES) != hipSuccess || per_cu < 1) { fprintf(stderr, "kernel_launch: occupancy query gave %d\n", per_cu); per_cu = 1; }
        (void)hipGetLastError();
        grid = cus * per_cu;
    }
    if (grid < 0) return;
    Args a{};
    for (int i = 0; i < 21; ++i) a.in[i] = (const float*)d_in[i];
    a.out = (float*)d_out; a.ws = (unsigned char*)d_ws;
#if MK_MULTI_LAUNCH
    for (int p = 0; p < N_PHASES; ++p) {
        a.ph_lo = p; a.ph_hi = p + 1;
        hipLaunchKernelGGL(mega_fwd, dim3(grid), dim3(NTHREADS), LDS_BYTES, stream, a);
    }
#else
    a.ph_lo = 0; a.ph_hi = N_PHASES;
    void* kargs[] = {&a};
    hipError_t e = hipLaunchCooperativeKernel((const void*)mega_fwd, dim3(grid), dim3(NTHREADS), kargs, LDS_BYTES, stream);
    if (e != hipSuccess) fprintf(stderr, "cooperative launch failed: %s (grid %d)\n", hipGetErrorString(e), grid);
#endif
}
```
